# Optimizing an MI355X kernel written in HIP

```python
import math
import jax, jax.numpy as jnp
from jax import lax
import numpy as np


D_MODEL = 1024
BATCH = 4
SEQ = 8192
DEPTH = 1
DEC_BATCH = 16
DEC_SEQ = 32
PAST_LEN = 2048

CHUNK = 64
LEFT_CHUNKS = 8
WINDOW = CHUNK * LEFT_CHUNKS
BAND = WINDOW + CHUNK
D_MIX = D_MODEL
D_ATTN = D_MIX // 2
D_SSM = D_MIX - D_ATTN
ATTN_HEAD_DIM = 64
ATTN_HEADS = D_ATTN // ATTN_HEAD_DIM
ATTN_SCALE = ATTN_HEAD_DIM ** -0.5
MAX_REL = 128
N_REL = 2 * MAX_REL + 1
NEG_INF = -1e30
SSM_HEAD_DIM = 64
SSM_HEADS = D_SSM // SSM_HEAD_DIM
SSM_GROUPS = 2
SSM_HEADS_PER_GROUP = SSM_HEADS // SSM_GROUPS
SSM_STATE = 128
SSM_CONV = 4
SSM_CONV_DIM = D_SSM + 2 * SSM_GROUPS * SSM_STATE
D_IN_PROJ = 3 * D_ATTN + D_SSM + SSM_CONV_DIM + SSM_HEADS
SPLITS = (D_ATTN, 2 * D_ATTN, 3 * D_ATTN, 3 * D_ATTN + D_SSM, 3 * D_ATTN + D_SSM + SSM_CONV_DIM)
D_FF = 2688
FFN_CONV = 3
ALPHA = (2.0 * DEPTH) ** 0.25
BETA_INIT = (8.0 * DEPTH) ** -0.25
LN_EPS = 1e-5
RMS_EPS = 1e-5

kernel_name = 'hybrid_chunk_attn_ssd_convffn_step'


def layer_norm(x, g, b):
    xf = x.astype(jnp.float32)
    mu = jnp.mean(xf, axis=-1, keepdims=True)
    var = jnp.mean(jnp.square(xf - mu), axis=-1, keepdims=True)
    return ((xf - mu) * lax.rsqrt(var + LN_EPS) * g.astype(jnp.float32) + b.astype(jnp.float32)).astype(x.dtype)


def rms_norm(x, g):
    xf = x.astype(jnp.float32)
    return (xf * lax.rsqrt(jnp.mean(jnp.square(xf), axis=-1, keepdims=True) + RMS_EPS) * g.astype(jnp.float32)).astype(x.dtype)


def causal_dwconv(x, past, w, b):
    K = w.shape[0]
    L = x.shape[1]
    xp = jnp.concatenate([past.astype(x.dtype), x], axis=1)
    out = b + w[0] * xp[:, 0:L]
    for t in range(1, K):
        out = out + w[t] * xp[:, t:t + L]
    return out, xp[:, L:]


def band_attention(q, k, v, rel, valid, rel_bias):
    idx = jnp.clip(rel, -MAX_REL, MAX_REL) + MAX_REL
    bias = rel_bias[:, idx].astype(jnp.float32)
    s = jnp.einsum('bqhd,bkhd->bhqk', q, k).astype(jnp.float32) * ATTN_SCALE + bias
    if valid is not None:
        s = jnp.where(valid, s, NEG_INF)
    p = jax.nn.softmax(s, axis=-1).astype(v.dtype)
    return jnp.einsum('bhqk,bkhd->bqhd', p, v)


def attn_prompt(q, k, v, rel_bias):
    L = q.shape[1]
    n_chunks = L // CHUNK
    pad = ((0, 0), (WINDOW, 0), (0, 0), (0, 0))
    k_pad = jnp.pad(k, pad)
    v_pad = jnp.pad(v, pad)
    rel = (WINDOW + jnp.arange(CHUNK)[:, None]) - jnp.arange(BAND)[None, :]

    def one_chunk(c):
        start = c * CHUNK
        q_c = lax.dynamic_slice_in_dim(q, start, CHUNK, axis=1)
        k_c = lax.dynamic_slice_in_dim(k_pad, start, BAND, axis=1)
        v_c = lax.dynamic_slice_in_dim(v_pad, start, BAND, axis=1)
        valid = (start - WINDOW + jnp.arange(BAND))[None, :] >= 0
        return band_attention(q_c, k_c, v_c, rel, valid, rel_bias)

    out = lax.map(one_chunk, jnp.arange(n_chunks))
    return jnp.moveaxis(out, 0, 1).reshape(q.shape)


def attn_sample(q, k, v, k_past, v_past, rel_bias):
    n_past = k_past.shape[1]
    Lq = q.shape[1]
    kk = jnp.concatenate([k_past.astype(k.dtype), k], axis=1)
    vv = jnp.concatenate([v_past.astype(v.dtype), v], axis=1)
    rel = (n_past + jnp.arange(Lq)[:, None]) - jnp.arange(n_past + Lq)[None, :]
    return band_attention(q, kk, vv, rel, None, rel_bias)


def ssd_scan(x, dt, A, Bm, Cm, h0):
    f32 = jnp.float32
    bsz, L = x.shape[:2]
    G, R, P, N = SSM_GROUPS, SSM_HEADS_PER_GROUP, SSM_HEAD_DIM, SSM_STATE
    n_chunks = -(-L // CHUNK)
    pad_len = n_chunks * CHUNK - L

    def to_chunks(t):
        t = jnp.pad(t, [(0, 0), (0, pad_len)] + [(0, 0)] * (t.ndim - 2))
        return t.reshape((bsz, n_chunks, CHUNK) + t.shape[2:])

    x_c = to_chunks(x.astype(f32) * dt[..., None]).reshape(bsz, n_chunks, CHUNK, G, R, P)
    a_c = to_chunks(dt * A).reshape(bsz, n_chunks, CHUNK, G, R)
    B_c = to_chunks(Bm.astype(f32))
    C_c = to_chunks(Cm.astype(f32))
    a_cum = jnp.cumsum(a_c, axis=2)
    causal = jnp.tril(jnp.ones((CHUNK, CHUNK), bool))[:, :, None, None]
    seg = a_cum[:, :, :, None] - a_cum[:, :, None, :]
    Lmat = jnp.exp(jnp.where(causal, seg, -jnp.inf))
    CB = jnp.einsum('bclgn,bcsgn->bclsg', C_c, B_c)
    y_diag = jnp.einsum('bclsg,bclsgr,bcsgrp->bclgrp', CB, Lmat, x_c)
    decay_states = jnp.exp(a_cum[:, :, -1:] - a_cum)
    states = jnp.einsum('bcsgn,bcsgr,bcsgrp->bcgrpn', B_c, decay_states, x_c)
    chunk_decay = jnp.exp(a_cum[:, :, -1])

    def step(h, inp):
        st, dec = inp
        return h * dec[..., None, None] + st, h

    h_init = h0.astype(f32).reshape(bsz, G, R, P, N)
    h_final, prev = lax.scan(step, h_init, (jnp.moveaxis(states, 1, 0), jnp.moveaxis(chunk_decay, 1, 0)))
    prev = jnp.moveaxis(prev, 0, 1)
    y_off = jnp.einsum('bclgn,bcgrpn,bclgr->bclgrp', C_c, prev, jnp.exp(a_cum))
    y = (y_diag + y_off).reshape(bsz, n_chunks * CHUNK, SSM_HEADS, P)[:, :L]
    return y, h_final.reshape(bsz, SSM_HEADS, P, N)


def ssd_mixer(z, xBC, dt_raw, conv_past, h0, conv_w, conv_b, dt_bias, A_log, D_skip, norm_g):
    bsz, L = z.shape[:2]
    xBC, conv_new = causal_dwconv(xBC, conv_past, conv_w, conv_b)
    xBC = jax.nn.silu(xBC)
    xs, Bm, Cm = jnp.split(xBC, [D_SSM, D_SSM + SSM_GROUPS * SSM_STATE], axis=-1)
    xh = xs.reshape(bsz, L, SSM_HEADS, SSM_HEAD_DIM)
    Bm = Bm.reshape(bsz, L, SSM_GROUPS, SSM_STATE)
    Cm = Cm.reshape(bsz, L, SSM_GROUPS, SSM_STATE)
    dt = jax.nn.softplus(dt_raw.astype(jnp.float32) + dt_bias.astype(jnp.float32))
    A = -jnp.exp(A_log.astype(jnp.float32))
    y, h_new = ssd_scan(xh, dt, A, Bm, Cm, h0)
    y = y + xh.astype(jnp.float32) * D_skip.astype(jnp.float32)[:, None]
    y = y.reshape(bsz, L, D_SSM) * jax.nn.silu(z.astype(jnp.float32))
    return rms_norm(y, norm_g).astype(z.dtype), conv_new, h_new


def hybrid_layer(x, k_past, v_past, h0, conv_past, ffn_past,
                 w_in, rel_bias, attn_norm_g, ssm_conv_w, ssm_conv_b, ssm_dt_bias, ssm_A_log,
                 ssm_D, ssm_norm_g, w_out, ln1_g, ln1_b, w_up, ffn_conv_w, ffn_conv_b, w_down,
                 ln2_g, ln2_b):
    bsz, L, _ = x.shape
    if h0 is None:
        h0 = jnp.zeros((bsz, SSM_HEADS, SSM_HEAD_DIM, SSM_STATE), jnp.float32)
        conv_past = jnp.zeros((bsz, SSM_CONV - 1, SSM_CONV_DIM), x.dtype)
        ffn_past = jnp.zeros((bsz, FFN_CONV - 1, 2 * D_FF), x.dtype)
    proj = x @ w_in
    q, k, v, z, xBC, dt_raw = jnp.split(proj, SPLITS, axis=-1)
    q = q.reshape(bsz, L, ATTN_HEADS, ATTN_HEAD_DIM)
    k = k.reshape(bsz, L, ATTN_HEADS, ATTN_HEAD_DIM)
    v = v.reshape(bsz, L, ATTN_HEADS, ATTN_HEAD_DIM)
    if k_past is None:
        a = attn_prompt(q, k, v, rel_bias)
        n_keep = min(WINDOW, L)
        k_new, v_new = k[:, L - n_keep:], v[:, L - n_keep:]
    else:
        a = attn_sample(q, k, v, k_past, v_past, rel_bias)
        k_new, v_new = k, v
    a = rms_norm(a.reshape(bsz, L, D_ATTN), attn_norm_g)
    s, conv_new, h_new = ssd_mixer(z, xBC, dt_raw, conv_past, h0, ssm_conv_w, ssm_conv_b,
                                   ssm_dt_bias, ssm_A_log, ssm_D, ssm_norm_g)
    mix = jnp.concatenate([a, s], axis=-1) @ w_out
    x = layer_norm(ALPHA * x + mix, ln1_g, ln1_b)
    h, ffn_new = causal_dwconv(x @ w_up, ffn_past, ffn_conv_w, ffn_conv_b)
    hv, hg = jnp.split(h, [D_FF], axis=-1)
    f = (hv * jax.nn.silu(hg)) @ w_down
    x = layer_norm(ALPHA * x + f, ln2_g, ln2_b)
    return x, (k_new, v_new, h_new, conv_new, ffn_new)


def setup_inputs(seed: int = 0) -> dict:
    key = jax.random.key(seed)
    ks = jax.random.split(key, 26)
    f32 = jnp.float32

    def nrm(k, shape, scale):
        return jax.random.normal(k, shape, f32) * scale

    n_cache = min(WINDOW, PAST_LEN)
    dt0 = jnp.exp(jax.random.uniform(ks[9], (DEPTH, SSM_HEADS), f32, math.log(1e-3), math.log(1e-1)))
    return {
        'x_prompt': nrm(ks[0], (BATCH, SEQ, D_MODEL), 1.0),
        'x_sample': nrm(ks[1], (DEC_BATCH, DEC_SEQ, D_MODEL), 1.0),
        'cache_attn_k': nrm(ks[2], (DEPTH, DEC_BATCH, n_cache, ATTN_HEADS, ATTN_HEAD_DIM), 1.0),
        'cache_attn_v': nrm(ks[3], (DEPTH, DEC_BATCH, n_cache, ATTN_HEADS, ATTN_HEAD_DIM), 1.0),
        'state_ssm': nrm(ks[4], (DEPTH, DEC_BATCH, SSM_HEADS, SSM_HEAD_DIM, SSM_STATE), 0.5),
        'state_ssm_conv': nrm(ks[5], (DEPTH, DEC_BATCH, SSM_CONV - 1, SSM_CONV_DIM), 1.0),
        'state_ffn_conv': nrm(ks[6], (DEPTH, DEC_BATCH, FFN_CONV - 1, 2 * D_FF), 1.0),
        'w_in': nrm(ks[7], (DEPTH, D_MODEL, D_IN_PROJ), D_MODEL ** -0.5),
        'rel_bias': nrm(ks[8], (DEPTH, ATTN_HEADS, N_REL), 0.5),
        'attn_norm_g': 1.0 + nrm(ks[10], (DEPTH, D_ATTN), 0.02),
        'ssm_conv_w': nrm(ks[11], (DEPTH, SSM_CONV, SSM_CONV_DIM), SSM_CONV ** -0.5),
        'ssm_conv_b': nrm(ks[12], (DEPTH, SSM_CONV_DIM), 0.02),
        'ssm_dt_bias': dt0 + jnp.log(-jnp.expm1(-dt0)),
        'ssm_A_log': jnp.log(jax.random.uniform(ks[13], (DEPTH, SSM_HEADS), f32, 1.0, 16.0)),
        'ssm_D': 1.0 + nrm(ks[14], (DEPTH, SSM_HEADS), 0.02),
        'ssm_norm_g': 1.0 + nrm(ks[15], (DEPTH, D_SSM), 0.02),
        'w_out': nrm(ks[16], (DEPTH, D_MIX, D_MODEL), D_MIX ** -0.5 * BETA_INIT),
        'ln1_g': 1.0 + nrm(ks[17], (DEPTH, D_MODEL), 0.02),
        'ln1_b': nrm(ks[18], (DEPTH, D_MODEL), 0.02),
        'w_up': nrm(ks[19], (DEPTH, D_MODEL, 2 * D_FF), D_MODEL ** -0.5),
        'ffn_conv_w': nrm(ks[20], (DEPTH, FFN_CONV, 2 * D_FF), FFN_CONV ** -0.5),
        'ffn_conv_b': nrm(ks[21], (DEPTH, 2 * D_FF), 0.02),
        'w_down': nrm(ks[22], (DEPTH, D_FF, D_MODEL), D_FF ** -0.5 * BETA_INIT),
        'ln2_g': 1.0 + nrm(ks[23], (DEPTH, D_MODEL), 0.02),
        'ln2_b': nrm(ks[24], (DEPTH, D_MODEL), 0.02),
    }


def reference(x_prompt, x_sample, cache_attn_k, cache_attn_v, state_ssm, state_ssm_conv, state_ffn_conv,
              w_in, rel_bias, attn_norm_g, ssm_conv_w, ssm_conv_b, ssm_dt_bias, ssm_A_log, ssm_D,
              ssm_norm_g, w_out, ln1_g, ln1_b, w_up, ffn_conv_w, ffn_conv_b, w_down, ln2_g, ln2_b):
    yp, ys = x_prompt, x_sample
    st_p, st_s = [], []
    for l in range(DEPTH):
        params = (w_in[l], rel_bias[l], attn_norm_g[l], ssm_conv_w[l], ssm_conv_b[l], ssm_dt_bias[l],
                  ssm_A_log[l], ssm_D[l], ssm_norm_g[l], w_out[l], ln1_g[l], ln1_b[l], w_up[l],
                  ffn_conv_w[l], ffn_conv_b[l], w_down[l], ln2_g[l], ln2_b[l])
        yp, sp = hybrid_layer(yp, None, None, None, None, None, *params)
        ys, ss = hybrid_layer(ys, cache_attn_k[l], cache_attn_v[l], state_ssm[l], state_ssm_conv[l],
                              state_ffn_conv[l], *params)
        st_p.append(sp)
        st_s.append(ss)
    new_k_prompt = jnp.stack([s[0] for s in st_p])
    new_v_prompt = jnp.stack([s[1] for s in st_p])
    new_k_sample = jnp.stack([s[0] for s in st_s])
    new_v_sample = jnp.stack([s[1] for s in st_s])
    new_ssm_prompt = jnp.stack([s[2] for s in st_p])
    new_ssm_sample = jnp.stack([s[2] for s in st_s])
    new_ssm_conv_prompt = jnp.stack([s[3] for s in st_p])
    new_ssm_conv_sample = jnp.stack([s[3] for s in st_s])
    new_ffn_conv_prompt = jnp.stack([s[4] for s in st_p])
    new_ffn_conv_sample = jnp.stack([s[4] for s in st_s])
    return (yp, ys, new_k_prompt, new_v_prompt, new_k_sample, new_v_sample,
            new_ssm_prompt, new_ssm_sample, new_ssm_conv_prompt, new_ssm_conv_sample,
            new_ffn_conv_prompt, new_ffn_conv_sample)
```

```cpp
#include <hip/hip_runtime.h>
#include <hip/hip_cooperative_groups.h>
#include <cstdio>
namespace cg = cooperative_groups;

#define LAS __attribute__((address_space(3)))
typedef unsigned short bf16_t;
typedef short bf16x8 __attribute__((ext_vector_type(8)));
typedef short s16x4 __attribute__((ext_vector_type(4)));
typedef float f32x2 __attribute__((ext_vector_type(2)));
typedef float f32x4 __attribute__((ext_vector_type(4)));
typedef float f32x16 __attribute__((ext_vector_type(16)));
typedef unsigned u32x2 __attribute__((ext_vector_type(2)));
typedef unsigned u32x4 __attribute__((ext_vector_type(4)));
typedef __bf16 bf2_t __attribute__((ext_vector_type(2)));
typedef int i32x4 __attribute__((ext_vector_type(4)));
typedef int i32x8 __attribute__((ext_vector_type(8)));
#define DI __device__ __forceinline__

constexpr int MP = 32768, MS = 512, MT = MP + MS;
constexpr int DM = 1024, NIN = 3080, NINP = 3328, DFF = 2688, NUP = 5376;
constexpr int NCHUNK = 528;
constexpr float ALPHA = 1.189207115002721f;
constexpr float LOG2E = 1.4426950408889634f;
constexpr int NT = 512;
constexpr int LDS_BYTES = 147456;
constexpr int GP8 = 2816;
constexpr float SC_X1 = 16.f, SC_WUP = 64.f, SC_G = 8.f, SC_WDN = 128.f;

constexpr size_t O_Y = 0;
constexpr size_t O_NKP = (size_t)MT * 1024;
constexpr size_t O_NVP = O_NKP + 1048576;
constexpr size_t O_NKS = O_NVP + 1048576;
constexpr size_t O_NVS = O_NKS + 262144;
constexpr size_t O_SSP = O_NVS + 262144;
constexpr size_t O_SSS = O_SSP + 262144;
constexpr size_t O_SCP = O_SSS + 1048576;
constexpr size_t O_SCS = O_SCP + 12288;
constexpr size_t O_FCP = O_SCS + 49152;
constexpr size_t O_FCS = O_FCP + 43008;

constexpr size_t al256(size_t x) { return (x + 255) & ~(size_t)255; }
constexpr size_t WS_WIN = 0;
constexpr size_t WS_WOUT = WS_WIN + al256((size_t)NINP * 1024 * 2);
constexpr size_t WS_WUP = WS_WOUT + al256((size_t)1024 * 1024 * 2);
constexpr size_t WS_WDOWN = WS_WUP + al256((size_t)NUP * 1024 * 2);
constexpr size_t WS_WUP8 = WS_WDOWN + al256((size_t)1024 * DFF * 2);
constexpr size_t WS_WDN8 = WS_WUP8 + al256((size_t)NUP * 1024);
constexpr size_t WS_GS = WS_WDN8 + al256((size_t)1024 * GP8);
constexpr size_t WS_DT = WS_GS + al256((size_t)MS * DFF * 2);
constexpr size_t WS_DEC = WS_DT + al256((size_t)MT * 8 * 4);
constexpr size_t WS_BAR = WS_DEC + al256((size_t)NCHUNK * 8 * 4);
constexpr size_t WS_XB = WS_BAR + 16384 + 8192;
constexpr size_t WS_R3 = WS_XB + al256((size_t)(MT + 256) * 1024 * 2);
constexpr size_t WS_G = WS_R3;
constexpr size_t WS_X1F8 = WS_R3 + al256((size_t)MP * DFF * 2) + 8192;
constexpr size_t WS_Q = WS_R3;
constexpr size_t WS_KP = WS_Q + al256((size_t)MT * 512 * 2);
constexpr size_t WS_KS = WS_KP + al256((size_t)MP * 512 * 2);
constexpr size_t WS_VFP = WS_KS + al256((size_t)16 * 544 * 512 * 2);
constexpr size_t WS_VFS = WS_VFP + al256((size_t)4 * 8 * 512 * 1024 * 2);
constexpr size_t WS_Z = WS_VFS + al256((size_t)16 * 8 * 34 * 1024 * 2) + 65536;
constexpr size_t WS_XBC = WS_Z + al256((size_t)MT * 512 * 2);
constexpr size_t WS_A2 = WS_XBC + al256((size_t)MT * 1024 * 2);
constexpr size_t WS_ST = WS_A2 + al256((size_t)MT * 1024 * 2);
constexpr size_t WS_END = WS_ST + al256((size_t)NCHUNK * 65536 * 2);
static_assert(WS_X1F8 + (size_t)(MT + 256) * 1024 <= WS_A2, "G8/X1F8 alias");
static_assert(WS_A2 + (size_t)MT * 1024 * 4 <= WS_END, "U2 alias");

struct Params {
    const float* in[25];
    float* out;
    unsigned char* ws;
};
typedef const __attribute__((address_space(4))) Params* KP;

DI unsigned pk2(float lo, float hi) { f32x2 f = {lo, hi}; return __builtin_bit_cast(unsigned, __builtin_convertvector(f, bf2_t)); }
DI unsigned pk4_f8(float a, float b, float c, float d) { int w = 0; w = __builtin_amdgcn_cvt_pk_fp8_f32(a, b, w, false); w = __builtin_amdgcn_cvt_pk_fp8_f32(c, d, w, true); return (unsigned)w; }
DI float bf_lo(unsigned w) { return __uint_as_float(w << 16); }
DI float bf_hi(unsigned w) { return __uint_as_float(w & 0xffff0000u); }
DI float silu_f(float x) { return x * __builtin_amdgcn_rcpf(1.0f + __builtin_amdgcn_exp2f(-x * LOG2E)); }
DI int crow(int reg, int h) { return (reg & 3) + 8 * (reg >> 2) + 4 * h; }
#define MFMA32(a, b, c) __builtin_amdgcn_mfma_f32_32x32x16_bf16((a), (b), (c), 0, 0, 0)
DI bf16x8 pack8(float a0, float a1, float a2, float a3, float a4, float a5, float a6, float a7) {
    u32x4 p; p.x = pk2(a0, a1); p.y = pk2(a2, a3); p.z = pk2(a4, a5); p.w = pk2(a6, a7); return __builtin_bit_cast(bf16x8, p);
}
DI void pin(bf16x8& v) { asm volatile("" : "+v"(v)); }
DI void pin(u32x2& v) { asm volatile("" : "+v"(v)); }
DI void pin(f32x4& v) { asm volatile("" : "+v"(v)); }
DI bf16x8 tr_frag(LAS unsigned char* lo, LAS unsigned char* hi) {
    s16x4 a = __builtin_amdgcn_ds_read_tr16_b64_v4i16((LAS s16x4*)lo);
    s16x4 b = __builtin_amdgcn_ds_read_tr16_b64_v4i16((LAS s16x4*)hi);
    return __builtin_shufflevector(a, b, 0, 1, 2, 3, 4, 5, 6, 7);
}


#define XB_TMO      128
#define XB_XCNT(j)  (256  + 64 * (j))
#define XB_XSUB(j)  (1280 + 64 * (j))
#define XB_XGEN(j)  (2304 + 64 * (j))
#define XB_TOP      3328
#define XB_TOPGEN   3392
#define XCD_BAR_WORDS 3456
#define XB_SPIN_CAP (1u << 20)
DI unsigned xb_ld(unsigned* p)              { return __hip_atomic_load(p, __ATOMIC_RELAXED, __HIP_MEMORY_SCOPE_AGENT); }
DI unsigned xb_add(unsigned* p, unsigned v) { return __hip_atomic_fetch_add(p, v, __ATOMIC_RELAXED, __HIP_MEMORY_SCOPE_AGENT); }
DI unsigned xb_xcc_id() { return (unsigned)__builtin_amdgcn_s_getreg((3 << 11) | 20) & 0xFu; }
#define XB_SPIN(cond, bar) do { unsigned _sp = 0; while (cond) { __builtin_amdgcn_s_sleep(1); \
    if ((++_sp & 255u) == 0u) { if (xb_ld(&(bar)[XB_TMO])) break; if (_sp > XB_SPIN_CAP) { atomicAdd(&(bar)[XB_TMO], 1u); break; } } } } while (0)
struct XcdBarrier { unsigned* bar; unsigned x; volatile LAS unsigned* st; };
DI XcdBarrier xcd_barrier_post(unsigned* bar, volatile LAS unsigned* st) {
    XcdBarrier b; b.bar = bar; b.x = xb_xcc_id(); b.st = st;
    if (threadIdx.x == 0) (void)xb_add(&bar[XB_XCNT(b.x)], 1u);
    return b;
}
DI void xcd_barrier_complete(unsigned* bar, unsigned x, unsigned& nloc, unsigned& nx) {
    const unsigned G = gridDim.x * gridDim.y * gridDim.z;
    unsigned sum, cnt, mine, sp = 0u;
    for (;;) {
        sum = 0u; cnt = 0u; mine = 0u;
#pragma unroll
        for (unsigned j = 0; j < 16; ++j) { const unsigned c = xb_ld(&bar[XB_XCNT(j)]); sum += c; cnt += (c > 0u) ? 1u : 0u; mine = (j == x) ? c : mine; }
        if (sum == G) break;
        __builtin_amdgcn_s_sleep(1);
        if ((++sp & 255u) == 0u) { if (xb_ld(&bar[XB_TMO])) break; if (sp > XB_SPIN_CAP) { atomicAdd(&bar[XB_TMO], 1u); break; } }
    }
    nloc = mine > 0u ? mine : 1u; nx = cnt > 0u ? cnt : 1u;
}
DI void xcd_census(const XcdBarrier& b, int tid_in) {
    if (tid_in < 64) {
        const unsigned G = gridDim.x * gridDim.y * gridDim.z;
        unsigned c = 0u, sum = 0u, sp = 0u;
        for (;;) {
            c = (tid_in < 16) ? xb_ld(&b.bar[XB_XCNT(tid_in)]) : 0u;
            sum = c;
#pragma unroll
            for (int o = 1; o < 16; o <<= 1) sum += __shfl_xor(sum, o);
            sum = __shfl(sum, 0);
            if (sum == G) break;
            __builtin_amdgcn_s_sleep(1);
            if (++sp > XB_SPIN_CAP) break;
        }
        if (sum == G) {
            const unsigned long long nz = __builtin_amdgcn_ballot_w64(c > 0u);
            const unsigned mine = __shfl(c, (int)b.x);
            if (tid_in == 0) { b.st[0] = mine > 0u ? mine : 1u; b.st[1] = (unsigned)__builtin_popcountll(nz); }
        }
    }
}
DI void xcd_barrier(const XcdBarrier& b, int tid_in) {
    asm volatile("s_waitcnt vmcnt(0)" ::: "memory");
    __syncthreads();
    if (tid_in == 0) {
        unsigned* bar = b.bar;
        __builtin_amdgcn_s_waitcnt(0);
        unsigned nloc = b.st[0], nx = b.st[1];
        if (nloc == 0u) { xcd_barrier_complete(bar, b.x, nloc, nx); b.st[0] = nloc; b.st[1] = nx; }
        const unsigned old = xb_add(&bar[XB_XSUB(b.x)], 1u);
        const unsigned gen = old / nloc;
        if (old + 1u == (gen + 1u) * nloc) {
            __builtin_amdgcn_fence(__ATOMIC_RELEASE, "agent");
            asm volatile("s_waitcnt vmcnt(0)" ::: "memory");
            const unsigned og = xb_add(&bar[XB_TOP], 1u);
            const unsigned tg = og / nx;
            if (og + 1u == (tg + 1u) * nx) xb_add(&bar[XB_TOPGEN], 1u);
            else XB_SPIN(xb_ld(&bar[XB_TOPGEN]) == tg, bar);
            __builtin_amdgcn_fence(__ATOMIC_ACQUIRE, "agent");
            xb_add(&bar[XB_XGEN(b.x)], 1u);
            asm volatile("s_waitcnt vmcnt(0)" ::: "memory");
        } else {
            XB_SPIN(xb_ld(&bar[XB_XGEN(b.x)]) == gen, bar);
            __builtin_amdgcn_fence(__ATOMIC_ACQUIRE, "agent");
            asm volatile("s_waitcnt vmcnt(0)" ::: "memory");
        }
    }
    __syncthreads();
}

namespace pg8 {
constexpr int BM = 256, BK = 64, HALF = 128, HTB = HALF * BK * 2, NXCD = 8, WGM = 8;
DI int lds_byte(int r, int c) { const int st = (r >> 4) * 2 + (c >> 5), rr = r & 15, cc = c & 31, ob = rr * 64 + cc * 2; return st * 1024 + (ob ^ (((ob >> 9) & 1) << 5)); }
DI void stage_rc(int b, int& R, int& C) { const int st = b / 1024, sb = b % 1024, swz = sb ^ (((sb >> 9) & 1) << 5); R = (st >> 1) * 16 + swz / 64; C = (st & 1) * 32 + (swz % 64) / 2; }
DI int perm32(int rho) { const int n = rho >> 4, i = rho & 15; return 8 * (i >> 2) + 4 * n + (i & 3); }
struct Unit { int pm, pn; };
struct Order {
    int nM, nN, nwg, G, c;
    DI void init(int nM_, int nN_, int G_, int c_) { nM = nM_; nN = nN_; nwg = nM * nN; G = G_; c = c_; }
    DI bool next(int i, Unit& u) const {
        const long L = (long)i * G + c; if (L >= nwg) return false;
        int wgid = (int)L; { const int q = nwg / NXCD, r = nwg % NXCD, xcd = wgid % NXCD, off = wgid / NXCD; wgid = (xcd < r ? xcd * (q + 1) : r * (q + 1) + (xcd - r) * q) + off; }
        const int nig = WGM * nN, gid = wgid / nig, fm = gid * WGM, gsz = (nM - fm) < WGM ? (nM - fm) : WGM;
        u.pm = fm + ((wgid % nig) % gsz); u.pn = (wgid % nig) / gsz; return true;
    }
};
struct AMapPlain {
    const void* A; int pitch;
    DI const char* unit_base(int pm) const { return (const char*)A + (size_t)pm * 256 * pitch; }
    DI size_t hstep() const { return (size_t)HALF * pitch; }
    DI unsigned voff(int R, int Cb) const { return (unsigned)(R * pitch + Cb); }
};
template <int WRS> struct AMapUp {
    const void* A; int pitch;
    DI const char* unit_base(int pm) const {
        if (WRS == 126) { const int b = pm / 33, ti = pm - b * 33; return (const char*)A + ((long)b * 8192 + ti * 252 - 2) * pitch; }
        return (const char*)A + ((long)MP + pm * 256) * pitch;
    }
    DI size_t hstep() const { return (size_t)4 * pitch; }
    DI unsigned voff(int R, int Cb) const { return (unsigned)((((R >> 6) * WRS + (R & 15) * 8 + ((R >> 4) & 3)) * pitch) + Cb); }
};

template <class Epi, class AMap, bool F8 = false>
DI void gemm_phase(LAS unsigned char* lds, const AMap am, const void* Bt, const int Kb, const Order& S, const Epi& E) {
    int tid = threadIdx.x; asm volatile("" : "+v"(tid));
    const int wid = __builtin_amdgcn_readfirstlane(tid >> 6), lane = tid & 63, wr = wid >> 2, wc = wid & 3, fr = lane & 15, fq = lane >> 4;
    const int nt = Kb / 128;
    unsigned voffA, voffB; size_t dA2, dB2;
    { int R, C; stage_rc(tid * 16, R, C); const int Rb = Epi::PERM ? ((R & ~31) + perm32(R & 31)) : R;
      voffA = am.voff(R, 2 * C); voffB = (unsigned)(Rb * Kb + 2 * C); dA2 = (size_t)(am.voff(64, 0) - am.voff(0, 0)); dB2 = (size_t)64 * Kb; }
    const size_t kstep = (size_t)128;
    const size_t hstepA = am.hstep();
    const size_t hstepB = (size_t)HALF * Kb;
    const size_t tstepB = 2 * hstepB;
    const unsigned ldsw = (unsigned)wid * 1024u;
    constexpr int QOFF = F8 ? 16 : 1024;
    const int aoff = F8 ? lds_byte(wr * 64 + fr, 16 * (fq & 1)) + 1024 * (fq >> 1) : lds_byte(wr * 64 + fr, fq * 8);
    const int boff = F8 ? lds_byte(wc * 32 + fr, 16 * (fq & 1)) + 1024 * (fq >> 1) : lds_byte(wc * 32 + fr, fq * 8);
#define PG8_SA(b, h) (((b) * 2 + (h)) * HTB)
#define PG8_SB(b, h) ((4 + (b) * 2 + (h)) * HTB)
#define PG8_STAGE(bufoff, gbase, voff) do { \
        __builtin_amdgcn_global_load_lds((const unsigned*)((const char*)(gbase) + (voff)), (LAS unsigned*)(lds + (bufoff) + ldsw), 16, 0, 0); \
        __builtin_amdgcn_global_load_lds((const unsigned*)((const char*)(gbase) + d2_##voff + (voff)), (LAS unsigned*)(lds + (bufoff) + ldsw + 8192), 16, 0, 0); } while (0)
#define d2_voffA dA2
#define d2_voffB dB2
#define PG8_LDA(dst, b, h) do { _Pragma("unroll") for (int m = 0; m < 4; ++m) { const i32x4 lo_ = *(const LAS i32x4*)(lds + PG8_SA(b, h) + aoff + m * 2048), hi_ = *(const LAS i32x4*)(lds + PG8_SA(b, h) + aoff + QOFF + m * 2048); \
        dst[m] = __builtin_shufflevector(lo_, hi_, 0, 1, 2, 3, 4, 5, 6, 7); } } while (0)
#define PG8_LDB(dst, b, h) do { _Pragma("unroll") for (int n = 0; n < 2; ++n) { const i32x4 lo_ = *(const LAS i32x4*)(lds + PG8_SB(b, h) + boff + n * 2048), hi_ = *(const LAS i32x4*)(lds + PG8_SB(b, h) + boff + QOFF + n * 2048); \
        dst[n] = __builtin_shufflevector(lo_, hi_, 0, 1, 2, 3, 4, 5, 6, 7); } } while (0)
#define PG8_HALF(v, k) __builtin_bit_cast(bf16x8, __builtin_shufflevector(v, v, 4 * (k), 4 * (k) + 1, 4 * (k) + 2, 4 * (k) + 3))
#define PG8_MMA(ai, bj, At, Bt_) do { __builtin_amdgcn_s_setprio(1); _Pragma("unroll") for (int m = 0; m < 4; ++m) _Pragma("unroll") for (int n = 0; n < 2; ++n) { \
        if (F8) acc[ai][bj][m][n] = __builtin_amdgcn_mfma_scale_f32_16x16x128_f8f6f4(Bt_[n], At[m], acc[ai][bj][m][n], 0, 0, 0, 0, 0, 0); \
        else { acc[ai][bj][m][n] = __builtin_amdgcn_mfma_f32_16x16x32_bf16(PG8_HALF(Bt_[n], 0), PG8_HALF(At[m], 0), acc[ai][bj][m][n], 0, 0, 0); \
               acc[ai][bj][m][n] = __builtin_amdgcn_mfma_f32_16x16x32_bf16(PG8_HALF(Bt_[n], 1), PG8_HALF(At[m], 1), acc[ai][bj][m][n], 0, 0, 0); } } \
        __builtin_amdgcn_s_setprio(0); } while (0)
#define PG8_WAIT_V(n) asm volatile("s_waitcnt vmcnt(" #n ")" ::: "memory")
#define PG8_WAIT_L(n) asm volatile("s_waitcnt lgkmcnt(" #n ")" ::: "memory")
#define PG8_BAR __builtin_amdgcn_s_barrier()
#define PG8_SCHED __builtin_amdgcn_sched_barrier(0)
    Unit cur, nxt; int ui = 0;
    if (!S.next(0, cur)) return;
    f32x4 acc[2][2][4][2];
#pragma unroll
    for (int a = 0; a < 2; ++a)
#pragma unroll
        for (int b = 0; b < 2; ++b)
#pragma unroll
            for (int m = 0; m < 4; ++m)
#pragma unroll
                for (int n = 0; n < 2; ++n) acc[a][b][m][n] = (f32x4){0.f, 0.f, 0.f, 0.f};
    i32x8 At[4], B0[2], B1[2];
    const char* cA = am.unit_base(cur.pm); const char* cB = (const char*)Bt + (size_t)cur.pn * tstepB;
    PG8_STAGE(PG8_SB(0, 0), cB, voffB); PG8_STAGE(PG8_SA(0, 0), cA, voffA); PG8_STAGE(PG8_SB(0, 1), cB + hstepB, voffB); PG8_STAGE(PG8_SA(0, 1), cA + hstepA, voffA);
    if (wr == 1) PG8_BAR;
    PG8_WAIT_V(4); PG8_BAR;
    PG8_STAGE(PG8_SB(1, 0), cB + kstep, voffB); PG8_STAGE(PG8_SA(1, 0), cA + kstep, voffA); PG8_STAGE(PG8_SB(1, 1), cB + hstepB + kstep, voffB);
    PG8_WAIT_V(6); PG8_BAR;
    for (;;) {
        const bool has_next = S.next(ui + 1, nxt);
        const char* nA = has_next ? am.unit_base(nxt.pm) : cA; const char* nB = has_next ? (const char*)Bt + (size_t)nxt.pn * tstepB : cB;
        for (int t = 0; t < nt; t += 2) {
            const bool last = (t == nt - 2);
            const char* a1 = cA + (size_t)(t + 1) * kstep;
            const char* a2 = last ? nA : cA + (size_t)(t + 2) * kstep; const char* b2 = last ? nB : cB + (size_t)(t + 2) * kstep;
            const char* a3 = a2 + kstep; const char* b3 = b2 + kstep;
            PG8_LDB(B0, 0, 0); PG8_SCHED; PG8_LDA(At, 0, 0); PG8_STAGE(PG8_SA(1, 1), a1 + hstepA, voffA);
            PG8_WAIT_L(8); PG8_BAR; PG8_WAIT_L(0); PG8_MMA(0, 0, At, B0); PG8_BAR; PG8_SCHED;
            PG8_LDB(B1, 0, 1); PG8_STAGE(PG8_SB(0, 0), b2, voffB);
            PG8_BAR; PG8_WAIT_L(0); PG8_MMA(0, 1, At, B1); PG8_BAR;
            PG8_LDA(At, 0, 1); PG8_STAGE(PG8_SA(0, 0), a2, voffA);
            PG8_BAR; PG8_WAIT_L(0); PG8_MMA(1, 0, At, B0); PG8_BAR; PG8_SCHED;
            PG8_STAGE(PG8_SB(0, 1), b2 + hstepB, voffB);
            PG8_WAIT_V(6); PG8_BAR; PG8_MMA(1, 1, At, B1); PG8_BAR;
            PG8_LDB(B0, 1, 0); PG8_SCHED; PG8_LDA(At, 1, 0); PG8_STAGE(PG8_SA(0, 1), a2 + hstepA, voffA);
            PG8_WAIT_L(8); PG8_BAR; PG8_WAIT_L(0); PG8_MMA(0, 0, At, B0); PG8_BAR; PG8_SCHED;
            PG8_LDB(B1, 1, 1); PG8_STAGE(PG8_SB(1, 0), b3, voffB);
            PG8_BAR; PG8_WAIT_L(0); PG8_MMA(0, 1, At, B1); PG8_BAR;
            PG8_LDA(At, 1, 1); PG8_STAGE(PG8_SA(1, 0), a3, voffA);
            PG8_BAR; PG8_WAIT_L(0); PG8_MMA(1, 0, At, B0); PG8_BAR; PG8_SCHED;
            PG8_STAGE(PG8_SB(1, 1), b3 + hstepB, voffB);
            PG8_WAIT_V(6); PG8_BAR; PG8_MMA(1, 1, At, B1); PG8_BAR;
        }
        { unsigned z_ = 0u; asm volatile("" : "+s"(z_)); int l2_ = (int)__builtin_amdgcn_mbcnt_hi(~0u, __builtin_amdgcn_mbcnt_lo(~0u, z_)); asm volatile("" : "+v"(l2_));
          E(acc, cur, wr, wc, l2_ & 15, l2_ >> 4); }
        if (!has_next) break;
#pragma unroll
        for (int a = 0; a < 2; ++a)
#pragma unroll
            for (int b = 0; b < 2; ++b)
#pragma unroll
                for (int m = 0; m < 4; ++m)
#pragma unroll
                    for (int n = 0; n < 2; ++n) acc[a][b][m][n] = (f32x4){0.f, 0.f, 0.f, 0.f};
        cur = nxt; cA = nA; cB = nB; ++ui;
    }
    PG8_WAIT_V(0);
    if (wr == 0) PG8_BAR;
    PG8_BAR;
#undef PG8_SA
#undef PG8_SB
#undef PG8_STAGE
#undef d2_voffA
#undef d2_voffB
#undef PG8_LDA
#undef PG8_LDB
#undef PG8_HALF
#undef PG8_MMA
#undef PG8_WAIT_V
#undef PG8_WAIT_L
#undef PG8_BAR
#undef PG8_SCHED
}
}

typedef f32x4 AccT[2][2][4][2];

struct EpiInProj {
    static constexpr bool PERM = true;
    float* out; unsigned char* ws;
    DI void operator()(const AccT& acc, const pg8::Unit& u, int wr, int wc, int fr, int fq) const {
        const int pn = u.pn, r0 = u.pm * 256 + wr * 64 + fr, ct = wc * 32 + 8 * fq;
        const bool samp = u.pm >= 128;
        if (pn == 12) {
            if (wc == 0 && fq == 0) {
                float* DT = (float*)(ws + WS_DT);
#pragma unroll
                for (int ai = 0; ai < 2; ++ai)
#pragma unroll
                    for (int m = 0; m < 4; ++m) { const int row = r0 + ai * 128 + m * 16;
                        *(f32x4*)(DT + (size_t)row * 8) = acc[ai][0][m][0]; *(f32x4*)(DT + (size_t)row * 8 + 4) = acc[ai][0][m][1]; }
            }
            return;
        }
#pragma unroll
        for (int ai = 0; ai < 2; ++ai)
#pragma unroll
            for (int m = 0; m < 4; ++m) {
                const int row = r0 + ai * 128 + m * 16;
                const int rs = row - MP, sb = rs >> 5, st = rs & 31;
                const int pb = row >> 13, pt = row & 8191;
#pragma unroll
                for (int bj = 0; bj < 2; ++bj) {
                    const f32x4 v0 = acc[ai][bj][m][0], v1 = acc[ai][bj][m][1];
                    u32x4 w; w.x = pk2(v0[0], v0[1]); w.y = pk2(v0[2], v0[3]); w.z = pk2(v1[0], v1[1]); w.w = pk2(v1[2], v1[3]);
                    const int ctile = bj * 128 + ct;
                    if (pn < 2) {
                        *(u32x4*)((bf16_t*)(ws + WS_Q) + (size_t)row * 512 + pn * 256 + ctile) = w;
                    } else if (pn < 4) {
                        const int col = (pn - 2) * 256 + ctile;
                        if (!samp) {
                            *(u32x4*)((bf16_t*)(ws + WS_KP) + (size_t)row * 512 + col) = w;
                            if (pt >= 7680) { float* o = out + O_NKP + ((size_t)(pb * 512 + pt - 7680)) * 512 + col; *(f32x4*)o = v0; *(f32x4*)(o + 4) = v1; }
                        } else {
                            *(u32x4*)((bf16_t*)(ws + WS_KS) + ((size_t)sb * 544 + 512 + st) * 512 + col) = w;
                            float* o = out + O_NKS + (size_t)rs * 512 + col; *(f32x4*)o = v0; *(f32x4*)(o + 4) = v1;
                        }
                    } else if (pn < 6) {
                        const int col = (pn - 4) * 256 + ctile, head = col >> 6, d0 = col & 63;
                        bf16_t* vb; int t;
                        if (!samp) { t = pt; vb = (bf16_t*)(ws + WS_VFP) + ((size_t)(pb * 8 + head) * 512 + (t >> 4)) * 1024;
                            if (pt >= 7680) { float* o = out + O_NVP + ((size_t)(pb * 512 + pt - 7680)) * 512 + col; *(f32x4*)o = v0; *(f32x4*)(o + 4) = v1; } }
                        else { t = 512 + st; vb = (bf16_t*)(ws + WS_VFS) + ((size_t)(sb * 8 + head) * 34 + (t >> 4)) * 1024;
                            float* o = out + O_NVS + (size_t)rs * 512 + col; *(f32x4*)o = v0; *(f32x4*)(o + 4) = v1; }
                        const int tt = t & 15, hh = (tt >> 2) & 1, jj = ((tt >> 3) << 2) | (tt & 3);
                        bf16_t* p = vb + (hh * 64 + d0) * 8 + jj;
                        p[0] = (bf16_t)(w.x & 0xffff); p[8] = (bf16_t)(w.x >> 16); p[16] = (bf16_t)(w.y & 0xffff); p[24] = (bf16_t)(w.y >> 16);
                        p[32] = (bf16_t)(w.z & 0xffff); p[40] = (bf16_t)(w.z >> 16); p[48] = (bf16_t)(w.w & 0xffff); p[56] = (bf16_t)(w.w >> 16);
                    } else if (pn < 8) {
                        *(u32x4*)((bf16_t*)(ws + WS_Z) + (size_t)row * 512 + (pn - 6) * 256 + ctile) = w;
                    } else {
                        const int col = (pn - 8) * 256 + ctile;
                        *(u32x4*)((bf16_t*)(ws + WS_XBC) + (size_t)row * 1024 + col) = w;
                        if (!samp) { if (pt >= 8189) { float* o = out + O_SCP + ((size_t)(pb * 3 + pt - 8189)) * 1024 + col; *(f32x4*)o = v0; *(f32x4*)(o + 4) = v1; } }
                        else { if (st >= 29) { float* o = out + O_SCS + ((size_t)(sb * 3 + st - 29)) * 1024 + col; *(f32x4*)o = v0; *(f32x4*)(o + 4) = v1; } }
                    }
                }
            }
    }
};

struct EpiOutProj {
    static constexpr bool PERM = false;
    const float* xp; const float* xs; bf16_t* U;
    DI void operator()(const AccT& acc, const pg8::Unit& u, int wr, int wc, int fr, int fq) const {
        const int r0 = u.pm * 256 + wr * 64 + fr, c0 = u.pn * 256 + wc * 32 + 4 * fq;
#pragma unroll
        for (int ai = 0; ai < 2; ++ai) {
            f32x4 xv[4][2][2];
#pragma unroll
            for (int m = 0; m < 4; ++m) { const int row = r0 + ai * 128 + m * 16; const float* xr = (row < MP) ? xp + (size_t)row * 1024 : xs + (size_t)(row - MP) * 1024;
#pragma unroll
                for (int bj = 0; bj < 2; ++bj)
#pragma unroll
                    for (int n = 0; n < 2; ++n) xv[m][bj][n] = *(const f32x4*)(xr + c0 + bj * 128 + n * 16); }
#pragma unroll
            for (int m = 0; m < 4; ++m)
#pragma unroll
                for (int bj = 0; bj < 2; ++bj)
#pragma unroll
                    for (int n = 0; n < 2; ++n) pin(xv[m][bj][n]);
#pragma unroll
            for (int m = 0; m < 4; ++m) { const int row = r0 + ai * 128 + m * 16; bf16_t* ur = U + (size_t)row * 1024;
#pragma unroll
                for (int bj = 0; bj < 2; ++bj)
#pragma unroll
                    for (int n = 0; n < 2; ++n) { const f32x4 o = xv[m][bj][n] * ALPHA + acc[ai][bj][m][n];
                        u32x2 w; w.x = pk2(o[0], o[1]); w.y = pk2(o[2], o[3]); *(u32x2*)(ur + c0 + bj * 128 + n * 16) = w; } }
        }
    }
};
struct EpiDown {
    static constexpr bool PERM = false;
    const bf16_t* X1; bf16_t* U;
    DI void operator()(const AccT& acc, const pg8::Unit& u, int wr, int wc, int fr, int fq) const {
        const int r0 = u.pm * 256 + wr * 64 + fr, c0 = u.pn * 256 + wc * 32 + 4 * fq;
        u32x2 xw[2][4][2][2];
#pragma unroll
        for (int ai = 0; ai < 2; ++ai)
#pragma unroll
            for (int m = 0; m < 4; ++m) { const bf16_t* xr = X1 + (size_t)(r0 + ai * 128 + m * 16) * 1024;
#pragma unroll
                for (int bj = 0; bj < 2; ++bj)
#pragma unroll
                    for (int n = 0; n < 2; ++n) xw[ai][m][bj][n] = *(const u32x2*)(xr + c0 + bj * 128 + n * 16); }
#pragma unroll
        for (int ai = 0; ai < 2; ++ai)
#pragma unroll
            for (int m = 0; m < 4; ++m)
#pragma unroll
                for (int bj = 0; bj < 2; ++bj)
#pragma unroll
                    for (int n = 0; n < 2; ++n) pin(xw[ai][m][bj][n]);
#pragma unroll
        for (int ai = 0; ai < 2; ++ai)
#pragma unroll
            for (int m = 0; m < 4; ++m) { bf16_t* ur = U + (size_t)(r0 + ai * 128 + m * 16) * 1024;
#pragma unroll
                for (int bj = 0; bj < 2; ++bj)
#pragma unroll
                    for (int n = 0; n < 2; ++n) { const u32x2 w = xw[ai][m][bj][n];
                        const f32x4 xv = {bf_lo(w.x), bf_hi(w.x), bf_lo(w.y), bf_hi(w.y)}; const f32x4 o = xv * ALPHA + acc[ai][bj][m][n];
                        u32x2 wo; wo.x = pk2(o[0], o[1]); wo.y = pk2(o[2], o[3]); *(u32x2*)(ur + c0 + bj * 128 + n * 16) = wo; } }
    }
};

DI float dpp_shr1(float v) { return __builtin_bit_cast(float, __builtin_amdgcn_update_dpp(0, __builtin_bit_cast(int, v), 0x111, 0xf, 0xf, false)); }
template <bool SAMP> struct EpiUp {
    static constexpr bool PERM = true;
    unsigned char* G8; bf16_t* GS; const float* cw; const float* cb; const float* past; float* onf;
    DI void operator()(const AccT& acc, const pg8::Unit& u, int wr, int wc, int fr, int fq) const {
        const int colv = u.pn * 128 + wc * 32 + 8 * fq;
        int bb, tb; long grow0;
        if (!SAMP) { bb = u.pm / 33; const int ti = u.pm - bb * 33; tb = ti * 252 + wr * 126 + fr * 8 - 2; grow0 = (long)bb * 8192 + tb; }
        else { const int lg = wr * 16 + fr; bb = u.pm * 8 + (lg >> 2); tb = (lg & 3) * 8; grow0 = (long)bb * 32 + tb; }
        const bool first = SAMP ? ((fr & 3) == 0) : (fr == 0);
        const float asc = SAMP ? 1.0f : 1.0f / (SC_X1 * SC_WUP);
#pragma unroll
        for (int n = 0; n < 2; ++n) {
            const int cv = colv + 4 * n, cgt = DFF + cv;
            const f32x4 wv0 = *(const f32x4*)(cw + cv), wv1 = *(const f32x4*)(cw + NUP + cv), wv2 = *(const f32x4*)(cw + 2 * NUP + cv), bv = *(const f32x4*)(cb + cv);
            const f32x4 wg0 = *(const f32x4*)(cw + cgt), wg1 = *(const f32x4*)(cw + NUP + cgt), wg2 = *(const f32x4*)(cw + 2 * NUP + cgt), bg = *(const f32x4*)(cb + cgt);
            f32x4 hv[8], hg[8];
#pragma unroll
            for (int tau = 0; tau < 8; ++tau) { hv[tau] = acc[tau >> 2][0][tau & 3][n] * asc; hg[tau] = acc[tau >> 2][1][tau & 3][n] * asc; }
            if (SAMP) {
                if ((fr & 3) == 3) { float* o = onf + ((size_t)(bb * 2)) * NUP; *(f32x4*)(o + cv) = hv[6]; *(f32x4*)(o + cgt) = hg[6]; *(f32x4*)(o + NUP + cv) = hv[7]; *(f32x4*)(o + NUP + cgt) = hg[7]; }
            }
            if (!SAMP) { if (tb < 0) { hv[0] = (f32x4){0.f, 0.f, 0.f, 0.f}; hv[1] = hv[0]; hg[0] = hv[0]; hg[1] = hv[0]; } }
            f32x4 pv2, pv1, pg2, pg1;
#pragma unroll
            for (int j = 0; j < 4; ++j) { pv2[j] = dpp_shr1(hv[6][j]); pv1[j] = dpp_shr1(hv[7][j]); pg2[j] = dpp_shr1(hg[6][j]); pg1[j] = dpp_shr1(hg[7][j]); }
            if (SAMP) { if (first) { const float* ps = past + (size_t)bb * 2 * NUP; pv2 = *(const f32x4*)(ps + cv); pv1 = *(const f32x4*)(ps + NUP + cv); pg2 = *(const f32x4*)(ps + cgt); pg1 = *(const f32x4*)(ps + NUP + cgt); } }
#pragma unroll
            for (int tau = 0; tau < 8; ++tau) {
                const f32x4 a2v = (tau >= 2) ? hv[tau >= 2 ? tau - 2 : 0] : (tau == 0 ? pv2 : pv1);
                const f32x4 a1v = (tau >= 1) ? hv[tau >= 1 ? tau - 1 : 0] : pv1;
                const f32x4 a2g = (tau >= 2) ? hg[tau >= 2 ? tau - 2 : 0] : (tau == 0 ? pg2 : pg1);
                const f32x4 a1g = (tau >= 1) ? hg[tau >= 1 ? tau - 1 : 0] : pg1;
                const f32x4 ov = bv + wv0 * a2v + wv1 * a1v + wv2 * hv[tau];
                const f32x4 og = bg + wg0 * a2g + wg1 * a1g + wg2 * hg[tau];
                const float g0 = ov[0] * silu_f(og[0]), g1 = ov[1] * silu_f(og[1]), g2 = ov[2] * silu_f(og[2]), g3 = ov[3] * silu_f(og[3]);
                if (!SAMP) { const int t = tb + tau; const bool ok = (t >= 0) && (t < 8192) && (fr > 0 || tau >= 2);
                    const unsigned off = ok ? (unsigned)(((int)grow0 + tau) * DFF + cv) * 2u : (unsigned)((size_t)MP * DFF * 2) + (unsigned)(fr + 16 * fq) * 8u;
                    u32x2 w; w.x = pk2(g0, g1); w.y = pk2(g2, g3); *(u32x2*)(G8 + off) = w; }
                else { u32x2 w; w.x = pk2(g0, g1); w.y = pk2(g2, g3); *(u32x2*)(GS + (size_t)(grow0 + tau) * DFF + cv) = w; }
            }
        }
    }
};

DI f32x16 small_block_p(const bf16_t* xp, const bf16_t* wp, int K);
DI f32x16 small_block(const bf16_t* X, const bf16_t* Wt, int K, int row0, int col0, int lane) {
    const int r = lane & 31, h2 = lane >> 5;
    return small_block_p(X + (size_t)(row0 + r) * K + 8 * h2, Wt + (size_t)(col0 + r) * K + 8 * h2, K);
}
DI f32x16 small_block_p(const bf16_t* xp, const bf16_t* wp, int K) {
    f32x16 acc;
#pragma unroll
    for (int i = 0; i < 16; ++i) acc[i] = 0.f;
    int k0 = 0;
#pragma unroll 1
    for (; k0 + 256 <= K; k0 += 256) {
        bf16x8 a[16], b[16];
#pragma unroll
        for (int j = 0; j < 16; ++j) { a[j] = *(const bf16x8*)(wp + k0 + 16 * j); b[j] = *(const bf16x8*)(xp + k0 + 16 * j); }
#pragma unroll
        for (int j = 0; j < 16; ++j) { pin(a[j]); pin(b[j]); }
#pragma unroll
        for (int j = 0; j < 16; ++j) acc = MFMA32(a[j], b[j], acc);
    }
    if (k0 < K) {
        bf16x8 a[8], b[8];
#pragma unroll
        for (int j = 0; j < 8; ++j) { a[j] = *(const bf16x8*)(wp + k0 + 16 * j); b[j] = *(const bf16x8*)(xp + k0 + 16 * j); }
#pragma unroll
        for (int j = 0; j < 8; ++j) { pin(a[j]); pin(b[j]); }
#pragma unroll
        for (int j = 0; j < 8; ++j) acc = MFMA32(a[j], b[j], acc);
    }
    return acc;
}
DI void small_inproj(KP P) {
    int tid = threadIdx.x; asm volatile("" : "+v"(tid));
    const int lane = tid & 63, wave = tid >> 6, gw = blockIdx.x * 8 + wave, NGW = gridDim.x * 8, r = lane & 31, h2 = lane >> 5;
    const bf16_t* XB = (const bf16_t*)(P->ws + WS_XB); const bf16_t* WI = (const bf16_t*)(P->ws + WS_WIN);
    float* DT = (float*)(P->ws + WS_DT); float* out = P->out;
    for (int task = gw; task < 1024 + 16 * 97; task += NGW) {
        if (task < 1024) {
            const f32x16 acc = small_block(XB, WI, 1024, task * 32, 3072, lane);
            *(f32x4*)(DT + (size_t)(task * 32 + r) * 8 + 4 * h2) = (f32x4){acc[0], acc[1], acc[2], acc[3]};
            continue;
        }
        const int t2 = task - 1024, sb = t2 / 97, cb = t2 - sb * 97, row = MP + sb * 32 + r, col0 = cb * 32;
        const f32x16 acc = small_block(XB, WI, 1024, MP + sb * 32, col0, lane);
#pragma unroll
        for (int g = 0; g < 4; ++g) {
            const int col = col0 + 8 * g + 4 * h2; const f32x4 v = {acc[4 * g], acc[4 * g + 1], acc[4 * g + 2], acc[4 * g + 3]};
            u32x2 w; w.x = pk2(v[0], v[1]); w.y = pk2(v[2], v[3]);
            if (col < 512) *(u32x2*)((bf16_t*)(P->ws + WS_Q) + (size_t)row * 512 + col) = w;
            else if (col < 1024) { *(u32x2*)((bf16_t*)(P->ws + WS_KS) + ((size_t)sb * 544 + 512 + r) * 512 + col - 512) = w; *(f32x4*)(out + O_NKS + (size_t)(sb * 32 + r) * 512 + col - 512) = v; }
            else if (col < 1536) { const int c = col - 1024, head = c >> 6, d0 = c & 63, t = 512 + r, tt = t & 15, hh = (tt >> 2) & 1, jj = ((tt >> 3) << 2) | (tt & 3);
                bf16_t* p = (bf16_t*)(P->ws + WS_VFS) + ((size_t)(sb * 8 + head) * 34 + (t >> 4)) * 1024 + (hh * 64 + d0) * 8 + jj;
                p[0] = (bf16_t)(w.x & 0xffff); p[8] = (bf16_t)(w.x >> 16); p[16] = (bf16_t)(w.y & 0xffff); p[24] = (bf16_t)(w.y >> 16);
                *(f32x4*)(out + O_NVS + (size_t)(sb * 32 + r) * 512 + c) = v; }
            else if (col < 2048) *(u32x2*)((bf16_t*)(P->ws + WS_Z) + (size_t)row * 512 + col - 1536) = w;
            else if (col < 3072) { *(u32x2*)((bf16_t*)(P->ws + WS_XBC) + (size_t)row * 1024 + col - 2048) = w;
                if (r >= 29) *(f32x4*)(out + O_SCS + ((size_t)(sb * 3 + r - 29)) * 1024 + col - 2048) = v; }
            else if (col < 3080) *(f32x4*)(DT + (size_t)row * 8 + col - 3072) = v;
        }
    }
}
DI void small_down_splitk(KP P, LAS unsigned char* lds, int tid_in) {
    int tid = tid_in; asm volatile("" : "+v"(tid));
    const int lane = tid & 63, wave = __builtin_amdgcn_readfirstlane(tid >> 6), r = lane & 31, h2 = lane >> 5;
    const int tl = wave / 3, kq = wave - 3 * tl;
    const bf16_t* X = (const bf16_t*)(P->ws + WS_GS); const bf16_t* Wt = (const bf16_t*)(P->ws + WS_WDOWN);
    LAS float* part = (LAS float*)lds;
    for (int pair = blockIdx.x; pair < 256; pair += gridDim.x) {
        const int task = pair * 2 + tl, sb = task >> 5, cb = task & 31, col0 = cb * 32;
        __syncthreads();
        if (tl < 2) {
            const f32x16 acc = small_block_p(X + (size_t)(sb * 32 + r) * DFF + kq * 896 + 8 * h2, Wt + (size_t)(col0 + r) * DFF + kq * 896 + 8 * h2, 896);
#pragma unroll
            for (int i = 0; i < 16; ++i) part[((tl * 3 + kq) * 16 + i) * 64 + lane] = acc[i];
        }
        __syncthreads();
        if (tl < 2 && kq == 0) {
            const int row = MP + sb * 32 + r;
#pragma unroll
            for (int g = 0; g < 4; ++g) {
                f32x4 v;
#pragma unroll
                for (int e = 0; e < 4; ++e) { const int i = 4 * g + e; v[e] = part[((tl * 3 + 0) * 16 + i) * 64 + lane] + part[((tl * 3 + 1) * 16 + i) * 64 + lane] + part[((tl * 3 + 2) * 16 + i) * 64 + lane]; }
                const int col = col0 + 8 * g + 4 * h2;
                const u32x2 w = *(const u32x2*)((const bf16_t*)(P->ws + WS_XB) + (size_t)row * 1024 + col); const f32x4 xv = {bf_lo(w.x), bf_hi(w.x), bf_lo(w.y), bf_hi(w.y)};
                const f32x4 o = xv * ALPHA + v; u32x2 wo; wo.x = pk2(o[0], o[1]); wo.y = pk2(o[2], o[3]);
                *(u32x2*)((bf16_t*)(P->ws + WS_A2) + (size_t)row * 1024 + col) = wo;
            }
        }
    }
}
DI void small_out_splitk(KP P, LAS unsigned char* lds, int tid_in) {
    int tid = tid_in; asm volatile("" : "+v"(tid));
    const int lane = tid & 63, wave = __builtin_amdgcn_readfirstlane(tid >> 6), r = lane & 31, h2 = lane >> 5;
    const int tl = wave >> 2, kq = wave & 3;
    const bf16_t* X = (const bf16_t*)(P->ws + WS_A2); const bf16_t* Wt = (const bf16_t*)(P->ws + WS_WOUT);
    LAS float* part = (LAS float*)lds;
    for (int pair = blockIdx.x; pair < 256; pair += gridDim.x) {
        const int task = pair * 2 + tl, sb = task >> 5, cb = task & 31, col0 = cb * 32;
        __syncthreads();
        const f32x16 acc = small_block_p(X + (size_t)(MP + sb * 32 + r) * 1024 + kq * 256 + 8 * h2, Wt + (size_t)(col0 + r) * 1024 + kq * 256 + 8 * h2, 256);
#pragma unroll
        for (int i = 0; i < 16; ++i) part[((tl * 4 + kq) * 16 + i) * 64 + lane] = acc[i];
        __syncthreads();
        if (kq == 0) {
            const int row = MP + sb * 32 + r;
#pragma unroll
            for (int g = 0; g < 4; ++g) {
                f32x4 v;
#pragma unroll
                for (int e = 0; e < 4; ++e) { const int i = 4 * g + e; v[e] = (part[((tl * 4 + 0) * 16 + i) * 64 + lane] + part[((tl * 4 + 1) * 16 + i) * 64 + lane]) + (part[((tl * 4 + 2) * 16 + i) * 64 + lane] + part[((tl * 4 + 3) * 16 + i) * 64 + lane]); }
                const int col = col0 + 8 * g + 4 * h2;
                const f32x4 xv = *(const f32x4*)(P->in[1] + (size_t)(row - MP) * 1024 + col);
                const f32x4 o = xv * ALPHA + v; u32x2 wo; wo.x = pk2(o[0], o[1]); wo.y = pk2(o[2], o[3]);
                *(u32x2*)((bf16_t*)(P->out + O_Y) + (size_t)row * 1024 + col) = wo;
            }
        }
    }
}
DI void small_ffnconv_prompt(KP P, LAS unsigned char* lds, int tid_in) {
    int tid = tid_in; asm volatile("" : "+v"(tid));
    const int lane = tid & 63, kq = __builtin_amdgcn_readfirstlane(tid >> 6), r = lane & 31, h2 = lane >> 5;
    const bf16_t* X1 = (const bf16_t*)(P->ws + WS_XB); const bf16_t* WU = (const bf16_t*)(P->ws + WS_WUP);
    const int rr = r & 7, b = rr >> 1, t = 8190 + (rr & 1);
    LAS float* part = (LAS float*)lds;
    for (int task = blockIdx.x; task < 168; task += gridDim.x) {
        const int rho0 = task * 32, n0 = ((rho0 >> 7) & 1) * DFF + (rho0 >> 8) * 128 + (rho0 & 127);
        __syncthreads();
        const f32x16 acc = small_block_p(X1 + ((size_t)b * 8192 + t) * 1024 + kq * 128 + 8 * h2, WU + (size_t)(rho0 + r) * 1024 + kq * 128 + 8 * h2, 128);
#pragma unroll
        for (int i = 0; i < 16; ++i) part[(kq * 16 + i) * 64 + lane] = acc[i];
        __syncthreads();
        if (kq == 0 && r < 8) {
#pragma unroll
            for (int g = 0; g < 4; ++g) { f32x4 v;
#pragma unroll
                for (int e = 0; e < 4; ++e) { float s = 0.f;
#pragma unroll
                    for (int q = 0; q < 8; ++q) s += part[(q * 16 + 4 * g + e) * 64 + lane];
                    v[e] = s; }
                *(f32x4*)(P->out + O_FCP + (size_t)(b * 2 + (rr & 1)) * NUP + n0 + 8 * g + 4 * h2) = v; }
        }
    }
}
template <bool DOWN> DI void small_resid(KP P, int tid_in) {
    int tid = tid_in; asm volatile("" : "+v"(tid));
    const int lane = tid & 63, wave = tid >> 6, gw = blockIdx.x * 8 + wave, NGW = gridDim.x * 8, r = lane & 31, h2 = lane >> 5;
    const bf16_t* X = DOWN ? (const bf16_t*)(P->ws + WS_GS) - (size_t)MP * DFF : (const bf16_t*)(P->ws + WS_A2); const bf16_t* Wt = (const bf16_t*)(P->ws + (DOWN ? WS_WDOWN : WS_WOUT));
    const int K = DOWN ? DFF : 1024;
    for (int task = gw; task < 512; task += NGW) {
        const int sb = task >> 5, cb = task & 31, row = MP + sb * 32 + r, col0 = cb * 32;
        const f32x16 acc = small_block(X, Wt, K, MP + sb * 32, col0, lane);
#pragma unroll
        for (int g = 0; g < 4; ++g) {
            const int col = col0 + 8 * g + 4 * h2; const f32x4 v = {acc[4 * g], acc[4 * g + 1], acc[4 * g + 2], acc[4 * g + 3]};
            f32x4 xv;
            if (DOWN) { const u32x2 w = *(const u32x2*)((const bf16_t*)(P->ws + WS_XB) + (size_t)row * 1024 + col); xv = (f32x4){bf_lo(w.x), bf_hi(w.x), bf_lo(w.y), bf_hi(w.y)}; }
            else xv = *(const f32x4*)(P->in[1] + (size_t)(row - MP) * 1024 + col);
            bf16_t* U = DOWN ? (bf16_t*)(P->ws + WS_A2) : (bf16_t*)(P->out + O_Y);
            const f32x4 o = xv * ALPHA + v; u32x2 wo; wo.x = pk2(o[0], o[1]); wo.y = pk2(o[2], o[3]); *(u32x2*)(U + (size_t)row * 1024 + col) = wo;
        }
    }
}

DI void p0_transpose_item(const float* W, int K, int N, bf16_t* WT, int drow0, LAS float* scr, int k0, int n0, int lane) {
    const int nn = n0 + (lane & 31); const int nc = (nn < N) ? nn : N - 1;
    float tv[32];
#pragma unroll
    for (int i = 0; i < 32; ++i) tv[i] = W[(size_t)(k0 + 2 * i + (lane >> 5)) * N + nc];
#pragma unroll
    for (int i = 0; i < 32; ++i) scr[(2 * i + (lane >> 5)) * 33 + (lane & 31)] = tv[i];
    asm volatile("s_waitcnt lgkmcnt(0)" ::: "memory");
    const int c = lane & 7;
#pragma unroll
    for (int j = 0; j < 4; ++j) { const int n = (lane >> 3) + 8 * j; const LAS float* s = scr + (8 * c) * 33 + n;
        u32x4 o; o.x = pk2(s[0 * 33], s[1 * 33]); o.y = pk2(s[2 * 33], s[3 * 33]); o.z = pk2(s[4 * 33], s[5 * 33]); o.w = pk2(s[6 * 33], s[7 * 33]);
        if (n0 + n < N) *(u32x4*)(WT + (size_t)(drow0 + n) * K + k0 + 8 * c) = o; }
    asm volatile("s_waitcnt lgkmcnt(0)" ::: "memory");
}
DI void p0_transpose_item_f8(const float* W, int K, int N, unsigned char* WT, int pitch, int drow0, LAS float* scr, int k0, int n0, int lane, float sc) {
    const int nn = n0 + (lane & 31); const int nc = (nn < N) ? nn : N - 1;
    float tv[32];
#pragma unroll
    for (int i = 0; i < 32; ++i) tv[i] = W[(size_t)(k0 + 2 * i + (lane >> 5)) * N + nc];
#pragma unroll
    for (int i = 0; i < 32; ++i) scr[(2 * i + (lane >> 5)) * 33 + (lane & 31)] = tv[i] * sc;
    asm volatile("s_waitcnt lgkmcnt(0)" ::: "memory");
    const int c = lane & 7;
#pragma unroll
    for (int j = 0; j < 4; ++j) { const int n = (lane >> 3) + 8 * j; const LAS float* s = scr + (8 * c) * 33 + n;
        u32x2 o; o.x = pk4_f8(s[0 * 33], s[1 * 33], s[2 * 33], s[3 * 33]); o.y = pk4_f8(s[4 * 33], s[5 * 33], s[6 * 33], s[7 * 33]);
        if (n0 + n < N) *(u32x2*)(WT + (size_t)(drow0 + n) * pitch + k0 + 8 * c) = o; }
    asm volatile("s_waitcnt lgkmcnt(0)" ::: "memory");
}
constexpr int LATE_ITEMS = 16 * 32 + 16 * 168 + 42 * 32, LATE_WG_ITEMS = LATE_ITEMS / 64;
DI void convert_late_item(KP P, LAS unsigned char* lds, int wi) {
    int tid = threadIdx.x; asm volatile("" : "+v"(tid));
    const int lane = tid & 63, wave = tid >> 6;
    __syncthreads();
    LAS float* scr = (LAS float*)(lds + wave * 8448);
    constexpr int I_OUT = 16 * 32, I_UP = 16 * 168;
#pragma unroll 1
    for (int j = 0; j < 8; ++j) {
        int r = wi * 64 + wave * 8 + j;
        if (r < I_OUT) { const int kb = r / 32, nb = r % 32; p0_transpose_item(P->in[16], 1024, 1024, (bf16_t*)(P->ws + WS_WOUT), nb * 32, scr, kb * 64, nb * 32, lane); continue; } r -= I_OUT;
        if (r < I_UP) { const int kb = r / 168, nb = r % 168; const int n0 = nb * 32; const int np = (n0 < DFF) ? n0 : n0 - DFF;
            const int drow = (np >> 7) * 256 + ((n0 < DFF) ? 0 : 128) + (np & 127);
            p0_transpose_item(P->in[19], 1024, NUP, (bf16_t*)(P->ws + WS_WUP), drow, scr, kb * 64, n0, lane);
            p0_transpose_item_f8(P->in[19], 1024, NUP, P->ws + WS_WUP8, 1024, drow, scr, kb * 64, n0, lane, SC_WUP); continue; } r -= I_UP;
        { const int kb = r / 32, nb = r % 32; p0_transpose_item(P->in[22], DFF, 1024, (bf16_t*)(P->ws + WS_WDOWN), nb * 32, scr, kb * 64, nb * 32, lane); }
    }
}
DI void phase_convert(KP P, LAS unsigned char* lds) {
    int tid = threadIdx.x; asm volatile("" : "+v"(tid));
    const int lane = tid & 63, wave = tid >> 6, G = gridDim.x;
    LAS float* scr = (LAS float*)(lds + wave * 8448);
    const int gw = blockIdx.x * 8 + wave, NGW = G * 8;
    constexpr int I_IN = 16 * 97;
    for (int it = gw; it < I_IN; it += NGW) { const int kb = it / 97, nb = it % 97; p0_transpose_item(P->in[7], 1024, NIN, (bf16_t*)(P->ws + WS_WIN), nb * 32, scr, kb * 64, nb * 32, lane); }
    const size_t gt = (size_t)blockIdx.x * NT + tid, NGT = (size_t)G * NT;
    { bf16_t* XB = (bf16_t*)(P->ws + WS_XB);
      constexpr size_t NCH = (size_t)MT * 128;
      size_t i0 = gt;
      for (; i0 + 3 * NGT < NCH; i0 += 4 * NGT) {
          f32x4 a[4], b[4];
#pragma unroll
          for (int u = 0; u < 4; ++u) { const size_t e = (i0 + u * NGT) * 8; const float* src = (e < (size_t)MP * 1024) ? P->in[0] + e : P->in[1] + (e - (size_t)MP * 1024);
              a[u] = *(const f32x4*)src; b[u] = *(const f32x4*)(src + 4); }
#pragma unroll
          for (int u = 0; u < 4; ++u) { pin(a[u]); pin(b[u]); }
#pragma unroll
          for (int u = 0; u < 4; ++u) { u32x4 w; w.x = pk2(a[u][0], a[u][1]); w.y = pk2(a[u][2], a[u][3]); w.z = pk2(b[u][0], b[u][1]); w.w = pk2(b[u][2], b[u][3]); *(u32x4*)(XB + (i0 + u * NGT) * 8) = w; }
      }
      for (; i0 < NCH; i0 += NGT) { const size_t e = i0 * 8; const float* src = (e < (size_t)MP * 1024) ? P->in[0] + e : P->in[1] + (e - (size_t)MP * 1024);
          const f32x4 a = *(const f32x4*)src, b = *(const f32x4*)(src + 4); u32x4 w; w.x = pk2(a[0], a[1]); w.y = pk2(a[2], a[3]); w.z = pk2(b[0], b[1]); w.w = pk2(b[2], b[3]); *(u32x4*)(XB + e) = w; }
    }
    { bf16_t* WI = (bf16_t*)(P->ws + WS_WIN) + (size_t)NIN * 1024;
      for (size_t i = gt; i < (size_t)(NINP - NIN) * 128; i += NGT) *(u32x4*)(WI + i * 8) = (u32x4){0u, 0u, 0u, 0u}; }
    { bf16_t* KS = (bf16_t*)(P->ws + WS_KS); bf16_t* VF = (bf16_t*)(P->ws + WS_VFS);
      for (size_t i = gt; i < (size_t)16 * 512 * 64; i += NGT) {
          const int cgp = (int)(i & 63), t = (int)((i >> 6) & 511), b = (int)(i >> 15);
          const float* ks = P->in[2] + ((size_t)(b * 512 + t)) * 512 + cgp * 8; const float* vs = P->in[3] + ((size_t)(b * 512 + t)) * 512 + cgp * 8;
          const f32x4 a = *(const f32x4*)ks, c = *(const f32x4*)(ks + 4); u32x4 w; w.x = pk2(a[0], a[1]); w.y = pk2(a[2], a[3]); w.z = pk2(c[0], c[1]); w.w = pk2(c[2], c[3]);
          *(u32x4*)(KS + ((size_t)b * 544 + t) * 512 + cgp * 8) = w;
          const f32x4 va = *(const f32x4*)vs, vc = *(const f32x4*)(vs + 4);
          const int head = cgp >> 3, d0 = (cgp & 7) * 8, tt = t & 15, hh = (tt >> 2) & 1, jj = ((tt >> 3) << 2) | (tt & 3);
          bf16_t* p = VF + ((size_t)(b * 8 + head) * 34 + (t >> 4)) * 1024 + (hh * 64 + d0) * 8 + jj;
          const unsigned w0 = pk2(va[0], va[1]), w1 = pk2(va[2], va[3]), w2 = pk2(vc[0], vc[1]), w3 = pk2(vc[2], vc[3]);
          p[0] = (bf16_t)(w0 & 0xffff); p[8] = (bf16_t)(w0 >> 16); p[16] = (bf16_t)(w1 & 0xffff); p[24] = (bf16_t)(w1 >> 16);
          p[32] = (bf16_t)(w2 & 0xffff); p[40] = (bf16_t)(w2 >> 16); p[48] = (bf16_t)(w3 & 0xffff); p[56] = (bf16_t)(w3 >> 16);
      } }
}

template <bool OUT_BF16>
DI void phase_ln(const bf16_t* src, const float* gam, const float* bet, void* dst, unsigned char* dst8, unsigned char* g8pad, int tid_in) {
    int tid = tid_in; asm volatile("" : "+v"(tid));
    const int lane = tid & 63, wave = tid >> 6, gw = blockIdx.x * 8 + wave, NGW = gridDim.x * 8;
    f32x4 g4[4], b4[4];
#pragma unroll
    for (int j = 0; j < 4; ++j) { g4[j] = *(const f32x4*)(gam + (lane + 64 * j) * 4); b4[j] = *(const f32x4*)(bet + (lane + 64 * j) * 4); }
    for (int row0 = gw; row0 < MT; row0 += 2 * NGW) {
        u32x2 wv[2][4];
#pragma unroll
        for (int u = 0; u < 2; ++u) { const int row = row0 + u * NGW;
#pragma unroll
            for (int j = 0; j < 4; ++j) { wv[u][j] = (u32x2){0u, 0u}; if (row < MT) wv[u][j] = *(const u32x2*)(src + (size_t)row * 1024 + (lane + 64 * j) * 4); } }
#pragma unroll
        for (int u = 0; u < 2; ++u) { const int row = row0 + u * NGW; if (row >= MT) continue;
            f32x4 v[4]; float s = 0.f;
#pragma unroll
            for (int j = 0; j < 4; ++j) { const u32x2 w = wv[u][j]; v[j] = (f32x4){bf_lo(w.x), bf_hi(w.x), bf_lo(w.y), bf_hi(w.y)}; s += (v[j][0] + v[j][1]) + (v[j][2] + v[j][3]); }
#pragma unroll
            for (int o = 1; o < 64; o <<= 1) s += __shfl_xor(s, o);
            const float mean = s * (1.f / 1024.f); float q = 0.f;
#pragma unroll
            for (int j = 0; j < 4; ++j) { v[j] = v[j] - mean; q += (v[j][0] * v[j][0] + v[j][1] * v[j][1]) + (v[j][2] * v[j][2] + v[j][3] * v[j][3]); }
#pragma unroll
            for (int o = 1; o < 64; o <<= 1) q += __shfl_xor(q, o);
            const float rstd = 1.0f / sqrtf(q * (1.f / 1024.f) + 1e-5f);
#pragma unroll
            for (int j = 0; j < 4; ++j) { const f32x4 o = v[j] * rstd * g4[j] + b4[j];
                if (OUT_BF16) { u32x2 w; w.x = pk2(o[0], o[1]); w.y = pk2(o[2], o[3]); *(u32x2*)((bf16_t*)dst + (size_t)row * 1024 + (lane + 64 * j) * 4) = w;
                    *(unsigned*)(dst8 + (size_t)row * 1024 + (lane + 64 * j) * 4) = pk4_f8(o[0] * SC_X1, o[1] * SC_X1, o[2] * SC_X1, o[3] * SC_X1); }
                else *(f32x4*)((float*)dst + (size_t)row * 1024 + (lane + 64 * j) * 4) = o; }
        }
    }
}

constexpr int XCS = 2080;
constexpr int L_DT = 64 * XCS;
constexpr int L_AC = L_DT + 2048;
constexpr int L_RED = L_AC + 2048;

DI float ssd_dt_scan(KP P, LAS unsigned char* lds, int r0, int Lv, int h, int lane) {
    const float* DT = (const float*)(P->ws + WS_DT);
    float dt = 0.f;
    if (lane < Lv) { const float x = DT[(size_t)(r0 + lane) * 8 + h] + P->in[12][h]; dt = (x > 20.f) ? x : log1pf(expf(x)); }
    const float A = -expf(P->in[13][h]);
    float a = dt * A;
#pragma unroll
    for (int off = 1; off < 64; off <<= 1) { const float v = __shfl_up(a, off); if (lane >= off) a += v; }
    ((LAS float*)(lds + L_DT))[h * 64 + lane] = dt;
    ((LAS float*)(lds + L_AC))[h * 64 + lane] = a;
    return __shfl(a, 63);
}
template <bool DEC, int NCG>
DI void ssd_conv_to_lds(KP P, LAS unsigned char* lds, int tid, int r0, int Lv, bool samp, int sb, bool has_prev) {
    const int tblk = tid >> 7, cgp = tid & 127;
    if (cgp >= NCG) return;
    const int ch0 = cgp * 8, t0 = tblk * 16;
    const bf16_t* XBC = (const bf16_t*)(P->ws + WS_XBC);
    const float* cwp = P->in[10]; const float* cbp = P->in[11];
    float w[4][8], bias[8];
#pragma unroll
    for (int k = 0; k < 4; ++k) { const f32x4 a = *(const f32x4*)(cwp + k * 1024 + ch0), b = *(const f32x4*)(cwp + k * 1024 + ch0 + 4);
#pragma unroll
        for (int e = 0; e < 4; ++e) { w[k][e] = a[e]; w[k][4 + e] = b[e]; } }
    { const f32x4 a = *(const f32x4*)(cbp + ch0), b = *(const f32x4*)(cbp + ch0 + 4);
#pragma unroll
        for (int e = 0; e < 4; ++e) { bias[e] = a[e]; bias[4 + e] = b[e]; } }
    u32x4 raw[19]; f32x4 pa[3], pb[3];
    const bool halo_f32 = samp && (t0 == 0);
#pragma unroll
    for (int k = 0; k < 19; ++k) {
        const int tt = t0 - 3 + k;
        raw[k] = (u32x4){0u, 0u, 0u, 0u};
        if (tt >= 0) { if (tt < Lv) raw[k] = *(const u32x4*)(XBC + (size_t)(r0 + tt) * 1024 + ch0); }
        else if (!samp && has_prev) raw[k] = *(const u32x4*)(XBC + (size_t)(r0 + tt) * 1024 + ch0);
    }
#pragma unroll
    for (int k = 0; k < 3; ++k) { pa[k] = (f32x4){0.f, 0.f, 0.f, 0.f}; pb[k] = pa[k];
        if (halo_f32) { const float* s = P->in[5] + ((size_t)(sb * 3 + k)) * 1024 + ch0; pa[k] = *(const f32x4*)s; pb[k] = *(const f32x4*)(s + 4); } }
    float xw[3][8];
#pragma unroll
    for (int k = 0; k < 3; ++k) {
        const u32x4 q = raw[k];
        xw[k][0] = bf_lo(q.x); xw[k][1] = bf_hi(q.x); xw[k][2] = bf_lo(q.y); xw[k][3] = bf_hi(q.y); xw[k][4] = bf_lo(q.z); xw[k][5] = bf_hi(q.z); xw[k][6] = bf_lo(q.w); xw[k][7] = bf_hi(q.w);
        if (halo_f32) {
#pragma unroll
            for (int e = 0; e < 4; ++e) { xw[k][e] = pa[k][e]; xw[k][4 + e] = pb[k][e]; } }
    }
    const int head = cgp >> 3;
    const LAS float* sdt = (const LAS float*)(lds + L_DT) + head * 64; const LAS float* sac = (const LAS float*)(lds + L_AC) + head * 64;
    const float atot = (cgp < 64) ? sac[63] : 0.f;
#pragma unroll
    for (int i = 0; i < 16; ++i) {
        const int t = t0 + i; float xc[8];
        { const u32x4 q = raw[3 + i];
          xc[0] = bf_lo(q.x); xc[1] = bf_hi(q.x); xc[2] = bf_lo(q.y); xc[3] = bf_hi(q.y); xc[4] = bf_lo(q.z); xc[5] = bf_hi(q.z); xc[6] = bf_lo(q.w); xc[7] = bf_hi(q.w); }
        float f = 1.f;
        if (cgp < 64) { f = sdt[t]; if (DEC) f *= __builtin_amdgcn_exp2f((atot - sac[t]) * LOG2E); }
        if (t >= Lv) f = 0.f;
        float o[8];
#pragma unroll
        for (int e = 0; e < 8; ++e) { const float v = bias[e] + w[0][e] * xw[0][e] + w[1][e] * xw[1][e] + w[2][e] * xw[2][e] + w[3][e] * xc[e]; o[e] = silu_f(v) * f; }
        u32x4 q; q.x = pk2(o[0], o[1]); q.y = pk2(o[2], o[3]); q.z = pk2(o[4], o[5]); q.w = pk2(o[6], o[7]);
        *(LAS u32x4*)(lds + t * XCS + ch0 * 2) = q;
#pragma unroll
        for (int e = 0; e < 8; ++e) { xw[0][e] = xw[1][e]; xw[1][e] = xw[2][e]; xw[2][e] = xc[e]; }
    }
}
DI void chunk_geom(int ch, bool& samp, int& sb, int& r0, int& Lv, bool& has_prev) {
    samp = ch >= 512; sb = ch - 512;
    if (!samp) { r0 = ch * 64; Lv = 64; has_prev = (ch & 127) != 0; } else { r0 = MP + sb * 32; Lv = 32; has_prev = false; }
}
DI void ssd_states_tile(KP P, LAS unsigned char* lds, int ch) {
    int tid = threadIdx.x; asm volatile("" : "+v"(tid));
    const int lane = tid & 63, h = __builtin_amdgcn_readfirstlane(tid >> 6);
    bool samp, has_prev; int sb, r0, Lv; chunk_geom(ch, samp, sb, r0, Lv, has_prev);
    __syncthreads();
    const float atot = ssd_dt_scan(P, lds, r0, Lv, h, lane);
    if (lane == 0) ((float*)(P->ws + WS_DEC))[ch * 8 + h] = expf(atot);
    __syncthreads();
    ssd_conv_to_lds<true, 96>(P, lds, tid, r0, Lv, samp, sb, has_prev);
    __syncthreads();
    const int r = lane & 31, h2 = lane >> 5, blk = (lane >> 4) & 1, i16 = lane & 15, q = i16 >> 2, pp = i16 & 3, g = h >> 2;
    bf16_t* ST = (bf16_t*)(P->ws + WS_ST) + ((size_t)ch * 8 + h) * 8192;
#pragma unroll 1
    for (int nh = 0; nh < 2; ++nh) {
        f32x16 acc[2][2];
#pragma unroll
        for (int a = 0; a < 2; ++a)
#pragma unroll
            for (int b = 0; b < 2; ++b)
#pragma unroll
                for (int i = 0; i < 16; ++i) acc[a][b][i] = 0.f;
#pragma unroll
        for (int sp = 0; sp < 4; ++sp) {
            LAS unsigned char* rlo = lds + (16 * sp + 8 * h2 + q) * XCS + (16 * blk + 4 * pp) * 2;
            LAS unsigned char* rhi = rlo + 4 * XCS;
            bf16x8 af[2], bfr[2];
#pragma unroll
            for (int pb = 0; pb < 2; ++pb) af[pb] = tr_frag(rlo + (h * 64 + 32 * pb) * 2, rhi + (h * 64 + 32 * pb) * 2);
#pragma unroll
            for (int nb = 0; nb < 2; ++nb) bfr[nb] = tr_frag(rlo + (512 + g * 128 + 64 * nh + 32 * nb) * 2, rhi + (512 + g * 128 + 64 * nh + 32 * nb) * 2);
#pragma unroll
            for (int pb = 0; pb < 2; ++pb)
#pragma unroll
                for (int nb = 0; nb < 2; ++nb) acc[pb][nb] = MFMA32(af[pb], bfr[nb], acc[pb][nb]);
        }
#pragma unroll
        for (int pb = 0; pb < 2; ++pb)
#pragma unroll
            for (int nb = 0; nb < 2; ++nb) {
                bf16_t* sp_ = ST + (32 * pb + 4 * h2) * 128 + 64 * nh + 32 * nb + r;
#pragma unroll
                for (int i = 0; i < 16; ++i) sp_[((i & 3) + 8 * (i >> 2)) * 128] = (bf16_t)(pk2(acc[pb][nb][i], 0.f) & 0xffff);
            }
    }
}
DI void phase_scan(KP P, LAS unsigned char* lds) {
    int tid = threadIdx.x; asm volatile("" : "+v"(tid));
    unsigned* ST = (unsigned*)(P->ws + WS_ST); const float* DEC = (const float*)(P->ws + WS_DEC);
    LAS float* sdec = (LAS float*)lds;
    for (int blk = blockIdx.x; blk < 256; blk += gridDim.x) {
        const int b = blk >> 6, h = (blk >> 3) & 7, rem = (blk & 63) * 512 + tid;
        __syncthreads();
        if (tid < 128) sdec[tid] = DEC[(b * 128 + tid) * 8 + h];
        __syncthreads();
        float H0 = 0.f, H1 = 0.f;
        unsigned* sp = ST + (size_t)b * 128 * 32768 + rem;
#pragma unroll 1
        for (int c0 = 0; c0 < 128; c0 += 64) {
            unsigned w[64];
#pragma unroll
            for (int k = 0; k < 64; ++k) w[k] = sp[(size_t)(c0 + k) * 32768];
#pragma unroll
            for (int k = 0; k < 64; ++k) { const float d = sdec[c0 + k]; sp[(size_t)(c0 + k) * 32768] = pk2(H0, H1); H0 = H0 * d + bf_lo(w[k]); H1 = H1 * d + bf_hi(w[k]); }
        }
        *(f32x2*)(P->out + O_SSP + ((size_t)blk * 512 + tid) * 2) = (f32x2){H0, H1};
    }
}
DI void phase_sample_state(KP P) {
    int tid = threadIdx.x; asm volatile("" : "+v"(tid));
    const size_t gt = (size_t)blockIdx.x * NT + tid, NGT = (size_t)gridDim.x * NT;
    const unsigned* ST = (const unsigned*)(P->ws + WS_ST); const float* DEC = (const float*)(P->ws + WS_DEC);
    for (size_t pr0 = gt; pr0 < 524288; pr0 += 4 * NGT) {
        f32x2 h0[4]; unsigned w[4]; float d[4];
#pragma unroll
        for (int u = 0; u < 4; ++u) { const size_t pr = pr0 + u * NGT; h0[u] = (f32x2){0.f, 0.f}; w[u] = 0u; d[u] = 0.f;
            if (pr < 524288) { const int b = (int)(pr >> 15), rem = (int)(pr & 32767), h = rem >> 12, chq = 512 + b;
                h0[u] = *(const f32x2*)(P->in[4] + pr * 2); w[u] = ST[(size_t)chq * 32768 + rem]; d[u] = DEC[chq * 8 + h]; } }
#pragma unroll
        for (int u = 0; u < 4; ++u) { const size_t pr = pr0 + u * NGT;
            if (pr < 524288) *(f32x2*)(P->out + O_SSS + pr * 2) = (f32x2){h0[u][0] * d[u] + bf_lo(w[u]), h0[u][1] * d[u] + bf_hi(w[u])}; }
    }
}
DI void ssd_out_tile(KP P, LAS unsigned char* lds, int ch) {
    int tid = threadIdx.x; asm volatile("" : "+v"(tid));
    const int lane = tid & 63, h = __builtin_amdgcn_readfirstlane(tid >> 6);
    bool samp, has_prev; int sb, r0, Lv; chunk_geom(ch, samp, sb, r0, Lv, has_prev);
    __syncthreads();
    ssd_dt_scan(P, lds, r0, Lv, h, lane);
    __syncthreads();
    ssd_conv_to_lds<false, 128>(P, lds, tid, r0, Lv, samp, sb, has_prev);
    __syncthreads();
    const int r = lane & 31, h2 = lane >> 5, blk = (lane >> 4) & 1, i16 = lane & 15, q = i16 >> 2, pp = i16 & 3, g = h >> 2;
    const LAS float* sac = (const LAS float*)(lds + L_AC) + h * 64; const LAS float* sdt = (const LAS float*)(lds + L_DT) + h * 64;
    f32x16 cb[2][2];
#pragma unroll
    for (int a = 0; a < 2; ++a)
#pragma unroll
        for (int b = 0; b < 2; ++b)
#pragma unroll
            for (int i = 0; i < 16; ++i) cb[a][b][i] = 0.f;
    const bf16_t* PREV = (const bf16_t*)(P->ws + WS_ST) + ((size_t)ch * 8 + h) * 8192;
#pragma unroll 2
    for (int kk = 0; kk < 8; ++kk) {
        bf16x8 bm[2], cm[2];
#pragma unroll
        for (int x = 0; x < 2; ++x) {
            bm[x] = *(const LAS bf16x8*)(lds + (32 * x + r) * XCS + (512 + g * 128 + 16 * kk + 8 * h2) * 2);
            cm[x] = *(const LAS bf16x8*)(lds + (32 * x + r) * XCS + (768 + g * 128 + 16 * kk + 8 * h2) * 2);
        }
#pragma unroll
        for (int a = 0; a < 2; ++a)
#pragma unroll
            for (int b = 0; b < 2; ++b) cb[a][b] = MFMA32(bm[a], cm[b], cb[a][b]);
    }
    __builtin_amdgcn_sched_barrier(0);
    float acl[2]; acl[0] = sac[r]; acl[1] = sac[32 + r];
    f32x16 y[2][2];
#pragma unroll
    for (int a = 0; a < 2; ++a)
#pragma unroll
        for (int b = 0; b < 2; ++b)
#pragma unroll
            for (int i = 0; i < 16; ++i) y[a][b][i] = 0.f;
#pragma unroll
    for (int sbk = 0; sbk < 2; ++sbk) {
        float acs[16];
#pragma unroll
        for (int gi = 0; gi < 4; ++gi) { const f32x4 t4 = *(const LAS f32x4*)(sac + 32 * sbk + 8 * gi + 4 * h2); acs[4 * gi] = t4[0]; acs[4 * gi + 1] = t4[1]; acs[4 * gi + 2] = t4[2]; acs[4 * gi + 3] = t4[3]; }
#pragma unroll
        for (int s2 = 0; s2 < 2; ++s2) {
            bf16x8 pf[2];
#pragma unroll
            for (int lb = 0; lb < 2; ++lb) {
                const int l = 32 * lb + r; float m[8];
#pragma unroll
                for (int j = 0; j < 8; ++j) { const int i = 8 * s2 + j, s = 32 * sbk + crow(i, h2);
                    m[j] = (s <= l) ? cb[sbk][lb][i] * __builtin_amdgcn_exp2f((acl[lb] - acs[i]) * LOG2E) : 0.f; }
                pf[lb] = pack8(m[0], m[1], m[2], m[3], m[4], m[5], m[6], m[7]);
            }
            LAS unsigned char* rlo = lds + (32 * sbk + 16 * s2 + 4 * h2 + q) * XCS + (h * 64 + 16 * blk + 4 * pp) * 2;
            LAS unsigned char* rhi = rlo + 8 * XCS;
#pragma unroll
            for (int pb = 0; pb < 2; ++pb) { const bf16x8 xa = tr_frag(rlo + 64 * pb, rhi + 64 * pb);
#pragma unroll
                for (int lb = 0; lb < 2; ++lb) y[pb][lb] = MFMA32(xa, pf[lb], y[pb][lb]); }
        }
    }
    __builtin_amdgcn_sched_barrier(0);
    {
        f32x16 yo[2][2];
#pragma unroll
        for (int a = 0; a < 2; ++a)
#pragma unroll
            for (int b = 0; b < 2; ++b)
#pragma unroll
                for (int i = 0; i < 16; ++i) yo[a][b][i] = 0.f;
        bf16x8 pv[8][2];
#pragma unroll
        for (int kk = 0; kk < 8; ++kk)
#pragma unroll
            for (int x = 0; x < 2; ++x) {
                if (!samp) pv[kk][x] = *(const bf16x8*)(PREV + (32 * x + r) * 128 + 16 * kk + 8 * h2);
                else { const float* hp = P->in[4] + ((size_t)(sb * 8 + h) * 64 + 32 * x + r) * 128 + 16 * kk + 8 * h2; const f32x4 ha = *(const f32x4*)hp, hb = *(const f32x4*)(hp + 4);
                    pv[kk][x] = pack8(ha[0], ha[1], ha[2], ha[3], hb[0], hb[1], hb[2], hb[3]); }
            }
#pragma unroll
        for (int kk = 0; kk < 8; ++kk)
#pragma unroll
            for (int x = 0; x < 2; ++x) pin(pv[kk][x]);
#pragma unroll
        for (int kk = 0; kk < 8; ++kk) {
            bf16x8 cm[2];
#pragma unroll
            for (int x = 0; x < 2; ++x) cm[x] = *(const LAS bf16x8*)(lds + (32 * x + r) * XCS + (768 + g * 128 + 16 * kk + 8 * h2) * 2);
#pragma unroll
            for (int a = 0; a < 2; ++a)
#pragma unroll
                for (int b = 0; b < 2; ++b) yo[a][b] = MFMA32(pv[kk][a], cm[b], yo[a][b]);
        }
#pragma unroll
        for (int lb = 0; lb < 2; ++lb) { const float eo = __builtin_amdgcn_exp2f(acl[lb] * LOG2E);
#pragma unroll
            for (int pb = 0; pb < 2; ++pb)
#pragma unroll
                for (int i = 0; i < 16; ++i) y[pb][lb][i] += eo * yo[pb][lb][i]; }
    }
    __builtin_amdgcn_sched_barrier(0);
    const float Dh = P->in[14][h];
    const bf16_t* Z = (const bf16_t*)(P->ws + WS_Z);
    float ss[2] = {0.f, 0.f};
    u32x2 zq[2][2][4];
#pragma unroll
    for (int lb = 0; lb < 2; ++lb)
#pragma unroll
        for (int pb = 0; pb < 2; ++pb)
#pragma unroll
            for (int gi = 0; gi < 4; ++gi) { const int l = 32 * lb + r; zq[lb][pb][gi] = (u32x2){0u, 0u};
                if (l < Lv) zq[lb][pb][gi] = *(const u32x2*)(Z + (size_t)(r0 + l) * 512 + h * 64 + 32 * pb + 8 * gi + 4 * h2); }
#pragma unroll
    for (int lb = 0; lb < 2; ++lb)
#pragma unroll
        for (int pb = 0; pb < 2; ++pb)
#pragma unroll
            for (int gi = 0; gi < 4; ++gi) pin(zq[lb][pb][gi]);
#pragma unroll
    for (int lb = 0; lb < 2; ++lb) {
        const int l = 32 * lb + r; const bool ok = l < Lv;
        const float dtl = sdt[l]; const float dsk = ok ? Dh / dtl : 0.f;
#pragma unroll
        for (int pb = 0; pb < 2; ++pb)
#pragma unroll
            for (int gi = 0; gi < 4; ++gi) {
                const int p0 = 32 * pb + 8 * gi + 4 * h2;
                const u32x2 xq = *(const LAS u32x2*)(lds + l * XCS + (h * 64 + p0) * 2);
                const u32x2 zv2 = zq[lb][pb][gi];
                const float xv[4] = {bf_lo(xq.x), bf_hi(xq.x), bf_lo(xq.y), bf_hi(xq.y)}; const float zv[4] = {bf_lo(zv2.x), bf_hi(zv2.x), bf_lo(zv2.y), bf_hi(zv2.y)};
#pragma unroll
                for (int e = 0; e < 4; ++e) { const int i = 4 * gi + e; float v = y[pb][lb][i] + xv[e] * dsk; v *= silu_f(zv[e]); y[pb][lb][i] = v; ss[lb] += v * v; }
            }
    }
    LAS float* red = (LAS float*)(lds + L_RED);
#pragma unroll
    for (int lb = 0; lb < 2; ++lb) { ss[lb] += __shfl_xor(ss[lb], 32); if (h2 == 0) red[h * 64 + 32 * lb + r] = ss[lb]; }
    __syncthreads();
    bf16_t* A2 = (bf16_t*)(P->ws + WS_A2); const float* gam = P->in[15];
    f32x4 gv[2][4];
#pragma unroll
    for (int pb = 0; pb < 2; ++pb)
#pragma unroll
        for (int gi = 0; gi < 4; ++gi) gv[pb][gi] = *(const f32x4*)(gam + h * 64 + 32 * pb + 8 * gi + 4 * h2);
#pragma unroll
    for (int pb = 0; pb < 2; ++pb)
#pragma unroll
        for (int gi = 0; gi < 4; ++gi) pin(gv[pb][gi]);
#pragma unroll
    for (int lb = 0; lb < 2; ++lb) {
        const int l = 32 * lb + r; float tot = 0.f;
#pragma unroll
        for (int hh = 0; hh < 8; ++hh) tot += red[hh * 64 + l];
        const float rs = 1.0f / sqrtf(tot * (1.f / 512.f) + 1e-5f);
        if (l < Lv) {
#pragma unroll
            for (int pb = 0; pb < 2; ++pb)
#pragma unroll
                for (int gi = 0; gi < 4; ++gi) { const int p0 = 32 * pb + 8 * gi + 4 * h2; const f32x4 g4 = gv[pb][gi];
                    u32x2 w; w.x = pk2(y[pb][lb][4 * gi] * rs * g4[0], y[pb][lb][4 * gi + 1] * rs * g4[1]); w.y = pk2(y[pb][lb][4 * gi + 2] * rs * g4[2], y[pb][lb][4 * gi + 3] * rs * g4[3]);
                    *(u32x2*)(A2 + (size_t)(r0 + l) * 1024 + 512 + h * 64 + p0) = w; }
        }
    }
}

constexpr int L_TBL = 0;
constexpr int L_ARED = 8 * 260 * 4;
constexpr int L_AQ = 16384;
DI void attn_tile(KP P, LAS unsigned char* lds, int ch) {
    int tid = threadIdx.x; asm volatile("" : "+v"(tid));
    const int lane = tid & 63, hd = __builtin_amdgcn_readfirstlane(tid >> 6), r = lane & 31, h2 = lane >> 5;
    const bool samp = ch >= 512;
    int Lq, jt_lo, nkeys, ngr; long qrow0; const bf16_t* Kb; const bf16_t* Vb;
    if (!samp) { const int b = ch >> 7, c = ch & 127; qrow0 = (long)ch * 64; Lq = 64; jt_lo = (c < 8) ? 8 - c : 0; nkeys = 576; ngr = 36;
        Kb = (const bf16_t*)(P->ws + WS_KP) + ((long)b * 8192 + (long)(c - 8) * 64) * 512 + hd * 64;
        Vb = (const bf16_t*)(P->ws + WS_VFP) + ((long)(b * 8 + hd) * 512 + (long)(c - 8) * 4) * 1024; }
    else { const int b = ch - 512; qrow0 = (long)MP + b * 32; Lq = 32; jt_lo = 0; nkeys = 544; ngr = 34;
        Kb = (const bf16_t*)(P->ws + WS_KS) + (long)b * 544 * 512 + hd * 64;
        Vb = (const bf16_t*)(P->ws + WS_VFS) + (long)(b * 8 + hd) * 34 * 1024; }
    __syncthreads();
    LAS float* tbl = (LAS float*)(lds + L_TBL) + hd * 260;
    for (int i = lane; i < 257; i += 64) tbl[i] = P->in[8][hd * 257 + i] * LOG2E;
    __syncthreads();
    const bf16_t* Q = (const bf16_t*)(P->ws + WS_Q);
    LAS unsigned char* qlds = lds + L_AQ + hd * 8192 + lane * 16;
    { bf16x8 qtmp[2][4];
#pragma unroll
      for (int qb = 0; qb < 2; ++qb) { int qi = 32 * qb + r; if (qi > Lq - 1) qi = Lq - 1;
#pragma unroll
          for (int s = 0; s < 4; ++s) qtmp[qb][s] = *(const bf16x8*)(Q + (size_t)(qrow0 + qi) * 512 + hd * 64 + 16 * s + 8 * h2); }
#pragma unroll
      for (int qb = 0; qb < 2; ++qb)
#pragma unroll
          for (int s = 0; s < 4; ++s) pin(qtmp[qb][s]);
#pragma unroll
      for (int qb = 0; qb < 2; ++qb)
#pragma unroll
          for (int s = 0; s < 4; ++s) *(LAS bf16x8*)(qlds + (qb * 4 + s) * 1024) = qtmp[qb][s]; }
    f32x16 o[2][2];
#pragma unroll
    for (int a = 0; a < 2; ++a)
#pragma unroll
        for (int b = 0; b < 2; ++b)
#pragma unroll
            for (int i = 0; i < 16; ++i) o[a][b][i] = 0.f;
    float mrun[2] = {-1e30f, -1e30f}, lrun[2] = {0.f, 0.f};
    const float SC = 0.125f * LOG2E;
    for (int jt = jt_lo; jt < 9; ++jt) {
        bf16x8 kf[2][4];
#pragma unroll
        for (int kb = 0; kb < 2; ++kb) {
            int kj = 64 * jt + 32 * kb + r; if (kj > nkeys - 1) kj = nkeys - 1;
#pragma unroll
            for (int s = 0; s < 4; ++s) kf[kb][s] = *(const bf16x8*)(Kb + (long)kj * 512 + 16 * s + 8 * h2);
        }
#pragma unroll
        for (int kb = 0; kb < 2; ++kb)
#pragma unroll
            for (int s = 0; s < 4; ++s) pin(kf[kb][s]);
        f32x16 st[2][2];
#pragma unroll
        for (int kb = 0; kb < 2; ++kb)
#pragma unroll
            for (int qb = 0; qb < 2; ++qb) {
#pragma unroll
                for (int i = 0; i < 16; ++i) st[kb][qb][i] = 0.f;
#pragma unroll
                for (int s = 0; s < 4; ++s) st[kb][qb] = MFMA32(kf[kb][s], *(const LAS bf16x8*)(qlds + (qb * 4 + s) * 1024), st[kb][qb]);
            }
        __builtin_amdgcn_sched_barrier(0);
        bf16x8 vf[2][2][2];
#pragma unroll
        for (int kb = 0; kb < 2; ++kb)
#pragma unroll
            for (int s2 = 0; s2 < 2; ++s2) {
                int gidx = 4 * jt + 2 * kb + s2; if (gidx > ngr - 1) gidx = ngr - 1;
#pragma unroll
                for (int db = 0; db < 2; ++db) vf[kb][s2][db] = *(const bf16x8*)(Vb + (long)gidx * 1024 + (h2 * 64 + 32 * db + r) * 8);
            }
        __builtin_amdgcn_sched_barrier(0);
        const bool far = (jt <= 5);
        const bool tailmask = samp && (jt == 8);
        const float bfar = tbl[256];
#pragma unroll
        for (int qb = 0; qb < 2; ++qb) {
            const int qi = 32 * qb + r;
            float mx = -1e30f;
#pragma unroll
            for (int kb = 0; kb < 2; ++kb)
#pragma unroll
                for (int i = 0; i < 16; ++i) {
                    const int kj = 64 * jt + 32 * kb + crow(i, h2);
                    float bias = bfar;
                    if (!far) { int rel = 512 + qi - kj; rel = rel > 128 ? 128 : rel; rel = rel < -128 ? -128 : rel; bias = tbl[rel + 128]; }
                    float sc = st[kb][qb][i] * SC + bias;
                    if (tailmask && kj >= nkeys) sc = -1e30f;
                    st[kb][qb][i] = sc; mx = fmaxf(mx, sc);
                }
            mx = fmaxf(mx, __shfl_xor(mx, 32));
            const float mnew = fmaxf(mrun[qb], mx), alpha = __builtin_amdgcn_exp2f(mrun[qb] - mnew);
            float ls = 0.f;
#pragma unroll
            for (int kb = 0; kb < 2; ++kb)
#pragma unroll
                for (int i = 0; i < 16; ++i) { const float p = __builtin_amdgcn_exp2f(st[kb][qb][i] - mnew); st[kb][qb][i] = p; ls += p; }
            ls += __shfl_xor(ls, 32);
            lrun[qb] = lrun[qb] * alpha + ls; mrun[qb] = mnew;
            if (__builtin_amdgcn_ballot_w64(alpha != 1.0f) != 0ull) {
#pragma unroll
                for (int db = 0; db < 2; ++db)
#pragma unroll
                    for (int i = 0; i < 16; ++i) o[db][qb][i] *= alpha;
            }
        }
#pragma unroll
        for (int kb = 0; kb < 2; ++kb)
#pragma unroll
            for (int s2 = 0; s2 < 2; ++s2) {
                bf16x8 pf[2];
#pragma unroll
                for (int qb = 0; qb < 2; ++qb) pf[qb] = pack8(st[kb][qb][8 * s2], st[kb][qb][8 * s2 + 1], st[kb][qb][8 * s2 + 2], st[kb][qb][8 * s2 + 3],
                                                               st[kb][qb][8 * s2 + 4], st[kb][qb][8 * s2 + 5], st[kb][qb][8 * s2 + 6], st[kb][qb][8 * s2 + 7]);
#pragma unroll
                for (int db = 0; db < 2; ++db)
#pragma unroll
                    for (int qb = 0; qb < 2; ++qb) o[db][qb] = MFMA32(vf[kb][s2][db], pf[qb], o[db][qb]);
            }
    }
    LAS float* red = (LAS float*)(lds + L_ARED);
#pragma unroll
    for (int qb = 0; qb < 2; ++qb) {
        const float il = 1.0f / lrun[qb]; float ss = 0.f;
#pragma unroll
        for (int db = 0; db < 2; ++db)
#pragma unroll
            for (int i = 0; i < 16; ++i) { const float v = o[db][qb][i] * il; o[db][qb][i] = v; ss += v * v; }
        ss += __shfl_xor(ss, 32);
        if (h2 == 0) red[hd * 64 + 32 * qb + r] = ss;
    }
    __syncthreads();
    bf16_t* A2 = (bf16_t*)(P->ws + WS_A2); const float* gam = P->in[9];
    f32x4 gv[2][4];
#pragma unroll
    for (int db = 0; db < 2; ++db)
#pragma unroll
        for (int gi = 0; gi < 4; ++gi) gv[db][gi] = *(const f32x4*)(gam + hd * 64 + 32 * db + 8 * gi + 4 * h2);
#pragma unroll
    for (int db = 0; db < 2; ++db)
#pragma unroll
        for (int gi = 0; gi < 4; ++gi) pin(gv[db][gi]);
#pragma unroll
    for (int qb = 0; qb < 2; ++qb) {
        const int qi = 32 * qb + r; float tot = 0.f;
#pragma unroll
        for (int hh = 0; hh < 8; ++hh) tot += red[hh * 64 + qi];
        const float rs = 1.0f / sqrtf(tot * (1.f / 512.f) + 1e-5f);
        if (qi < Lq) {
#pragma unroll
            for (int db = 0; db < 2; ++db)
#pragma unroll
                for (int gi = 0; gi < 4; ++gi) { const int d0 = 32 * db + 8 * gi + 4 * h2; const f32x4 g4 = gv[db][gi];
                    u32x2 w; w.x = pk2(o[db][qb][4 * gi] * rs * g4[0], o[db][qb][4 * gi + 1] * rs * g4[1]); w.y = pk2(o[db][qb][4 * gi + 2] * rs * g4[2], o[db][qb][4 * gi + 3] * rs * g4[3]);
                    *(u32x2*)(A2 + (size_t)(qrow0 + qi) * 1024 + hd * 64 + d0) = w; }
        }
    }
}

__global__ void __launch_bounds__(NT, 2) hybrid_fwd(Params PA) {
    extern __shared__ __attribute__((aligned(16))) unsigned char lds_raw[];
    LAS unsigned char* lds = (LAS unsigned char*)lds_raw;
    cg::grid_group grid = cg::this_grid();
    const int G = gridDim.x, bx = blockIdx.x;
    int wid_s = __builtin_amdgcn_readfirstlane(threadIdx.x >> 6); asm volatile("" : "+s"(wid_s));
#define TIDX() ({ unsigned z_ = 0u; asm volatile("" : "+s"(z_)); (wid_s << 6) | (int)__builtin_amdgcn_mbcnt_hi(~0u, __builtin_amdgcn_mbcnt_lo(~0u, z_)); })
#define KARGS() ({ KP p_ = (KP)__builtin_amdgcn_kernarg_segment_ptr(); asm volatile("" : "+s"(p_)); p_; })
    if (PA.out == nullptr) grid.sync();
    {
        volatile LAS unsigned* stw = (volatile LAS unsigned*)(lds + LDS_BYTES - 16);
        if (threadIdx.x == 0) { stw[0] = 0u; stw[1] = 0u; }
        __syncthreads();
    }
    const XcdBarrier gbar = xcd_barrier_post((unsigned*)(PA.ws + WS_BAR), (volatile LAS unsigned*)(lds + LDS_BYTES - 16));
#define GRID_SYNC() xcd_barrier(gbar, TIDX())

#ifndef PHASE_MASK
#define PHASE_MASK 0xFFFF
#endif
#ifndef REPEAT_MASK
#define REPEAT_MASK 0
#endif
#define PH(k) if (KP P = KARGS()) if (PHASE_MASK & (1 << (k))) for (int rep_ = 0; rep_ <= ((REPEAT_MASK >> (k)) & 1); ++rep_)
#ifndef NREP_ALL
#define NREP_ALL 1
#endif
    for (int outer_ = 0; outer_ < NREP_ALL; ++outer_) {
    if (outer_) GRID_SYNC();
    PH(0) phase_convert(P, lds);
    xcd_census(gbar, TIDX());
    GRID_SYNC();
    PH(1) {
        pg8::AMapPlain am{(const void*)(P->ws + WS_XB), 2048}; pg8::Order S; S.init(128, 12, G, bx);
        EpiInProj E{P->out, P->ws};
        pg8::gemm_phase<EpiInProj, pg8::AMapPlain>(lds, am, (const void*)(P->ws + WS_WIN), 2048, S, E);
        small_inproj(P);
    }
    GRID_SYNC();
    PH(2) for (int ch = bx; ch < 512; ch += G) ssd_states_tile(P, lds, ch);
    GRID_SYNC();
    PH(3) phase_scan(P, lds);
    PH(4) {
        unsigned* qctr = (unsigned*)(P->ws + WS_BAR) + 3584 + 64 * (rep_ + 2 * outer_);
        volatile LAS unsigned* slot = (volatile LAS unsigned*)(lds + LDS_BYTES - 32);
        for (;;) {
            __syncthreads();
            if (threadIdx.x == 0) slot[0] = __hip_atomic_fetch_add(qctr, 1u, __ATOMIC_RELAXED, __HIP_MEMORY_SCOPE_AGENT);
            __syncthreads();
            const int itq = (int)slot[0];
            if (itq >= 560 + LATE_WG_ITEMS) break;
            if (itq < LATE_WG_ITEMS) { convert_late_item(P, lds, itq); continue; }
            const int it = itq - LATE_WG_ITEMS;
            if (it < 480) attn_tile(P, lds, (it / 120) * 128 + 8 + it % 120);
            else if (it < 512) { const int j = it - 480; attn_tile(P, lds, (j & 3) * 128 + 7 - (j >> 2)); }
            else if (it < 528) ssd_out_tile(P, lds, it);
            else if (it < 544) attn_tile(P, lds, it - 16);
            else ssd_states_tile(P, lds, it - 32);
        }
    }
    GRID_SYNC();
    PH(5) for (int ch = bx; ch < 512; ch += G) ssd_out_tile(P, lds, ch);
    PH(5) phase_sample_state(P);
    GRID_SYNC();
    PH(6) {
        __syncthreads();
        pg8::AMapPlain am{(const void*)(P->ws + WS_A2), 2048}; pg8::Order S; S.init(128, 4, G, bx);
        EpiOutProj E{P->in[0], P->in[1], (bf16_t*)(P->out + O_Y)};
        pg8::gemm_phase<EpiOutProj, pg8::AMapPlain>(lds, am, (const void*)(P->ws + WS_WOUT), 2048, S, E);
        small_out_splitk(P, lds, TIDX());
    }
    GRID_SYNC();
    PH(7) phase_ln<true>((const bf16_t*)(P->out + O_Y), P->in[17], P->in[18], (void*)(P->ws + WS_XB), P->ws + WS_X1F8, P->ws + WS_G, TIDX());
    GRID_SYNC();
    PH(8) {
        pg8::Order S; S.init(132, 21, G, bx);
        pg8::AMapUp<126> am{(const void*)(P->ws + WS_X1F8), 1024};
        EpiUp<false> E{P->ws + WS_G, nullptr, P->in[20], P->in[21], P->in[6], nullptr};
        pg8::gemm_phase<EpiUp<false>, pg8::AMapUp<126>, true>(lds, am, (const void*)(P->ws + WS_WUP8), 1024, S, E);
        pg8::Order S2; S2.init(2, 21, G, (bx + G - (2772 % G)) % G);
        pg8::AMapUp<128> am2{(const void*)(P->ws + WS_XB), 2048};
        EpiUp<true> E2{nullptr, (bf16_t*)(P->ws + WS_GS), P->in[20], P->in[21], P->in[6], P->out + O_FCS};
        pg8::gemm_phase<EpiUp<true>, pg8::AMapUp<128>>(lds, am2, (const void*)(P->ws + WS_WUP), 2048, S2, E2);
        small_ffnconv_prompt(P, lds, TIDX());
    }
    GRID_SYNC();
    PH(9) {
        pg8::AMapPlain am{(const void*)(P->ws + WS_G), DFF * 2}; pg8::Order S; S.init(128, 4, G, bx);
        EpiDown E{(const bf16_t*)(P->ws + WS_XB), (bf16_t*)(P->ws + WS_A2)};
        pg8::gemm_phase<EpiDown, pg8::AMapPlain>(lds, am, (const void*)(P->ws + WS_WDOWN), DFF * 2, S, E);
        small_down_splitk(P, lds, TIDX());
    }
    GRID_SYNC();
    PH(10) phase_ln<false>((const bf16_t*)(P->ws + WS_A2), P->in[23], P->in[24], (void*)(P->out + O_Y), nullptr, nullptr, TIDX());
    }
}

extern "C" void kernel_launch(void* const* d_in, const int* in_sizes, int n_in, void* d_out, int out_size, void* d_ws, size_t ws_size, hipStream_t stream) {
    static int grid_blocks = 0;
    if (!grid_blocks) {
        int dev = 0, cus = 0, per_cu = 0;
        hipGetDevice(&dev);
        hipDeviceGetAttribute(&cus, hipDeviceAttributeMultiprocessorCount, dev);
        hipFuncSetAttribute((const void*)hybrid_fwd, hipFuncAttributeMaxDynamicSharedMemorySize, LDS_BYTES);
        hipOccupancyMaxActiveBlocksPerMultiprocessor(&per_cu, (const void*)hybrid_fwd, NT, LDS_BYTES);
        if (per_cu < 1) per_cu = 1;
        if (per_cu > 1) per_cu = 1;
        grid_blocks = cus * per_cu;
        if (ws_size < WS_END) fprintf(stderr, "kernel_launch: workspace too small: %zu < %zu\n", ws_size, (size_t)WS_END);
    }
    Params p{};
    for (int i = 0; i < 25; ++i) p.in[i] = (const float*)d_in[i];
    p.out = (float*)d_out; p.ws = (unsigned char*)d_ws;
    hipMemsetAsync((unsigned char*)d_ws + WS_BAR, 0, 16384, stream);
    void* args[] = {&p};
    hipError_t e = hipLaunchCooperativeKernel((const void*)hybrid_fwd, dim3(grid_blocks), dim3(NT), args, LDS_BYTES, stream);
    if (e != hipSuccess) fprintf(stderr, "cooperative launch failed: %s (grid %d)\n", hipGetErrorString(e), grid_blocks);
}
```

```cpp
#include <hip/hip_runtime.h>
#include <hip/hip_cooperative_groups.h>
#include <cstdio>
namespace cg = cooperative_groups;

#define LAS __attribute__((address_space(3)))
typedef unsigned short bf16_t;
typedef short bf16x8 __attribute__((ext_vector_type(8)));
typedef short s16x4 __attribute__((ext_vector_type(4)));
typedef float f32x2 __attribute__((ext_vector_type(2)));
typedef float f32x4 __attribute__((ext_vector_type(4)));
typedef float f32x16 __attribute__((ext_vector_type(16)));
typedef unsigned u32x2 __attribute__((ext_vector_type(2)));
typedef unsigned u32x4 __attribute__((ext_vector_type(4)));
typedef __bf16 bf2_t __attribute__((ext_vector_type(2)));
typedef int i32x4 __attribute__((ext_vector_type(4)));
typedef int i32x8 __attribute__((ext_vector_type(8)));
#define DI __device__ __forceinline__

constexpr int MP = 32768, MS = 512, MT = MP + MS;
constexpr int DM = 1024, NIN = 3080, NINP = 3328, DFF = 2688, NUP = 5376;
constexpr int NCHUNK = 528;
constexpr float ALPHA = 1.189207115002721f;
constexpr float LOG2E = 1.4426950408889634f;
constexpr int NT = 512;
constexpr int LDS_BYTES = 147456;
constexpr int GP8 = 2816;
constexpr float SC_X1 = 16.f, SC_WUP = 64.f, SC_G = 8.f, SC_WDN = 128.f;

constexpr size_t O_Y = 0;
constexpr size_t O_NKP = (size_t)MT * 1024;
constexpr size_t O_NVP = O_NKP + 1048576;
constexpr size_t O_NKS = O_NVP + 1048576;
constexpr size_t O_NVS = O_NKS + 262144;
constexpr size_t O_SSP = O_NVS + 262144;
constexpr size_t O_SSS = O_SSP + 262144;
constexpr size_t O_SCP = O_SSS + 1048576;
constexpr size_t O_SCS = O_SCP + 12288;
constexpr size_t O_FCP = O_SCS + 49152;
constexpr size_t O_FCS = O_FCP + 43008;

constexpr size_t al256(size_t x) { return (x + 255) & ~(size_t)255; }
constexpr size_t WS_WIN = 0;
constexpr size_t WS_WOUT = WS_WIN + al256((size_t)NINP * 1024 * 2);
constexpr size_t WS_WUP = WS_WOUT + al256((size_t)1024 * 1024 * 2);
constexpr size_t WS_WDOWN = WS_WUP + al256((size_t)NUP * 1024 * 2);
constexpr size_t WS_WUP8 = WS_WDOWN + al256((size_t)1024 * DFF * 2);
constexpr size_t WS_WDN8 = WS_WUP8 + al256((size_t)NUP * 1024);
constexpr size_t WS_GS = WS_WDN8 + al256((size_t)1024 * GP8);
constexpr size_t WS_DT = WS_GS + al256((size_t)MS * DFF * 2);
constexpr size_t WS_DEC = WS_DT + al256((size_t)MT * 8 * 4);
constexpr size_t WS_BAR = WS_DEC + al256((size_t)NCHUNK * 8 * 4);
constexpr size_t WS_XB = WS_BAR + 16384 + 8192;
constexpr size_t WS_R3 = WS_XB + al256((size_t)(MT + 256) * 1024 * 2);
constexpr size_t WS_G = WS_R3;
constexpr size_t WS_X1F8 = WS_R3 + al256((size_t)MP * DFF * 2) + 8192;
constexpr size_t WS_Q = WS_R3;
constexpr size_t WS_KP = WS_Q + al256((size_t)MT * 512 * 2);
constexpr size_t WS_KS = WS_KP + al256((size_t)MP * 512 * 2);
constexpr size_t WS_VFP = WS_KS + al256((size_t)16 * 544 * 512 * 2);
constexpr size_t WS_VFS = WS_VFP + al256((size_t)4 * 8 * 512 * 1024 * 2);
constexpr size_t WS_Z = WS_VFS + al256((size_t)16 * 8 * 34 * 1024 * 2) + 65536;
constexpr size_t WS_XBC = WS_Z + al256((size_t)MT * 512 * 2);
constexpr size_t WS_A2 = WS_XBC + al256((size_t)MT * 1024 * 2);
constexpr size_t WS_ST = WS_A2 + al256((size_t)MT * 1024 * 2);
constexpr size_t WS_END = WS_ST + al256((size_t)NCHUNK * 65536 * 2);
static_assert(WS_X1F8 + (size_t)(MT + 256) * 1024 <= WS_A2, "G8/X1F8 alias");
static_assert(WS_A2 + (size_t)MT * 1024 * 4 <= WS_END, "U2 alias");

struct Params {
    const float* in[25];
    float* out;
    unsigned char* ws;
};
typedef const __attribute__((address_space(4))) Params* KP;

DI unsigned pk2(float lo, float hi) { f32x2 f = {lo, hi}; return __builtin_bit_cast(unsigned, __builtin_convertvector(f, bf2_t)); }
DI unsigned pk4_f8(float a, float b, float c, float d) { int w = 0; w = __builtin_amdgcn_cvt_pk_fp8_f32(a, b, w, false); w = __builtin_amdgcn_cvt_pk_fp8_f32(c, d, w, true); return (unsigned)w; }
DI float bf_lo(unsigned w) { return __uint_as_float(w << 16); }
DI float bf_hi(unsigned w) { return __uint_as_float(w & 0xffff0000u); }
DI float silu_f(float x) { return x * __builtin_amdgcn_rcpf(1.0f + __builtin_amdgcn_exp2f(-x * LOG2E)); }
DI int crow(int reg, int h) { return (reg & 3) + 8 * (reg >> 2) + 4 * h; }
#define MFMA32(a, b, c) __builtin_amdgcn_mfma_f32_32x32x16_bf16((a), (b), (c), 0, 0, 0)
DI bf16x8 pack8(float a0, float a1, float a2, float a3, float a4, float a5, float a6, float a7) {
    u32x4 p; p.x = pk2(a0, a1); p.y = pk2(a2, a3); p.z = pk2(a4, a5); p.w = pk2(a6, a7); return __builtin_bit_cast(bf16x8, p);
}
DI void pin(bf16x8& v) { asm volatile("" : "+v"(v)); }
DI void pin(u32x2& v) { asm volatile("" : "+v"(v)); }
DI void pin(f32x4& v) { asm volatile("" : "+v"(v)); }
DI bf16x8 tr_frag(LAS unsigned char* lo, LAS unsigned char* hi) {
    s16x4 a = __builtin_amdgcn_ds_read_tr16_b64_v4i16((LAS s16x4*)lo);
    s16x4 b = __builtin_amdgcn_ds_read_tr16_b64_v4i16((LAS s16x4*)hi);
    return __builtin_shufflevector(a, b, 0, 1, 2, 3, 4, 5, 6, 7);
}


#define XB_TMO      128
#define XB_XCNT(j)  (256  + 64 * (j))
#define XB_XSUB(j)  (1280 + 64 * (j))
#define XB_XGEN(j)  (2304 + 64 * (j))
#define XB_TOP      3328
#define XB_TOPGEN   3392
#define XCD_BAR_WORDS 3456
#define XB_SPIN_CAP (1u << 20)
DI unsigned xb_ld(unsigned* p)              { return __hip_atomic_load(p, __ATOMIC_RELAXED, __HIP_MEMORY_SCOPE_AGENT); }
DI unsigned xb_add(unsigned* p, unsigned v) { return __hip_atomic_fetch_add(p, v, __ATOMIC_RELAXED, __HIP_MEMORY_SCOPE_AGENT); }
DI unsigned xb_xcc_id() { return (unsigned)__builtin_amdgcn_s_getreg((3 << 11) | 20) & 0xFu; }
#define XB_SPIN(cond, bar) do { unsigned _sp = 0; while (cond) { __builtin_amdgcn_s_sleep(1); \
    if ((++_sp & 255u) == 0u) { if (xb_ld(&(bar)[XB_TMO])) break; if (_sp > XB_SPIN_CAP) { atomicAdd(&(bar)[XB_TMO], 1u); break; } } } } while (0)
struct XcdBarrier { unsigned* bar; unsigned x; volatile LAS unsigned* st; };
DI XcdBarrier xcd_barrier_post(unsigned* bar, volatile LAS unsigned* st) {
    XcdBarrier b; b.bar = bar; b.x = xb_xcc_id(); b.st = st;
    if (threadIdx.x == 0) (void)xb_add(&bar[XB_XCNT(b.x)], 1u);
    return b;
}
DI void xcd_barrier_complete(unsigned* bar, unsigned x, unsigned& nloc, unsigned& nx) {
    const unsigned G = gridDim.x * gridDim.y * gridDim.z;
    unsigned sum, cnt, mine, sp = 0u;
    for (;;) {
        sum = 0u; cnt = 0u; mine = 0u;
#pragma unroll
        for (unsigned j = 0; j < 16; ++j) { const unsigned c = xb_ld(&bar[XB_XCNT(j)]); sum += c; cnt += (c > 0u) ? 1u : 0u; mine = (j == x) ? c : mine; }
        if (sum == G) break;
        __builtin_amdgcn_s_sleep(1);
        if ((++sp & 255u) == 0u) { if (xb_ld(&bar[XB_TMO])) break; if (sp > XB_SPIN_CAP) { atomicAdd(&bar[XB_TMO], 1u); break; } }
    }
    nloc = mine > 0u ? mine : 1u; nx = cnt > 0u ? cnt : 1u;
}
DI void xcd_barrier(const XcdBarrier& b, int tid_in) {
    asm volatile("s_waitcnt vmcnt(0)" ::: "memory");
    __syncthreads();
    if (tid_in == 0) {
        unsigned* bar = b.bar;
        __builtin_amdgcn_s_waitcnt(0);
        unsigned nloc = b.st[0], nx = b.st[1];
        if (nloc == 0u) { xcd_barrier_complete(bar, b.x, nloc, nx); b.st[0] = nloc; b.st[1] = nx; }
        const unsigned old = xb_add(&bar[XB_XSUB(b.x)], 1u);
        const unsigned gen = old / nloc;
        if (old + 1u == (gen + 1u) * nloc) {
            __builtin_amdgcn_fence(__ATOMIC_RELEASE, "agent");
            asm volatile("s_waitcnt vmcnt(0)" ::: "memory");
            const unsigned og = xb_add(&bar[XB_TOP], 1u);
            const unsigned tg = og / nx;
            if (og + 1u == (tg + 1u) * nx) xb_add(&bar[XB_TOPGEN], 1u);
            else XB_SPIN(xb_ld(&bar[XB_TOPGEN]) == tg, bar);
            __builtin_amdgcn_fence(__ATOMIC_ACQUIRE, "agent");
            xb_add(&bar[XB_XGEN(b.x)], 1u);
            asm volatile("s_waitcnt vmcnt(0)" ::: "memory");
        } else {
            XB_SPIN(xb_ld(&bar[XB_XGEN(b.x)]) == gen, bar);
            __builtin_amdgcn_fence(__ATOMIC_ACQUIRE, "agent");
            asm volatile("s_waitcnt vmcnt(0)" ::: "memory");
        }
    }
    __syncthreads();
}

namespace pg8 {
constexpr int BM = 256, BK = 64, HALF = 128, HTB = HALF * BK * 2, NXCD = 8, WGM = 8;
DI int lds_byte(int r, int c) { const int st = (r >> 4) * 2 + (c >> 5), rr = r & 15, cc = c & 31, ob = rr * 64 + cc * 2; return st * 1024 + (ob ^ (((ob >> 9) & 1) << 5)); }
DI void stage_rc(int b, int& R, int& C) { const int st = b / 1024, sb = b % 1024, swz = sb ^ (((sb >> 9) & 1) << 5); R = (st >> 1) * 16 + swz / 64; C = (st & 1) * 32 + (swz % 64) / 2; }
DI int perm32(int rho) { const int n = rho >> 4, i = rho & 15; return 8 * (i >> 2) + 4 * n + (i & 3); }
struct Unit { int pm, pn; };
struct Order {
    int nM, nN, nwg, G, c;
    DI void init(int nM_, int nN_, int G_, int c_) { nM = nM_; nN = nN_; nwg = nM * nN; G = G_; c = c_; }
    DI bool next(int i, Unit& u) const {
        const long L = (long)i * G + c; if (L >= nwg) return false;
        int wgid = (int)L; { const int q = nwg / NXCD, r = nwg % NXCD, xcd = wgid % NXCD, off = wgid / NXCD; wgid = (xcd < r ? xcd * (q + 1) : r * (q + 1) + (xcd - r) * q) + off; }
        const int nig = WGM * nN, gid = wgid / nig, fm = gid * WGM, gsz = (nM - fm) < WGM ? (nM - fm) : WGM;
        u.pm = fm + ((wgid % nig) % gsz); u.pn = (wgid % nig) / gsz; return true;
    }
};
struct AMapPlain {
    const void* A; int pitch;
    DI const char* unit_base(int pm) const { return (const char*)A + (size_t)pm * 256 * pitch; }
    DI size_t hstep() const { return (size_t)HALF * pitch; }
    DI unsigned voff(int R, int Cb) const { return (unsigned)(R * pitch + Cb); }
};
template <int WRS> struct AMapUp {
    const void* A; int pitch;
    DI const char* unit_base(int pm) const {
        if (WRS == 126) { const int b = pm / 33, ti = pm - b * 33; return (const char*)A + ((long)b * 8192 + ti * 252 - 2) * pitch; }
        return (const char*)A + ((long)MP + pm * 256) * pitch;
    }
    DI size_t hstep() const { return (size_t)4 * pitch; }
    DI unsigned voff(int R, int Cb) const { return (unsigned)((((R >> 6) * WRS + (R & 15) * 8 + ((R >> 4) & 3)) * pitch) + Cb); }
};

template <class Epi, class AMap, bool F8 = false>
DI void gemm_phase(LAS unsigned char* lds, const AMap am, const void* Bt, const int Kb, const Order& S, const Epi& E) {
    int tid = threadIdx.x; asm volatile("" : "+v"(tid));
    const int wid = __builtin_amdgcn_readfirstlane(tid >> 6), lane = tid & 63, wr = wid >> 2, wc = wid & 3, fr = lane & 15, fq = lane >> 4;
    const int nt = Kb / 128;
    unsigned voffA, voffB; size_t dA2, dB2;
    { int R, C; stage_rc(tid * 16, R, C); const int Rb = Epi::PERM ? ((R & ~31) + perm32(R & 31)) : R;
      voffA = am.voff(R, 2 * C); voffB = (unsigned)(Rb * Kb + 2 * C); dA2 = (size_t)(am.voff(64, 0) - am.voff(0, 0)); dB2 = (size_t)64 * Kb; }
    const size_t kstep = (size_t)128;
    const size_t hstepA = am.hstep();
    const size_t hstepB = (size_t)HALF * Kb;
    const size_t tstepB = 2 * hstepB;
    const unsigned ldsw = (unsigned)wid * 1024u;
    constexpr int QOFF = F8 ? 16 : 1024;
    const int aoff = F8 ? lds_byte(wr * 64 + fr, 16 * (fq & 1)) + 1024 * (fq >> 1) : lds_byte(wr * 64 + fr, fq * 8);
    const int boff = F8 ? lds_byte(wc * 32 + fr, 16 * (fq & 1)) + 1024 * (fq >> 1) : lds_byte(wc * 32 + fr, fq * 8);
#define PG8_SA(b, h) (((b) * 2 + (h)) * HTB)
#define PG8_SB(b, h) ((4 + (b) * 2 + (h)) * HTB)
#define PG8_STAGE(bufoff, gbase, voff) do { \
        __builtin_amdgcn_global_load_lds((const unsigned*)((const char*)(gbase) + (voff)), (LAS unsigned*)(lds + (bufoff) + ldsw), 16, 0, 0); \
        __builtin_amdgcn_global_load_lds((const unsigned*)((const char*)(gbase) + d2_##voff + (voff)), (LAS unsigned*)(lds + (bufoff) + ldsw + 8192), 16, 0, 0); } while (0)
#define d2_voffA dA2
#define d2_voffB dB2
#define PG8_LDA(dst, b, h) do { _Pragma("unroll") for (int m = 0; m < 4; ++m) { const i32x4 lo_ = *(const LAS i32x4*)(lds + PG8_SA(b, h) + aoff + m * 2048), hi_ = *(const LAS i32x4*)(lds + PG8_SA(b, h) + aoff + QOFF + m * 2048); \
        dst[m] = __builtin_shufflevector(lo_, hi_, 0, 1, 2, 3, 4, 5, 6, 7); } } while (0)
#define PG8_LDB(dst, b, h) do { _Pragma("unroll") for (int n = 0; n < 2; ++n) { const i32x4 lo_ = *(const LAS i32x4*)(lds + PG8_SB(b, h) + boff + n * 2048), hi_ = *(const LAS i32x4*)(lds + PG8_SB(b, h) + boff + QOFF + n * 2048); \
        dst[n] = __builtin_shufflevector(lo_, hi_, 0, 1, 2, 3, 4, 5, 6, 7); } } while (0)
#define PG8_HALF(v, k) __builtin_bit_cast(bf16x8, __builtin_shufflevector(v, v, 4 * (k), 4 * (k) + 1, 4 * (k) + 2, 4 * (k) + 3))
#define PG8_MMA(ai, bj, At, Bt_) do { __builtin_amdgcn_s_setprio(1); _Pragma("unroll") for (int m = 0; m < 4; ++m) _Pragma("unroll") for (int n = 0; n < 2; ++n) { \
        if (F8) acc[ai][bj][m][n] = __builtin_amdgcn_mfma_scale_f32_16x16x128_f8f6f4(Bt_[n], At[m], acc[ai][bj][m][n], 0, 0, 0, 0, 0, 0); \
        else { acc[ai][bj][m][n] = __builtin_amdgcn_mfma_f32_16x16x32_bf16(PG8_HALF(Bt_[n], 0), PG8_HALF(At[m], 0), acc[ai][bj][m][n], 0, 0, 0); \
               acc[ai][bj][m][n] = __builtin_amdgcn_mfma_f32_16x16x32_bf16(PG8_HALF(Bt_[n], 1), PG8_HALF(At[m], 1), acc[ai][bj][m][n], 0, 0, 0); } } \
        __builtin_amdgcn_s_setprio(0); } while (0)
#define PG8_WAIT_V(n) asm volatile("s_waitcnt vmcnt(" #n ")" ::: "memory")
#define PG8_WAIT_L(n) asm volatile("s_waitcnt lgkmcnt(" #n ")" ::: "memory")
#define PG8_BAR __builtin_amdgcn_s_barrier()
#define PG8_SCHED __builtin_amdgcn_sched_barrier(0)
    Unit cur, nxt; int ui = 0;
    if (!S.next(0, cur)) return;
    f32x4 acc[2][2][4][2];
#pragma unroll
    for (int a = 0; a < 2; ++a)
#pragma unroll
        for (int b = 0; b < 2; ++b)
#pragma unroll
            for (int m = 0; m < 4; ++m)
#pragma unroll
                for (int n = 0; n < 2; ++n) acc[a][b][m][n] = (f32x4){0.f, 0.f, 0.f, 0.f};
    i32x8 At[4], B0[2], B1[2];
    const char* cA = am.unit_base(cur.pm); const char* cB = (const char*)Bt + (size_t)cur.pn * tstepB;
    PG8_STAGE(PG8_SB(0, 0), cB, voffB); PG8_STAGE(PG8_SA(0, 0), cA, voffA); PG8_STAGE(PG8_SB(0, 1), cB + hstepB, voffB); PG8_STAGE(PG8_SA(0, 1), cA + hstepA, voffA);
    if (wr == 1) PG8_BAR;
    PG8_WAIT_V(4); PG8_BAR;
    PG8_STAGE(PG8_SB(1, 0), cB + kstep, voffB); PG8_STAGE(PG8_SA(1, 0), cA + kstep, voffA); PG8_STAGE(PG8_SB(1, 1), cB + hstepB + kstep, voffB);
    PG8_WAIT_V(6); PG8_BAR;
    for (;;) {
        const bool has_next = S.next(ui + 1, nxt);
        const char* nA = has_next ? am.unit_base(nxt.pm) : cA; const char* nB = has_next ? (const char*)Bt + (size_t)nxt.pn * tstepB : cB;
        for (int t = 0; t < nt; t += 2) {
            const bool last = (t == nt - 2);
            const char* a1 = cA + (size_t)(t + 1) * kstep;
            const char* a2 = last ? nA : cA + (size_t)(t + 2) * kstep; const char* b2 = last ? nB : cB + (size_t)(t + 2) * kstep;
            const char* a3 = a2 + kstep; const char* b3 = b2 + kstep;
            PG8_LDB(B0, 0, 0); PG8_SCHED; PG8_LDA(At, 0, 0); PG8_STAGE(PG8_SA(1, 1), a1 + hstepA, voffA);
            PG8_WAIT_L(8); PG8_BAR; PG8_WAIT_L(0); PG8_MMA(0, 0, At, B0); PG8_BAR; PG8_SCHED;
            PG8_LDB(B1, 0, 1); PG8_STAGE(PG8_SB(0, 0), b2, voffB);
            PG8_BAR; PG8_WAIT_L(0); PG8_MMA(0, 1, At, B1); PG8_BAR;
            PG8_LDA(At, 0, 1); PG8_STAGE(PG8_SA(0, 0), a2, voffA);
            PG8_BAR; PG8_WAIT_L(0); PG8_MMA(1, 0, At, B0); PG8_BAR; PG8_SCHED;
            PG8_STAGE(PG8_SB(0, 1), b2 + hstepB, voffB);
            PG8_WAIT_V(6); PG8_BAR; PG8_MMA(1, 1, At, B1); PG8_BAR;
            PG8_LDB(B0, 1, 0); PG8_SCHED; PG8_LDA(At, 1, 0); PG8_STAGE(PG8_SA(0, 1), a2 + hstepA, voffA);
            PG8_WAIT_L(8); PG8_BAR; PG8_WAIT_L(0); PG8_MMA(0, 0, At, B0); PG8_BAR; PG8_SCHED;
            PG8_LDB(B1, 1, 1); PG8_STAGE(PG8_SB(1, 0), b3, voffB);
            PG8_BAR; PG8_WAIT_L(0); PG8_MMA(0, 1, At, B1); PG8_BAR;
            PG8_LDA(At, 1, 1); PG8_STAGE(PG8_SA(1, 0), a3, voffA);
            PG8_BAR; PG8_WAIT_L(0); PG8_MMA(1, 0, At, B0); PG8_BAR; PG8_SCHED;
            PG8_STAGE(PG8_SB(1, 1), b3 + hstepB, voffB);
            PG8_WAIT_V(6); PG8_BAR; PG8_MMA(1, 1, At, B1); PG8_BAR;
        }
        { unsigned z_ = 0u; asm volatile("" : "+s"(z_)); int l2_ = (int)__builtin_amdgcn_mbcnt_hi(~0u, __builtin_amdgcn_mbcnt_lo(~0u, z_)); asm volatile("" : "+v"(l2_));
          E(acc, cur, wr, wc, l2_ & 15, l2_ >> 4); }
        if (!has_next) break;
#pragma unroll
        for (int a = 0; a < 2; ++a)
#pragma unroll
            for (int b = 0; b < 2; ++b)
#pragma unroll
                for (int m = 0; m < 4; ++m)
#pragma unroll
                    for (int n = 0; n < 2; ++n) acc[a][b][m][n] = (f32x4){0.f, 0.f, 0.f, 0.f};
        cur = nxt; cA = nA; cB = nB; ++ui;
    }
    PG8_WAIT_V(0);
    if (wr == 0) PG8_BAR;
    PG8_BAR;
#undef PG8_SA
#undef PG8_SB
#undef PG8_STAGE
#undef d2_voffA
#undef d2_voffB
#undef PG8_LDA
#undef PG8_LDB
#undef PG8_HALF
#undef PG8_MMA
#undef PG8_WAIT_V
#undef PG8_WAIT_L
#undef PG8_BAR
#undef PG8_SCHED
}
}

typedef f32x4 AccT[2][2][4][2];

struct EpiInProj {
    static constexpr bool PERM = true;
    float* out; unsigned char* ws;
    DI void operator()(const AccT& acc, const pg8::Unit& u, int wr, int wc, int fr, int fq) const {
        const int pn = u.pn, r0 = u.pm * 256 + wr * 64 + fr, ct = wc * 32 + 8 * fq;
        const bool samp = u.pm >= 128;
        if (pn == 12) {
            if (wc == 0 && fq == 0) {
                float* DT = (float*)(ws + WS_DT);
#pragma unroll
                for (int ai = 0; ai < 2; ++ai)
#pragma unroll
                    for (int m = 0; m < 4; ++m) { const int row = r0 + ai * 128 + m * 16;
                        *(f32x4*)(DT + (size_t)row * 8) = acc[ai][0][m][0]; *(f32x4*)(DT + (size_t)row * 8 + 4) = acc[ai][0][m][1]; }
            }
            return;
        }
#pragma unroll
        for (int ai = 0; ai < 2; ++ai)
#pragma unroll
            for (int m = 0; m < 4; ++m) {
                const int row = r0 + ai * 128 + m * 16;
                const int rs = row - MP, sb = rs >> 5, st = rs & 31;
                const int pb = row >> 13, pt = row & 8191;
#pragma unroll
                for (int bj = 0; bj < 2; ++bj) {
                    const f32x4 v0 = acc[ai][bj][m][0], v1 = acc[ai][bj][m][1];
                    u32x4 w; w.x = pk2(v0[0], v0[1]); w.y = pk2(v0[2], v0[3]); w.z = pk2(v1[0], v1[1]); w.w = pk2(v1[2], v1[3]);
                    const int ctile = bj * 128 + ct;
                    if (pn < 2) {
                        *(u32x4*)((bf16_t*)(ws + WS_Q) + (size_t)row * 512 + pn * 256 + ctile) = w;
                    } else if (pn < 4) {
                        const int col = (pn - 2) * 256 + ctile;
                        if (!samp) {
                            *(u32x4*)((bf16_t*)(ws + WS_KP) + (size_t)row * 512 + col) = w;
                            if (pt >= 7680) { float* o = out + O_NKP + ((size_t)(pb * 512 + pt - 7680)) * 512 + col; *(f32x4*)o = v0; *(f32x4*)(o + 4) = v1; }
                        } else {
                            *(u32x4*)((bf16_t*)(ws + WS_KS) + ((size_t)sb * 544 + 512 + st) * 512 + col) = w;
                            float* o = out + O_NKS + (size_t)rs * 512 + col; *(f32x4*)o = v0; *(f32x4*)(o + 4) = v1;
                        }
                    } else if (pn < 6) {
                        const int col = (pn - 4) * 256 + ctile, head = col >> 6, d0 = col & 63;
                        bf16_t* vb; int t;
                        if (!samp) { t = pt; vb = (bf16_t*)(ws + WS_VFP) + ((size_t)(pb * 8 + head) * 512 + (t >> 4)) * 1024;
                            if (pt >= 7680) { float* o = out + O_NVP + ((size_t)(pb * 512 + pt - 7680)) * 512 + col; *(f32x4*)o = v0; *(f32x4*)(o + 4) = v1; } }
                        else { t = 512 + st; vb = (bf16_t*)(ws + WS_VFS) + ((size_t)(sb * 8 + head) * 34 + (t >> 4)) * 1024;
                            float* o = out + O_NVS + (size_t)rs * 512 + col; *(f32x4*)o = v0; *(f32x4*)(o + 4) = v1; }
                        const int tt = t & 15, hh = (tt >> 2) & 1, jj = ((tt >> 3) << 2) | (tt & 3);
                        bf16_t* p = vb + (hh * 64 + d0) * 8 + jj;
                        p[0] = (bf16_t)(w.x & 0xffff); p[8] = (bf16_t)(w.x >> 16); p[16] = (bf16_t)(w.y & 0xffff); p[24] = (bf16_t)(w.y >> 16);
                        p[32] = (bf16_t)(w.z & 0xffff); p[40] = (bf16_t)(w.z >> 16); p[48] = (bf16_t)(w.w & 0xffff); p[56] = (bf16_t)(w.w >> 16);
                    } else if (pn < 8) {
                        *(u32x4*)((bf16_t*)(ws + WS_Z) + (size_t)row * 512 + (pn - 6) * 256 + ctile) = w;
                    } else {
                        const int col = (pn - 8) * 256 + ctile;
                        *(u32x4*)((bf16_t*)(ws + WS_XBC) + (size_t)row * 1024 + col) = w;
                        if (!samp) { if (pt >= 8189) { float* o = out + O_SCP + ((size_t)(pb * 3 + pt - 8189)) * 1024 + col; *(f32x4*)o = v0; *(f32x4*)(o + 4) = v1; } }
                        else { if (st >= 29) { float* o = out + O_SCS + ((size_t)(sb * 3 + st - 29)) * 1024 + col; *(f32x4*)o = v0; *(f32x4*)(o + 4) = v1; } }
                    }
                }
            }
    }
};

struct EpiOutProj {
    static constexpr bool PERM = false;
    const float* xp; const float* xs; bf16_t* U;
    DI void operator()(const AccT& acc, const pg8::Unit& u, int wr, int wc, int fr, int fq) const {
        const int r0 = u.pm * 256 + wr * 64 + fr, c0 = u.pn * 256 + wc * 32 + 4 * fq;
#pragma unroll
        for (int ai = 0; ai < 2; ++ai) {
            f32x4 xv[4][2][2];
#pragma unroll
            for (int m = 0; m < 4; ++m) { const int row = r0 + ai * 128 + m * 16; const float* xr = (row < MP) ? xp + (size_t)row * 1024 : xs + (size_t)(row - MP) * 1024;
#pragma unroll
                for (int bj = 0; bj < 2; ++bj)
#pragma unroll
                    for (int n = 0; n < 2; ++n) xv[m][bj][n] = *(const f32x4*)(xr + c0 + bj * 128 + n * 16); }
#pragma unroll
            for (int m = 0; m < 4; ++m)
#pragma unroll
                for (int bj = 0; bj < 2; ++bj)
#pragma unroll
                    for (int n = 0; n < 2; ++n) pin(xv[m][bj][n]);
#pragma unroll
            for (int m = 0; m < 4; ++m) { const int row = r0 + ai * 128 + m * 16; bf16_t* ur = U + (size_t)row * 1024;
#pragma unroll
                for (int bj = 0; bj < 2; ++bj)
#pragma unroll
                    for (int n = 0; n < 2; ++n) { const f32x4 o = xv[m][bj][n] * ALPHA + acc[ai][bj][m][n];
                        u32x2 w; w.x = pk2(o[0], o[1]); w.y = pk2(o[2], o[3]); *(u32x2*)(ur + c0 + bj * 128 + n * 16) = w; } }
        }
    }
};
struct EpiDown {
    static constexpr bool PERM = false;
    const bf16_t* X1; bf16_t* U;
    DI void operator()(const AccT& acc, const pg8::Unit& u, int wr, int wc, int fr, int fq) const {
        const int r0 = u.pm * 256 + wr * 64 + fr, c0 = u.pn * 256 + wc * 32 + 4 * fq;
        u32x2 xw[2][4][2][2];
#pragma unroll
        for (int ai = 0; ai < 2; ++ai)
#pragma unroll
            for (int m = 0; m < 4; ++m) { const bf16_t* xr = X1 + (size_t)(r0 + ai * 128 + m * 16) * 1024;
#pragma unroll
                for (int bj = 0; bj < 2; ++bj)
#pragma unroll
                    for (int n = 0; n < 2; ++n) xw[ai][m][bj][n] = *(const u32x2*)(xr + c0 + bj * 128 + n * 16); }
#pragma unroll
        for (int ai = 0; ai < 2; ++ai)
#pragma unroll
            for (int m = 0; m < 4; ++m)
#pragma unroll
                for (int bj = 0; bj < 2; ++bj)
#pragma unroll
                    for (int n = 0; n < 2; ++n) pin(xw[ai][m][bj][n]);
#pragma unroll
        for (int ai = 0; ai < 2; ++ai)
#pragma unroll
            for (int m = 0; m < 4; ++m) { bf16_t* ur = U + (size_t)(r0 + ai * 128 + m * 16) * 1024;
#pragma unroll
                for (int bj = 0; bj < 2; ++bj)
#pragma unroll
                    for (int n = 0; n < 2; ++n) { const u32x2 w = xw[ai][m][bj][n];
                        const f32x4 xv = {bf_lo(w.x), bf_hi(w.x), bf_lo(w.y), bf_hi(w.y)}; const f32x4 o = xv * ALPHA + acc[ai][bj][m][n];
                        u32x2 wo; wo.x = pk2(o[0], o[1]); wo.y = pk2(o[2], o[3]); *(u32x2*)(ur + c0 + bj * 128 + n * 16) = wo; } }
    }
};

DI float dpp_shr1(float v) { return __builtin_bit_cast(float, __builtin_amdgcn_update_dpp(0, __builtin_bit_cast(int, v), 0x111, 0xf, 0xf, false)); }
template <bool SAMP> struct EpiUp {
    static constexpr bool PERM = true;
    unsigned char* G8; bf16_t* GS; const float* cw; const float* cb; const float* past; float* onf;
    DI void operator()(const AccT& acc, const pg8::Unit& u, int wr, int wc, int fr, int fq) const {
        const int colv = u.pn * 128 + wc * 32 + 8 * fq;
        int bb, tb; long grow0;
        if (!SAMP) { bb = u.pm / 33; const int ti = u.pm - bb * 33; tb = ti * 252 + wr * 126 + fr * 8 - 2; grow0 = (long)bb * 8192 + tb; }
        else { const int lg = wr * 16 + fr; bb = u.pm * 8 + (lg >> 2); tb = (lg & 3) * 8; grow0 = (long)bb * 32 + tb; }
        const bool first = SAMP ? ((fr & 3) == 0) : (fr == 0);
        const float asc = SAMP ? 1.0f : 1.0f / (SC_X1 * SC_WUP);
#pragma unroll
        for (int n = 0; n < 2; ++n) {
            const int cv = colv + 4 * n, cgt = DFF + cv;
            const f32x4 wv0 = *(const f32x4*)(cw + cv), wv1 = *(const f32x4*)(cw + NUP + cv), wv2 = *(const f32x4*)(cw + 2 * NUP + cv), bv = *(const f32x4*)(cb + cv);
            const f32x4 wg0 = *(const f32x4*)(cw + cgt), wg1 = *(const f32x4*)(cw + NUP + cgt), wg2 = *(const f32x4*)(cw + 2 * NUP + cgt), bg = *(const f32x4*)(cb + cgt);
            f32x4 hv[8], hg[8];
#pragma unroll
            for (int tau = 0; tau < 8; ++tau) { hv[tau] = acc[tau >> 2][0][tau & 3][n] * asc; hg[tau] = acc[tau >> 2][1][tau & 3][n] * asc; }
            if (SAMP) {
                if ((fr & 3) == 3) { float* o = onf + ((size_t)(bb * 2)) * NUP; *(f32x4*)(o + cv) = hv[6]; *(f32x4*)(o + cgt) = hg[6]; *(f32x4*)(o + NUP + cv) = hv[7]; *(f32x4*)(o + NUP + cgt) = hg[7]; }
            }
            if (!SAMP) { if (tb < 0) { hv[0] = (f32x4){0.f, 0.f, 0.f, 0.f}; hv[1] = hv[0]; hg[0] = hv[0]; hg[1] = hv[0]; } }
            f32x4 pv2, pv1, pg2, pg1;
#pragma unroll
            for (int j = 0; j < 4; ++j) { pv2[j] = dpp_shr1(hv[6][j]); pv1[j] = dpp_shr1(hv[7][j]); pg2[j] = dpp_shr1(hg[6][j]); pg1[j] = dpp_shr1(hg[7][j]); }
            if (SAMP) { if (first) { const float* ps = past + (size_t)bb * 2 * NUP; pv2 = *(const f32x4*)(ps + cv); pv1 = *(const f32x4*)(ps + NUP + cv); pg2 = *(const f32x4*)(ps + cgt); pg1 = *(const f32x4*)(ps + NUP + cgt); } }
#pragma unroll
            for (int tau = 0; tau < 8; ++tau) {
                const f32x4 a2v = (tau >= 2) ? hv[tau >= 2 ? tau - 2 : 0] : (tau == 0 ? pv2 : pv1);
                const f32x4 a1v = (tau >= 1) ? hv[tau >= 1 ? tau - 1 : 0] : pv1;
                const f32x4 a2g = (tau >= 2) ? hg[tau >= 2 ? tau - 2 : 0] : (tau == 0 ? pg2 : pg1);
                const f32x4 a1g = (tau >= 1) ? hg[tau >= 1 ? tau - 1 : 0] : pg1;
                const f32x4 ov = bv + wv0 * a2v + wv1 * a1v + wv2 * hv[tau];
                const f32x4 og = bg + wg0 * a2g + wg1 * a1g + wg2 * hg[tau];
                const float g0 = ov[0] * silu_f(og[0]), g1 = ov[1] * silu_f(og[1]), g2 = ov[2] * silu_f(og[2]), g3 = ov[3] * silu_f(og[3]);
                if (!SAMP) { const int t = tb + tau; const bool ok = (t >= 0) && (t < 8192) && (fr > 0 || tau >= 2);
                    const unsigned off = ok ? (unsigned)(((int)grow0 + tau) * DFF + cv) * 2u : (unsigned)((size_t)MP * DFF * 2) + (unsigned)(fr + 16 * fq) * 8u;
                    u32x2 w; w.x = pk2(g0, g1); w.y = pk2(g2, g3); *(u32x2*)(G8 + off) = w; }
                else { u32x2 w; w.x = pk2(g0, g1); w.y = pk2(g2, g3); *(u32x2*)(GS + (size_t)(grow0 + tau) * DFF + cv) = w; }
            }
        }
    }
};

DI f32x16 small_block_p(const bf16_t* xp, const bf16_t* wp, int K);
DI f32x16 small_block(const bf16_t* X, const bf16_t* Wt, int K, int row0, int col0, int lane) {
    const int r = lane & 31, h2 = lane >> 5;
    return small_block_p(X + (size_t)(row0 + r) * K + 8 * h2, Wt + (size_t)(col0 + r) * K + 8 * h2, K);
}
DI f32x16 small_block_p(const bf16_t* xp, const bf16_t* wp, int K) {
    f32x16 acc;
#pragma unroll
    for (int i = 0; i < 16; ++i) acc[i] = 0.f;
    int k0 = 0;
#pragma unroll 1
    for (; k0 + 256 <= K; k0 += 256) {
        bf16x8 a[16], b[16];
#pragma unroll
        for (int j = 0; j < 16; ++j) { a[j] = *(const bf16x8*)(wp + k0 + 16 * j); b[j] = *(const bf16x8*)(xp + k0 + 16 * j); }
#pragma unroll
        for (int j = 0; j < 16; ++j) { pin(a[j]); pin(b[j]); }
#pragma unroll
        for (int j = 0; j < 16; ++j) acc = MFMA32(a[j], b[j], acc);
    }
    if (k0 < K) {
        bf16x8 a[8], b[8];
#pragma unroll
        for (int j = 0; j < 8; ++j) { a[j] = *(const bf16x8*)(wp + k0 + 16 * j); b[j] = *(const bf16x8*)(xp + k0 + 16 * j); }
#pragma unroll
        for (int j = 0; j < 8; ++j) { pin(a[j]); pin(b[j]); }
#pragma unroll
        for (int j = 0; j < 8; ++j) acc = MFMA32(a[j], b[j], acc);
    }
    return acc;
}
DI void small_inproj(KP P) {
    int tid = threadIdx.x; asm volatile("" : "+v"(tid));
    const int lane = tid & 63, wave = tid >> 6, gw = blockIdx.x * 8 + wave, NGW = gridDim.x * 8, r = lane & 31, h2 = lane >> 5;
    const bf16_t* XB = (const bf16_t*)(P->ws + WS_XB); const bf16_t* WI = (const bf16_t*)(P->ws + WS_WIN);
    float* DT = (float*)(P->ws + WS_DT); float* out = P->out;
    for (int task = gw; task < 1024 + 16 * 97; task += NGW) {
        if (task < 1024) {
            const f32x16 acc = small_block(XB, WI, 1024, task * 32, 3072, lane);
            *(f32x4*)(DT + (size_t)(task * 32 + r) * 8 + 4 * h2) = (f32x4){acc[0], acc[1], acc[2], acc[3]};
            continue;
        }
        const int t2 = task - 1024, sb = t2 / 97, cb = t2 - sb * 97, row = MP + sb * 32 + r, col0 = cb * 32;
        const f32x16 acc = small_block(XB, WI, 1024, MP + sb * 32, col0, lane);
#pragma unroll
        for (int g = 0; g < 4; ++g) {
            const int col = col0 + 8 * g + 4 * h2; const f32x4 v = {acc[4 * g], acc[4 * g + 1], acc[4 * g + 2], acc[4 * g + 3]};
            u32x2 w; w.x = pk2(v[0], v[1]); w.y = pk2(v[2], v[3]);
            if (col < 512) *(u32x2*)((bf16_t*)(P->ws + WS_Q) + (size_t)row * 512 + col) = w;
            else if (col < 1024) { *(u32x2*)((bf16_t*)(P->ws + WS_KS) + ((size_t)sb * 544 + 512 + r) * 512 + col - 512) = w; *(f32x4*)(out + O_NKS + (size_t)(sb * 32 + r) * 512 + col - 512) = v; }
            else if (col < 1536) { const int c = col - 1024, head = c >> 6, d0 = c & 63, t = 512 + r, tt = t & 15, hh = (tt >> 2) & 1, jj = ((tt >> 3) << 2) | (tt & 3);
                bf16_t* p = (bf16_t*)(P->ws + WS_VFS) + ((size_t)(sb * 8 + head) * 34 + (t >> 4)) * 1024 + (hh * 64 + d0) * 8 + jj;
                p[0] = (bf16_t)(w.x & 0xffff); p[8] = (bf16_t)(w.x >> 16); p[16] = (bf16_t)(w.y & 0xffff); p[24] = (bf16_t)(w.y >> 16);
                *(f32x4*)(out + O_NVS + (size_t)(sb * 32 + r) * 512 + c) = v; }
            else if (col < 2048) *(u32x2*)((bf16_t*)(P->ws + WS_Z) + (size_t)row * 512 + col - 1536) = w;
            else if (col < 3072) { *(u32x2*)((bf16_t*)(P->ws + WS_XBC) + (size_t)row * 1024 + col - 2048) = w;
                if (r >= 29) *(f32x4*)(out + O_SCS + ((size_t)(sb * 3 + r - 29)) * 1024 + col - 2048) = v; }
            else if (col < 3080) *(f32x4*)(DT + (size_t)row * 8 + col - 3072) = v;
        }
    }
}
DI void small_down_splitk(KP P, LAS unsigned char* lds, int tid_in) {
    int tid = tid_in; asm volatile("" : "+v"(tid));
    const int lane = tid & 63, wave = __builtin_amdgcn_readfirstlane(tid >> 6), r = lane & 31, h2 = lane >> 5;
    const int tl = wave / 3, kq = wave - 3 * tl;
    const bf16_t* X = (const bf16_t*)(P->ws + WS_GS); const bf16_t* Wt = (const bf16_t*)(P->ws + WS_WDOWN);
    LAS float* part = (LAS float*)lds;
    for (int pair = blockIdx.x; pair < 256; pair += gridDim.x) {
        const int task = pair * 2 + tl, sb = task >> 5, cb = task & 31, col0 = cb * 32;
        __syncthreads();
        if (tl < 2) {
            const f32x16 acc = small_block_p(X + (size_t)(sb * 32 + r) * DFF + kq * 896 + 8 * h2, Wt + (size_t)(col0 + r) * DFF + kq * 896 + 8 * h2, 896);
#pragma unroll
            for (int i = 0; i < 16; ++i) part[((tl * 3 + kq) * 16 + i) * 64 + lane] = acc[i];
        }
        __syncthreads();
        if (tl < 2 && kq == 0) {
            const int row = MP + sb * 32 + r;
#pragma unroll
            for (int g = 0; g < 4; ++g) {
                f32x4 v;
#pragma unroll
                for (int e = 0; e < 4; ++e) { const int i = 4 * g + e; v[e] = part[((tl * 3 + 0) * 16 + i) * 64 + lane] + part[((tl * 3 + 1) * 16 + i) * 64 + lane] + part[((tl * 3 + 2) * 16 + i) * 64 + lane]; }
                const int col = col0 + 8 * g + 4 * h2;
                const u32x2 w = *(const u32x2*)((const bf16_t*)(P->ws + WS_XB) + (size_t)row * 1024 + col); const f32x4 xv = {bf_lo(w.x), bf_hi(w.x), bf_lo(w.y), bf_hi(w.y)};
                const f32x4 o = xv * ALPHA + v; u32x2 wo; wo.x = pk2(o[0], o[1]); wo.y = pk2(o[2], o[3]);
                *(u32x2*)((bf16_t*)(P->ws + WS_A2) + (size_t)row * 1024 + col) = wo;
            }
        }
    }
}
DI void small_out_splitk(KP P, LAS unsigned char* lds, int tid_in) {
    int tid = tid_in; asm volatile("" : "+v"(tid));
    const int lane = tid & 63, wave = __builtin_amdgcn_readfirstlane(tid >> 6), r = lane & 31, h2 = lane >> 5;
    const int tl = wave >> 2, kq = wave & 3;
    const bf16_t* X = (const bf16_t*)(P->ws + WS_A2); const bf16_t* Wt = (const bf16_t*)(P->ws + WS_WOUT);
    LAS float* part = (LAS float*)lds;
    for (int pair = blockIdx.x; pair < 256; pair += gridDim.x) {
        const int task = pair * 2 + tl, sb = task >> 5, cb = task & 31, col0 = cb * 32;
        __syncthreads();
        const f32x16 acc = small_block_p(X + (size_t)(MP + sb * 32 + r) * 1024 + kq * 256 + 8 * h2, Wt + (size_t)(col0 + r) * 1024 + kq * 256 + 8 * h2, 256);
#pragma unroll
        for (int i = 0; i < 16; ++i) part[((tl * 4 + kq) * 16 + i) * 64 + lane] = acc[i];
        __syncthreads();
        if (kq == 0) {
            const int row = MP + sb * 32 + r;
#pragma unroll
            for (int g = 0; g < 4; ++g) {
                f32x4 v;
#pragma unroll
                for (int e = 0; e < 4; ++e) { const int i = 4 * g + e; v[e] = (part[((tl * 4 + 0) * 16 + i) * 64 + lane] + part[((tl * 4 + 1) * 16 + i) * 64 + lane]) + (part[((tl * 4 + 2) * 16 + i) * 64 + lane] + part[((tl * 4 + 3) * 16 + i) * 64 + lane]); }
                const int col = col0 + 8 * g + 4 * h2;
                const f32x4 xv = *(const f32x4*)(P->in[1] + (size_t)(row - MP) * 1024 + col);
                const f32x4 o = xv * ALPHA + v; u32x2 wo; wo.x = pk2(o[0], o[1]); wo.y = pk2(o[2], o[3]);
                *(u32x2*)((bf16_t*)(P->out + O_Y) + (size_t)row * 1024 + col) = wo;
            }
        }
    }
}
DI void small_ffnconv_prompt(KP P, LAS unsigned char* lds, int tid_in) {
    int tid = tid_in; asm volatile("" : "+v"(tid));
    const int lane = tid & 63, kq = __builtin_amdgcn_readfirstlane(tid >> 6), r = lane & 31, h2 = lane >> 5;
    const bf16_t* X1 = (const bf16_t*)(P->ws + WS_XB); const bf16_t* WU = (const bf16_t*)(P->ws + WS_WUP);
    const int rr = r & 7, b = rr >> 1, t = 8190 + (rr & 1);
    LAS float* part = (LAS float*)lds;
    for (int task = blockIdx.x; task < 168; task += gridDim.x) {
        const int rho0 = task * 32, n0 = ((rho0 >> 7) & 1) * DFF + (rho0 >> 8) * 128 + (rho0 & 127);
        __syncthreads();
        const f32x16 acc = small_block_p(X1 + ((size_t)b * 8192 + t) * 1024 + kq * 128 + 8 * h2, WU + (size_t)(rho0 + r) * 1024 + kq * 128 + 8 * h2, 128);
#pragma unroll
        for (int i = 0; i < 16; ++i) part[(kq * 16 + i) * 64 + lane] = acc[i];
        __syncthreads();
        if (kq == 0 && r < 8) {
#pragma unroll
            for (int g = 0; g < 4; ++g) { f32x4 v;
#pragma unroll
                for (int e = 0; e < 4; ++e) { float s = 0.f;
#pragma unroll
                    for (int q = 0; q < 8; ++q) s += part[(q * 16 + 4 * g + e) * 64 + lane];
                    v[e] = s; }
                *(f32x4*)(P->out + O_FCP + (size_t)(b * 2 + (rr & 1)) * NUP + n0 + 8 * g + 4 * h2) = v; }
        }
    }
}
template <bool DOWN> DI void small_resid(KP P, int tid_in) {
    int tid = tid_in; asm volatile("" : "+v"(tid));
    const int lane = tid & 63, wave = tid >> 6, gw = blockIdx.x * 8 + wave, NGW = gridDim.x * 8, r = lane & 31, h2 = lane >> 5;
    const bf16_t* X = DOWN ? (const bf16_t*)(P->ws + WS_GS) - (size_t)MP * DFF : (const bf16_t*)(P->ws + WS_A2); const bf16_t* Wt = (const bf16_t*)(P->ws + (DOWN ? WS_WDOWN : WS_WOUT));
    const int K = DOWN ? DFF : 1024;
    for (int task = gw; task < 512; task += NGW) {
        const int sb = task >> 5, cb = task & 31, row = MP + sb * 32 + r, col0 = cb * 32;
        const f32x16 acc = small_block(X, Wt, K, MP + sb * 32, col0, lane);
#pragma unroll
        for (int g = 0; g < 4; ++g) {
            const int col = col0 + 8 * g + 4 * h2; const f32x4 v = {acc[4 * g], acc[4 * g + 1], acc[4 * g + 2], acc[4 * g + 3]};
            f32x4 xv;
            if (DOWN) { const u32x2 w = *(const u32x2*)((const bf16_t*)(P->ws + WS_XB) + (size_t)row * 1024 + col); xv = (f32x4){bf_lo(w.x), bf_hi(w.x), bf_lo(w.y), bf_hi(w.y)}; }
            else xv = *(const f32x4*)(P->in[1] + (size_t)(row - MP) * 1024 + col);
            bf16_t* U = DOWN ? (bf16_t*)(P->ws + WS_A2) : (bf16_t*)(P->out + O_Y);
            const f32x4 o = xv * ALPHA + v; u32x2 wo; wo.x = pk2(o[0], o[1]); wo.y = pk2(o[2], o[3]); *(u32x2*)(U + (size_t)row * 1024 + col) = wo;
        }
    }
}

DI void p0_transpose_item(const float* W, int K, int N, bf16_t* WT, int drow0, LAS float* scr, int k0, int n0, int lane) {
    const int nn = n0 + (lane & 31); const int nc = (nn < N) ? nn : N - 1;
    float tv[32];
#pragma unroll
    for (int i = 0; i < 32; ++i) tv[i] = W[(size_t)(k0 + 2 * i + (lane >> 5)) * N + nc];
#pragma unroll
    for (int i = 0; i < 32; ++i) scr[(2 * i + (lane >> 5)) * 33 + (lane & 31)] = tv[i];
    asm volatile("s_waitcnt lgkmcnt(0)" ::: "memory");
    const int c = lane & 7;
#pragma unroll
    for (int j = 0; j < 4; ++j) { const int n = (lane >> 3) + 8 * j; const LAS float* s = scr + (8 * c) * 33 + n;
        u32x4 o; o.x = pk2(s[0 * 33], s[1 * 33]); o.y = pk2(s[2 * 33], s[3 * 33]); o.z = pk2(s[4 * 33], s[5 * 33]); o.w = pk2(s[6 * 33], s[7 * 33]);
        if (n0 + n < N) *(u32x4*)(WT + (size_t)(drow0 + n) * K + k0 + 8 * c) = o; }
    asm volatile("s_waitcnt lgkmcnt(0)" ::: "memory");
}
DI void p0_transpose_item_f8(const float* W, int K, int N, unsigned char* WT, int pitch, int drow0, LAS float* scr, int k0, int n0, int lane, float sc) {
    const int nn = n0 + (lane & 31); const int nc = (nn < N) ? nn : N - 1;
    float tv[32];
#pragma unroll
    for (int i = 0; i < 32; ++i) tv[i] = W[(size_t)(k0 + 2 * i + (lane >> 5)) * N + nc];
#pragma unroll
    for (int i = 0; i < 32; ++i) scr[(2 * i + (lane >> 5)) * 33 + (lane & 31)] = tv[i] * sc;
    asm volatile("s_waitcnt lgkmcnt(0)" ::: "memory");
    const int c = lane & 7;
#pragma unroll
    for (int j = 0; j < 4; ++j) { const int n = (lane >> 3) + 8 * j; const LAS float* s = scr + (8 * c) * 33 + n;
        u32x2 o; o.x = pk4_f8(s[0 * 33], s[1 * 33], s[2 * 33], s[3 * 33]); o.y = pk4_f8(s[4 * 33], s[5 * 33], s[6 * 33], s[7 * 33]);
        if (n0 + n < N) *(u32x2*)(WT + (size_t)(drow0 + n) * pitch + k0 + 8 * c) = o; }
    asm volatile("s_waitcnt lgkmcnt(0)" ::: "memory");
}
constexpr int LATE_ITEMS = 16 * 32 + 16 * 168 + 42 * 32, LATE_WG_ITEMS = LATE_ITEMS / 64;
DI void convert_late_item(KP P, LAS unsigned char* lds, int wi) {
    int tid = threadIdx.x; asm volatile("" : "+v"(tid));
    const int lane = tid & 63, wave = tid >> 6;
    __syncthreads();
    LAS float* scr = (LAS float*)(lds + wave * 8448);
    constexpr int I_OUT = 16 * 32, I_UP = 16 * 168;
#pragma unroll 1
    for (int j = 0; j < 8; ++j) {
        int r = wi * 64 + wave * 8 + j;
        if (r < I_OUT) { const int kb = r / 32, nb = r % 32; p0_transpose_item(P->in[16], 1024, 1024, (bf16_t*)(P->ws + WS_WOUT), nb * 32, scr, kb * 64, nb * 32, lane); continue; } r -= I_OUT;
        if (r < I_UP) { const int kb = r / 168, nb = r % 168; const int n0 = nb * 32; const int np = (n0 < DFF) ? n0 : n0 - DFF;
            const int drow = (np >> 7) * 256 + ((n0 < DFF) ? 0 : 128) + (np & 127);
            p0_transpose_item(P->in[19], 1024, NUP, (bf16_t*)(P->ws + WS_WUP), drow, scr, kb * 64, n0, lane);
            p0_transpose_item_f8(P->in[19], 1024, NUP, P->ws + WS_WUP8, 1024, drow, scr, kb * 64, n0, lane, SC_WUP); continue; } r -= I_UP;
        { const int kb = r / 32, nb = r % 32; p0_transpose_item(P->in[22], DFF, 1024, (bf16_t*)(P->ws + WS_WDOWN), nb * 32, scr, kb * 64, nb * 32, lane); }
    }
}
DI void phase_convert(KP P, LAS unsigned char* lds) {
    int tid = threadIdx.x; asm volatile("" : "+v"(tid));
    const int lane = tid & 63, wave = tid >> 6, G = gridDim.x;
    LAS float* scr = (LAS float*)(lds + wave * 8448);
    const int gw = blockIdx.x * 8 + wave, NGW = G * 8;
    constexpr int I_IN = 16 * 97;
    for (int it = gw; it < I_IN; it += NGW) { const int kb = it / 97, nb = it % 97; p0_transpose_item(P->in[7], 1024, NIN, (bf16_t*)(P->ws + WS_WIN), nb * 32, scr, kb * 64, nb * 32, lane); }
    const size_t gt = (size_t)blockIdx.x * NT + tid, NGT = (size_t)G * NT;
    { bf16_t* XB = (bf16_t*)(P->ws + WS_XB);
      constexpr size_t NCH = (size_t)MT * 128;
      size_t i0 = gt;
      for (; i0 + 3 * NGT < NCH; i0 += 4 * NGT) {
          f32x4 a[4], b[4];
#pragma unroll
          for (int u = 0; u < 4; ++u) { const size_t e = (i0 + u * NGT) * 8; const float* src = (e < (size_t)MP * 1024) ? P->in[0] + e : P->in[1] + (e - (size_t)MP * 1024);
              a[u] = *(const f32x4*)src; b[u] = *(const f32x4*)(src + 4); }
#pragma unroll
          for (int u = 0; u < 4; ++u) { pin(a[u]); pin(b[u]); }
#pragma unroll
          for (int u = 0; u < 4; ++u) { u32x4 w; w.x = pk2(a[u][0], a[u][1]); w.y = pk2(a[u][2], a[u][3]); w.z = pk2(b[u][0], b[u][1]); w.w = pk2(b[u][2], b[u][3]); *(u32x4*)(XB + (i0 + u * NGT) * 8) = w; }
      }
      for (; i0 < NCH; i0 += NGT) { const size_t e = i0 * 8; const float* src = (e < (size_t)MP * 1024) ? P->in[0] + e : P->in[1] + (e - (size_t)MP * 1024);
          const f32x4 a = *(const f32x4*)src, b = *(const f32x4*)(src + 4); u32x4 w; w.x = pk2(a[0], a[1]); w.y = pk2(a[2], a[3]); w.z = pk2(b[0], b[1]); w.w = pk2(b[2], b[3]); *(u32x4*)(XB + e) = w; }
    }
    { bf16_t* WI = (bf16_t*)(P->ws + WS_WIN) + (size_t)NIN * 1024;
      for (size_t i = gt; i < (size_t)(NINP - NIN) * 128; i += NGT) *(u32x4*)(WI + i * 8) = (u32x4){0u, 0u, 0u, 0u}; }
    { bf16_t* KS = (bf16_t*)(P->ws + WS_KS); bf16_t* VF = (bf16_t*)(P->ws + WS_VFS);
      for (size_t i = gt; i < (size_t)16 * 512 * 64; i += NGT) {
          const int cgp = (int)(i & 63), t = (int)((i >> 6) & 511), b = (int)(i >> 15);
          const float* ks = P->in[2] + ((size_t)(b * 512 + t)) * 512 + cgp * 8; const float* vs = P->in[3] + ((size_t)(b * 512 + t)) * 512 + cgp * 8;
          const f32x4 a = *(const f32x4*)ks, c = *(const f32x4*)(ks + 4); u32x4 w; w.x = pk2(a[0], a[1]); w.y = pk2(a[2], a[3]); w.z = pk2(c[0], c[1]); w.w = pk2(c[2], c[3]);
          *(u32x4*)(KS + ((size_t)b * 544 + t) * 512 + cgp * 8) = w;
          const f32x4 va = *(const f32x4*)vs, vc = *(const f32x4*)(vs + 4);
          const int head = cgp >> 3, d0 = (cgp & 7) * 8, tt = t & 15, hh = (tt >> 2) & 1, jj = ((tt >> 3) << 2) | (tt & 3);
          bf16_t* p = VF + ((size_t)(b * 8 + head) * 34 + (t >> 4)) * 1024 + (hh * 64 + d0) * 8 + jj;
          const unsigned w0 = pk2(va[0], va[1]), w1 = pk2(va[2], va[3]), w2 = pk2(vc[0], vc[1]), w3 = pk2(vc[2], vc[3]);
          p[0] = (bf16_t)(w0 & 0xffff); p[8] = (bf16_t)(w0 >> 16); p[16] = (bf16_t)(w1 & 0xffff); p[24] = (bf16_t)(w1 >> 16);
          p[32] = (bf16_t)(w2 & 0xffff); p[40] = (bf16_t)(w2 >> 16); p[48] = (bf16_t)(w3 & 0xffff); p[56] = (bf16_t)(w3 >> 16);
      } }
}

template <bool OUT_BF16>
DI void phase_ln(const bf16_t* src, const float* gam, const float* bet, void* dst, unsigned char* dst8, unsigned char* g8pad, int tid_in) {
    int tid = tid_in; asm volatile("" : "+v"(tid));
    const int lane = tid & 63, wave = tid >> 6, gw = blockIdx.x * 8 + wave, NGW = gridDim.x * 8;
    f32x4 g4[4], b4[4];
#pragma unroll
    for (int j = 0; j < 4; ++j) { g4[j] = *(const f32x4*)(gam + (lane + 64 * j) * 4); b4[j] = *(const f32x4*)(bet + (lane + 64 * j) * 4); }
    for (int row0 = gw; row0 < MT; row0 += 2 * NGW) {
        u32x2 wv[2][4];
#pragma unroll
        for (int u = 0; u < 2; ++u) { const int row = row0 + u * NGW;
#pragma unroll
            for (int j = 0; j < 4; ++j) { wv[u][j] = (u32x2){0u, 0u}; if (row < MT) wv[u][j] = *(const u32x2*)(src + (size_t)row * 1024 + (lane + 64 * j) * 4); } }
#pragma unroll
        for (int u = 0; u < 2; ++u) { const int row = row0 + u * NGW; if (row >= MT) continue;
            f32x4 v[4]; float s = 0.f;
#pragma unroll
            for (int j = 0; j < 4; ++j) { const u32x2 w = wv[u][j]; v[j] = (f32x4){bf_lo(w.x), bf_hi(w.x), bf_lo(w.y), bf_hi(w.y)}; s += (v[j][0] + v[j][1]) + (v[j][2] + v[j][3]); }
#pragma unroll
            for (int o = 1; o < 64; o <<= 1) s += __shfl_xor(s, o);
            const float mean = s * (1.f / 1024.f); float q = 0.f;
#pragma unroll
            for (int j = 0; j < 4; ++j) { v[j] = v[j] - mean; q += (v[j][0] * v[j][0] + v[j][1] * v[j][1]) + (v[j][2] * v[j][2] + v[j][3] * v[j][3]); }
#pragma unroll
            for (int o = 1; o < 64; o <<= 1) q += __shfl_xor(q, o);
            const float rstd = 1.0f / sqrtf(q * (1.f / 1024.f) + 1e-5f);
#pragma unroll
            for (int j = 0; j < 4; ++j) { const f32x4 o = v[j] * rstd * g4[j] + b4[j];
                if (OUT_BF16) { u32x2 w; w.x = pk2(o[0], o[1]); w.y = pk2(o[2], o[3]); *(u32x2*)((bf16_t*)dst + (size_t)row * 1024 + (lane + 64 * j) * 4) = w;
                    *(unsigned*)(dst8 + (size_t)row * 1024 + (lane + 64 * j) * 4) = pk4_f8(o[0] * SC_X1, o[1] * SC_X1, o[2] * SC_X1, o[3] * SC_X1); }
                else *(f32x4*)((float*)dst + (size_t)row * 1024 + (lane + 64 * j) * 4) = o; }
        }
    }
}

constexpr int XCS = 2080;
constexpr int L_DT = 64 * XCS;
constexpr int L_AC = L_DT + 2048;
constexpr int L_RED = L_AC + 2048;

DI float ssd_dt_scan(KP P, LAS unsigned char* lds, int r0, int Lv, int h, int lane) {
    const float* DT = (const float*)(P->ws + WS_DT);
    float dt = 0.f;
    if (lane < Lv) { const float x = DT[(size_t)(r0 + lane) * 8 + h] + P->in[12][h]; dt = (x > 20.f) ? x : log1pf(expf(x)); }
    const float A = -expf(P->in[13][h]);
    float a = dt * A;
#pragma unroll
    for (int off = 1; off < 64; off <<= 1) { const float v = __shfl_up(a, off); if (lane >= off) a += v; }
    ((LAS float*)(lds + L_DT))[h * 64 + lane] = dt;
    ((LAS float*)(lds + L_AC))[h * 64 + lane] = a;
    return __shfl(a, 63);
}
template <bool DEC, int NCG>
DI void ssd_conv_to_lds(KP P, LAS unsigned char* lds, int tid, int r0, int Lv, bool samp, int sb, bool has_prev) {
    const int tblk = tid >> 7, cgp = tid & 127;
    if (cgp >= NCG) return;
    const int ch0 = cgp * 8, t0 = tblk * 16;
    const bf16_t* XBC = (const bf16_t*)(P->ws + WS_XBC);
    const float* cwp = P->in[10]; const float* cbp = P->in[11];
    float w[4][8], bias[8];
#pragma unroll
    for (int k = 0; k < 4; ++k) { const f32x4 a = *(const f32x4*)(cwp + k * 1024 + ch0), b = *(const f32x4*)(cwp + k * 1024 + ch0 + 4);
#pragma unroll
        for (int e = 0; e < 4; ++e) { w[k][e] = a[e]; w[k][4 + e] = b[e]; } }
    { const f32x4 a = *(const f32x4*)(cbp + ch0), b = *(const f32x4*)(cbp + ch0 + 4);
#pragma unroll
        for (int e = 0; e < 4; ++e) { bias[e] = a[e]; bias[4 + e] = b[e]; } }
    u32x4 raw[19]; f32x4 pa[3], pb[3];
    const bool halo_f32 = samp && (t0 == 0);
#pragma unroll
    for (int k = 0; k < 19; ++k) {
        const int tt = t0 - 3 + k;
        raw[k] = (u32x4){0u, 0u, 0u, 0u};
        if (tt >= 0) { if (tt < Lv) raw[k] = *(const u32x4*)(XBC + (size_t)(r0 + tt) * 1024 + ch0); }
        else if (!samp && has_prev) raw[k] = *(const u32x4*)(XBC + (size_t)(r0 + tt) * 1024 + ch0);
    }
#pragma unroll
    for (int k = 0; k < 3; ++k) { pa[k] = (f32x4){0.f, 0.f, 0.f, 0.f}; pb[k] = pa[k];
        if (halo_f32) { const float* s = P->in[5] + ((size_t)(sb * 3 + k)) * 1024 + ch0; pa[k] = *(const f32x4*)s; pb[k] = *(const f32x4*)(s + 4); } }
    float xw[3][8];
#pragma unroll
    for (int k = 0; k < 3; ++k) {
        const u32x4 q = raw[k];
        xw[k][0] = bf_lo(q.x); xw[k][1] = bf_hi(q.x); xw[k][2] = bf_lo(q.y); xw[k][3] = bf_hi(q.y); xw[k][4] = bf_lo(q.z); xw[k][5] = bf_hi(q.z); xw[k][6] = bf_lo(q.w); xw[k][7] = bf_hi(q.w);
        if (halo_f32) {
#pragma unroll
            for (int e = 0; e < 4; ++e) { xw[k][e] = pa[k][e]; xw[k][4 + e] = pb[k][e]; } }
    }
    const int head = cgp >> 3;
    const LAS float* sdt = (const LAS float*)(lds + L_DT) + head * 64; const LAS float* sac = (const LAS float*)(lds + L_AC) + head * 64;
    const float atot = (cgp < 64) ? sac[63] : 0.f;
#pragma unroll
    for (int i = 0; i < 16; ++i) {
        const int t = t0 + i; float xc[8];
        { const u32x4 q = raw[3 + i];
          xc[0] = bf_lo(q.x); xc[1] = bf_hi(q.x); xc[2] = bf_lo(q.y); xc[3] = bf_hi(q.y); xc[4] = bf_lo(q.z); xc[5] = bf_hi(q.z); xc[6] = bf_lo(q.w); xc[7] = bf_hi(q.w); }
        float f = 1.f;
        if (cgp < 64) { f = sdt[t]; if (DEC) f *= __builtin_amdgcn_exp2f((atot - sac[t]) * LOG2E); }
        if (t >= Lv) f = 0.f;
        float o[8];
#pragma unroll
        for (int e = 0; e < 8; ++e) { const float v = bias[e] + w[0][e] * xw[0][e] + w[1][e] * xw[1][e] + w[2][e] * xw[2][e] + w[3][e] * xc[e]; o[e] = silu_f(v) * f; }
        u32x4 q; q.x = pk2(o[0], o[1]); q.y = pk2(o[2], o[3]); q.z = pk2(o[4], o[5]); q.w = pk2(o[6], o[7]);
        *(LAS u32x4*)(lds + t * XCS + ch0 * 2) = q;
#pragma unroll
        for (int e = 0; e < 8; ++e) { xw[0][e] = xw[1][e]; xw[1][e] = xw[2][e]; xw[2][e] = xc[e]; }
    }
}
DI void chunk_geom(int ch, bool& samp, int& sb, int& r0, int& Lv, bool& has_prev) {
    samp = ch >= 512; sb = ch - 512;
    if (!samp) { r0 = ch * 64; Lv = 64; has_prev = (ch & 127) != 0; } else { r0 = MP + sb * 32; Lv = 32; has_prev = false; }
}
DI void ssd_states_tile(KP P, LAS unsigned char* lds, int ch) {
    int tid = threadIdx.x; asm volatile("" : "+v"(tid));
    const int lane = tid & 63, h = __builtin_amdgcn_readfirstlane(tid >> 6);
    bool samp, has_prev; int sb, r0, Lv; chunk_geom(ch, samp, sb, r0, Lv, has_prev);
    __syncthreads();
    const float atot = ssd_dt_scan(P, lds, r0, Lv, h, lane);
    if (lane == 0) ((float*)(P->ws + WS_DEC))[ch * 8 + h] = expf(atot);
    __syncthreads();
    ssd_conv_to_lds<true, 96>(P, lds, tid, r0, Lv, samp, sb, has_prev);
    __syncthreads();
    const int r = lane & 31, h2 = lane >> 5, blk = (lane >> 4) & 1, i16 = lane & 15, q = i16 >> 2, pp = i16 & 3, g = h >> 2;
    bf16_t* ST = (bf16_t*)(P->ws + WS_ST) + ((size_t)ch * 8 + h) * 8192;
#pragma unroll 1
    for (int nh = 0; nh < 2; ++nh) {
        f32x16 acc[2][2];
#pragma unroll
        for (int a = 0; a < 2; ++a)
#pragma unroll
            for (int b = 0; b < 2; ++b)
#pragma unroll
                for (int i = 0; i < 16; ++i) acc[a][b][i] = 0.f;
#pragma unroll
        for (int sp = 0; sp < 4; ++sp) {
            LAS unsigned char* rlo = lds + (16 * sp + 8 * h2 + q) * XCS + (16 * blk + 4 * pp) * 2;
            LAS unsigned char* rhi = rlo + 4 * XCS;
            bf16x8 af[2], bfr[2];
#pragma unroll
            for (int pb = 0; pb < 2; ++pb) af[pb] = tr_frag(rlo + (h * 64 + 32 * pb) * 2, rhi + (h * 64 + 32 * pb) * 2);
#pragma unroll
            for (int nb = 0; nb < 2; ++nb) bfr[nb] = tr_frag(rlo + (512 + g * 128 + 64 * nh + 32 * nb) * 2, rhi + (512 + g * 128 + 64 * nh + 32 * nb) * 2);
#pragma unroll
            for (int pb = 0; pb < 2; ++pb)
#pragma unroll
                for (int nb = 0; nb < 2; ++nb) acc[pb][nb] = MFMA32(af[pb], bfr[nb], acc[pb][nb]);
        }
#pragma unroll
        for (int pb = 0; pb < 2; ++pb)
#pragma unroll
            for (int nb = 0; nb < 2; ++nb) {
                bf16_t* sp_ = ST + (32 * pb + 4 * h2) * 128 + 64 * nh + 32 * nb + r;
#pragma unroll
                for (int i = 0; i < 16; ++i) sp_[((i & 3) + 8 * (i >> 2)) * 128] = (bf16_t)(pk2(acc[pb][nb][i], 0.f) & 0xffff);
            }
    }
}
DI void phase_scan(KP P, LAS unsigned char* lds) {
    int tid = threadIdx.x; asm volatile("" : "+v"(tid));
    unsigned* ST = (unsigned*)(P->ws + WS_ST); const float* DEC = (const float*)(P->ws + WS_DEC);
    LAS float* sdec = (LAS float*)lds;
    for (int blk = blockIdx.x; blk < 256; blk += gridDim.x) {
        const int b = blk >> 6, h = (blk >> 3) & 7, rem = (blk & 63) * 512 + tid;
        __syncthreads();
        if (tid < 128) sdec[tid] = DEC[(b * 128 + tid) * 8 + h];
        __syncthreads();
        float H0 = 0.f, H1 = 0.f;
        unsigned* sp = ST + (size_t)b * 128 * 32768 + rem;
#pragma unroll 1
        for (int c0 = 0; c0 < 128; c0 += 64) {
            unsigned w[64];
#pragma unroll
            for (int k = 0; k < 64; ++k) w[k] = sp[(size_t)(c0 + k) * 32768];
#pragma unroll
            for (int k = 0; k < 64; ++k) { const float d = sdec[c0 + k]; sp[(size_t)(c0 + k) * 32768] = pk2(H0, H1); H0 = H0 * d + bf_lo(w[k]); H1 = H1 * d + bf_hi(w[k]); }
        }
        *(f32x2*)(P->out + O_SSP + ((size_t)blk * 512 + tid) * 2) = (f32x2){H0, H1};
    }
}
DI void phase_sample_state(KP P) {
    int tid = threadIdx.x; asm volatile("" : "+v"(tid));
    const size_t gt = (size_t)blockIdx.x * NT + tid, NGT = (size_t)gridDim.x * NT;
    const unsigned* ST = (const unsigned*)(P->ws + WS_ST); const float* DEC = (const float*)(P->ws + WS_DEC);
    for (size_t pr0 = gt; pr0 < 524288; pr0 += 4 * NGT) {
        f32x2 h0[4]; unsigned w[4]; float d[4];
#pragma unroll
        for (int u = 0; u < 4; ++u) { const size_t pr = pr0 + u * NGT; h0[u] = (f32x2){0.f, 0.f}; w[u] = 0u; d[u] = 0.f;
            if (pr < 524288) { const int b = (int)(pr >> 15), rem = (int)(pr & 32767), h = rem >> 12, chq = 512 + b;
                h0[u] = *(const f32x2*)(P->in[4] + pr * 2); w[u] = ST[(size_t)chq * 32768 + rem]; d[u] = DEC[chq * 8 + h]; } }
#pragma unroll
        for (int u = 0; u < 4; ++u) { const size_t pr = pr0 + u * NGT;
            if (pr < 524288) *(f32x2*)(P->out + O_SSS + pr * 2) = (f32x2){h0[u][0] * d[u] + bf_lo(w[u]), h0[u][1] * d[u] + bf_hi(w[u])}; }
    }
}
DI void ssd_out_tile(KP P, LAS unsigned char* lds, int ch) {
    int tid = threadIdx.x; asm volatile("" : "+v"(tid));
    const int lane = tid & 63, h = __builtin_amdgcn_readfirstlane(tid >> 6);
    bool samp, has_prev; int sb, r0, Lv; chunk_geom(ch, samp, sb, r0, Lv, has_prev);
    __syncthreads();
    ssd_dt_scan(P, lds, r0, Lv, h, lane);
    __syncthreads();
    ssd_conv_to_lds<false, 128>(P, lds, tid, r0, Lv, samp, sb, has_prev);
    __syncthreads();
    const int r = lane & 31, h2 = lane >> 5, blk = (lane >> 4) & 1, i16 = lane & 15, q = i16 >> 2, pp = i16 & 3, g = h >> 2;
    const LAS float* sac = (const LAS float*)(lds + L_AC) + h * 64; const LAS float* sdt = (const LAS float*)(lds + L_DT) + h * 64;
    f32x16 cb[2][2];
#pragma unroll
    for (int a = 0; a < 2; ++a)
#pragma unroll
        for (int b = 0; b < 2; ++b)
#pragma unroll
            for (int i = 0; i < 16; ++i) cb[a][b][i] = 0.f;
    const bf16_t* PREV = (const bf16_t*)(P->ws + WS_ST) + ((size_t)ch * 8 + h) * 8192;
#pragma unroll 2
    for (int kk = 0; kk < 8; ++kk) {
        bf16x8 bm[2], cm[2];
#pragma unroll
        for (int x = 0; x < 2; ++x) {
            bm[x] = *(const LAS bf16x8*)(lds + (32 * x + r) * XCS + (512 + g * 128 + 16 * kk + 8 * h2) * 2);
            cm[x] = *(const LAS bf16x8*)(lds + (32 * x + r) * XCS + (768 + g * 128 + 16 * kk + 8 * h2) * 2);
        }
#pragma unroll
        for (int a = 0; a < 2; ++a)
#pragma unroll
            for (int b = 0; b < 2; ++b) cb[a][b] = MFMA32(bm[a], cm[b], cb[a][b]);
    }
    __builtin_amdgcn_sched_barrier(0);
    float acl[2]; acl[0] = sac[r]; acl[1] = sac[32 + r];
    f32x16 y[2][2];
#pragma unroll
    for (int a = 0; a < 2; ++a)
#pragma unroll
        for (int b = 0; b < 2; ++b)
#pragma unroll
            for (int i = 0; i < 16; ++i) y[a][b][i] = 0.f;
#pragma unroll
    for (int sbk = 0; sbk < 2; ++sbk) {
        float acs[16];
#pragma unroll
        for (int gi = 0; gi < 4; ++gi) { const f32x4 t4 = *(const LAS f32x4*)(sac + 32 * sbk + 8 * gi + 4 * h2); acs[4 * gi] = t4[0]; acs[4 * gi + 1] = t4[1]; acs[4 * gi + 2] = t4[2]; acs[4 * gi + 3] = t4[3]; }
#pragma unroll
        for (int s2 = 0; s2 < 2; ++s2) {
            bf16x8 pf[2];
#pragma unroll
            for (int lb = 0; lb < 2; ++lb) {
                const int l = 32 * lb + r; float m[8];
#pragma unroll
                for (int j = 0; j < 8; ++j) { const int i = 8 * s2 + j, s = 32 * sbk + crow(i, h2);
                    m[j] = (s <= l) ? cb[sbk][lb][i] * __builtin_amdgcn_exp2f((acl[lb] - acs[i]) * LOG2E) : 0.f; }
                pf[lb] = pack8(m[0], m[1], m[2], m[3], m[4], m[5], m[6], m[7]);
            }
            LAS unsigned char* rlo = lds + (32 * sbk + 16 * s2 + 4 * h2 + q) * XCS + (h * 64 + 16 * blk + 4 * pp) * 2;
            LAS unsigned char* rhi = rlo + 8 * XCS;
#pragma unroll
            for (int pb = 0; pb < 2; ++pb) { const bf16x8 xa = tr_frag(rlo + 64 * pb, rhi + 64 * pb);
#pragma unroll
                for (int lb = 0; lb < 2; ++lb) y[pb][lb] = MFMA32(xa, pf[lb], y[pb][lb]); }
        }
    }
    __builtin_amdgcn_sched_barrier(0);
    {
        f32x16 yo[2][2];
#pragma unroll
        for (int a = 0; a < 2; ++a)
#pragma unroll
            for (int b = 0; b < 2; ++b)
#pragma unroll
                for (int i = 0; i < 16; ++i) yo[a][b][i] = 0.f;
        bf16x8 pv[8][2];
#pragma unroll
        for (int kk = 0; kk < 8; ++kk)
#pragma unroll
            for (int x = 0; x < 2; ++x) {
                if (!samp) pv[kk][x] = *(const bf16x8*)(PREV + (32 * x + r) * 128 + 16 * kk + 8 * h2);
                else { const float* hp = P->in[4] + ((size_t)(sb * 8 + h) * 64 + 32 * x + r) * 128 + 16 * kk + 8 * h2; const f32x4 ha = *(const f32x4*)hp, hb = *(const f32x4*)(hp + 4);
                    pv[kk][x] = pack8(ha[0], ha[1], ha[2], ha[3], hb[0], hb[1], hb[2], hb[3]); }
            }
#pragma unroll
        for (int kk = 0; kk < 8; ++kk)
#pragma unroll
            for (int x = 0; x < 2; ++x) pin(pv[kk][x]);
#pragma unroll
        for (int kk = 0; kk < 8; ++kk) {
            bf16x8 cm[2];
#pragma unroll
            for (int x = 0; x < 2; ++x) cm[x] = *(const LAS bf16x8*)(lds + (32 * x + r) * XCS + (768 + g * 128 + 16 * kk + 8 * h2) * 2);
#pragma unroll
            for (int a = 0; a < 2; ++a)
#pragma unroll
                for (int b = 0; b < 2; ++b) yo[a][b] = MFMA32(pv[kk][a], cm[b], yo[a][b]);
        }
#pragma unroll
        for (int lb = 0; lb < 2; ++lb) { const float eo = __builtin_amdgcn_exp2f(acl[lb] * LOG2E);
#pragma unroll
            for (int pb = 0; pb < 2; ++pb)
#pragma unroll
                for (int i = 0; i < 16; ++i) y[pb][lb][i] += eo * yo[pb][lb][i]; }
    }
    __builtin_amdgcn_sched_barrier(0);
    const float Dh = P->in[14][h];
    const bf16_t* Z = (const bf16_t*)(P->ws + WS_Z);
    float ss[2] = {0.f, 0.f};
    u32x2 zq[2][2][4];
#pragma unroll
    for (int lb = 0; lb < 2; ++lb)
#pragma unroll
        for (int pb = 0; pb < 2; ++pb)
#pragma unroll
            for (int gi = 0; gi < 4; ++gi) { const int l = 32 * lb + r; zq[lb][pb][gi] = (u32x2){0u, 0u};
                if (l < Lv) zq[lb][pb][gi] = *(const u32x2*)(Z + (size_t)(r0 + l) * 512 + h * 64 + 32 * pb + 8 * gi + 4 * h2); }
#pragma unroll
    for (int lb = 0; lb < 2; ++lb)
#pragma unroll
        for (int pb = 0; pb < 2; ++pb)
#pragma unroll
            for (int gi = 0; gi < 4; ++gi) pin(zq[lb][pb][gi]);
#pragma unroll
    for (int lb = 0; lb < 2; ++lb) {
        const int l = 32 * lb + r; const bool ok = l < Lv;
        const float dtl = sdt[l]; const float dsk = ok ? Dh / dtl : 0.f;
#pragma unroll
        for (int pb = 0; pb < 2; ++pb)
#pragma unroll
            for (int gi = 0; gi < 4; ++gi) {
                const int p0 = 32 * pb + 8 * gi + 4 * h2;
                const u32x2 xq = *(const LAS u32x2*)(lds + l * XCS + (h * 64 + p0) * 2);
                const u32x2 zv2 = zq[lb][pb][gi];
                const float xv[4] = {bf_lo(xq.x), bf_hi(xq.x), bf_lo(xq.y), bf_hi(xq.y)}; const float zv[4] = {bf_lo(zv2.x), bf_hi(zv2.x), bf_lo(zv2.y), bf_hi(zv2.y)};
#pragma unroll
                for (int e = 0; e < 4; ++e) { const int i = 4 * gi + e; float v = y[pb][lb][i] + xv[e] * dsk; v *= silu_f(zv[e]); y[pb][lb][i] = v; ss[lb] += v * v; }
            }
    }
    LAS float* red = (LAS float*)(lds + L_RED);
#pragma unroll
    for (int lb = 0; lb < 2; ++lb) { ss[lb] += __shfl_xor(ss[lb], 32); if (h2 == 0) red[h * 64 + 32 * lb + r] = ss[lb]; }
    __syncthreads();
    bf16_t* A2 = (bf16_t*)(P->ws + WS_A2); const float* gam = P->in[15];
    f32x4 gv[2][4];
#pragma unroll
    for (int pb = 0; pb < 2; ++pb)
#pragma unroll
        for (int gi = 0; gi < 4; ++gi) gv[pb][gi] = *(const f32x4*)(gam + h * 64 + 32 * pb + 8 * gi + 4 * h2);
#pragma unroll
    for (int pb = 0; pb < 2; ++pb)
#pragma unroll
        for (int gi = 0; gi < 4; ++gi) pin(gv[pb][gi]);
#pragma unroll
    for (int lb = 0; lb < 2; ++lb) {
        const int l = 32 * lb + r; float tot = 0.f;
#pragma unroll
        for (int hh = 0; hh < 8; ++hh) tot += red[hh * 64 + l];
        const float rs = 1.0f / sqrtf(tot * (1.f / 512.f) + 1e-5f);
        if (l < Lv) {
#pragma unroll
            for (int pb = 0; pb < 2; ++pb)
#pragma unroll
                for (int gi = 0; gi < 4; ++gi) { const int p0 = 32 * pb + 8 * gi + 4 * h2; const f32x4 g4 = gv[pb][gi];
                    u32x2 w; w.x = pk2(y[pb][lb][4 * gi] * rs * g4[0], y[pb][lb][4 * gi + 1] * rs * g4[1]); w.y = pk2(y[pb][lb][4 * gi + 2] * rs * g4[2], y[pb][lb][4 * gi + 3] * rs * g4[3]);
                    *(u32x2*)(A2 + (size_t)(r0 + l) * 1024 + 512 + h * 64 + p0) = w; }
        }
    }
}

constexpr int L_TBL = 0;
constexpr int L_ARED = 8 * 260 * 4;
constexpr int L_AQ = 16384;
DI void attn_tile(KP P, LAS unsigned char* lds, int ch) {
    int tid = threadIdx.x; asm volatile("" : "+v"(tid));
    const int lane = tid & 63, hd = __builtin_amdgcn_readfirstlane(tid >> 6), r = lane & 31, h2 = lane >> 5;
    const bool samp = ch >= 512;
    int Lq, jt_lo, nkeys, ngr; long qrow0; const bf16_t* Kb; const bf16_t* Vb;
    if (!samp) { const int b = ch >> 7, c = ch & 127; qrow0 = (long)ch * 64; Lq = 64; jt_lo = (c < 8) ? 8 - c : 0; nkeys = 576; ngr = 36;
        Kb = (const bf16_t*)(P->ws + WS_KP) + ((long)b * 8192 + (long)(c - 8) * 64) * 512 + hd * 64;
        Vb = (const bf16_t*)(P->ws + WS_VFP) + ((long)(b * 8 + hd) * 512 + (long)(c - 8) * 4) * 1024; }
    else { const int b = ch - 512; qrow0 = (long)MP + b * 32; Lq = 32; jt_lo = 0; nkeys = 544; ngr = 34;
        Kb = (const bf16_t*)(P->ws + WS_KS) + (long)b * 544 * 512 + hd * 64;
        Vb = (const bf16_t*)(P->ws + WS_VFS) + (long)(b * 8 + hd) * 34 * 1024; }
    __syncthreads();
    LAS float* tbl = (LAS float*)(lds + L_TBL) + hd * 260;
    for (int i = lane; i < 257; i += 64) tbl[i] = P->in[8][hd * 257 + i] * LOG2E;
    __syncthreads();
    const bf16_t* Q = (const bf16_t*)(P->ws + WS_Q);
    LAS unsigned char* qlds = lds + L_AQ + hd * 8192 + lane * 16;
    { bf16x8 qtmp[2][4];
#pragma unroll
      for (int qb = 0; qb < 2; ++qb) { int qi = 32 * qb + r; if (qi > Lq - 1) qi = Lq - 1;
#pragma unroll
          for (int s = 0; s < 4; ++s) qtmp[qb][s] = *(const bf16x8*)(Q + (size_t)(qrow0 + qi) * 512 + hd * 64 + 16 * s + 8 * h2); }
#pragma unroll
      for (int qb = 0; qb < 2; ++qb)
#pragma unroll
          for (int s = 0; s < 4; ++s) pin(qtmp[qb][s]);
#pragma unroll
      for (int qb = 0; qb < 2; ++qb)
#pragma unroll
          for (int s = 0; s < 4; ++s) *(LAS bf16x8*)(qlds + (qb * 4 + s) * 1024) = qtmp[qb][s]; }
    f32x16 o[2][2];
#pragma unroll
    for (int a = 0; a < 2; ++a)
#pragma unroll
        for (int b = 0; b < 2; ++b)
#pragma unroll
            for (int i = 0; i < 16; ++i) o[a][b][i] = 0.f;
    float mrun[2] = {-1e30f, -1e30f}, lrun[2] = {0.f, 0.f};
    const float SC = 0.125f * LOG2E;
    for (int jt = jt_lo; jt < 9; ++jt) {
        bf16x8 kf[2][4];
#pragma unroll
        for (int kb = 0; kb < 2; ++kb) {
            int kj = 64 * jt + 32 * kb + r; if (kj > nkeys - 1) kj = nkeys - 1;
#pragma unroll
            for (int s = 0; s < 4; ++s) kf[kb][s] = *(const bf16x8*)(Kb + (long)kj * 512 + 16 * s + 8 * h2);
        }
#pragma unroll
        for (int kb = 0; kb < 2; ++kb)
#pragma unroll
            for (int s = 0; s < 4; ++s) pin(kf[kb][s]);
        f32x16 st[2][2];
#pragma unroll
        for (int kb = 0; kb < 2; ++kb)
#pragma unroll
            for (int qb = 0; qb < 2; ++qb) {
#pragma unroll
                for (int i = 0; i < 16; ++i) st[kb][qb][i] = 0.f;
#pragma unroll
                for (int s = 0; s < 4; ++s) st[kb][qb] = MFMA32(kf[kb][s], *(const LAS bf16x8*)(qlds + (qb * 4 + s) * 1024), st[kb][qb]);
            }
        __builtin_amdgcn_sched_barrier(0);
        bf16x8 vf[2][2][2];
#pragma unroll
        for (int kb = 0; kb < 2; ++kb)
#pragma unroll
            for (int s2 = 0; s2 < 2; ++s2) {
                int gidx = 4 * jt + 2 * kb + s2; if (gidx > ngr - 1) gidx = ngr - 1;
#pragma unroll
                for (int db = 0; db < 2; ++db) vf[kb][s2][db] = *(const bf16x8*)(Vb + (long)gidx * 1024 + (h2 * 64 + 32 * db + r) * 8);
            }
        __builtin_amdgcn_sched_barrier(0);
        const bool far = (jt <= 5);
        const bool tailmask = samp && (jt == 8);
        const float bfar = tbl[256];
#pragma unroll
        for (int qb = 0; qb < 2; ++qb) {
            const int qi = 32 * qb + r;
            float mx = -1e30f;
#pragma unroll
            for (int kb = 0; kb < 2; ++kb)
#pragma unroll
                for (int i = 0; i < 16; ++i) {
                    const int kj = 64 * jt + 32 * kb + crow(i, h2);
                    float bias = bfar;
                    if (!far) { int rel = 512 + qi - kj; rel = rel > 128 ? 128 : rel; rel = rel < -128 ? -128 : rel; bias = tbl[rel + 128]; }
                    float sc = st[kb][qb][i] * SC + bias;
                    if (tailmask && kj >= nkeys) sc = -1e30f;
                    st[kb][qb][i] = sc; mx = fmaxf(mx, sc);
                }
            mx = fmaxf(mx, __shfl_xor(mx, 32));
            const float mnew = fmaxf(mrun[qb], mx), alpha = __builtin_amdgcn_exp2f(mrun[qb] - mnew);
            float ls = 0.f;
#pragma unroll
            for (int kb = 0; kb < 2; ++kb)
#pragma unroll
                for (int i = 0; i < 16; ++i) { const float p = __builtin_amdgcn_exp2f(st[kb][qb][i] - mnew); st[kb][qb][i] = p; ls += p; }
            ls += __shfl_xor(ls, 32);
            lrun[qb] = lrun[qb] * alpha + ls; mrun[qb] = mnew;
            if (__builtin_amdgcn_ballot_w64(alpha != 1.0f) != 0ull) {
#pragma unroll
                for (int db = 0; db < 2; ++db)
#pragma unroll
                    for (int i = 0; i < 16; ++i) o[db][qb][i] *= alpha;
            }
        }
#pragma unroll
        for (int kb = 0; kb < 2; ++kb)
#pragma unroll
            for (int s2 = 0; s2 < 2; ++s2) {
                bf16x8 pf[2];
#pragma unroll
                for (int qb = 0; qb < 2; ++qb) pf[qb] = pack8(st[kb][qb][8 * s2], st[kb][qb][8 * s2 + 1], st[kb][qb][8 * s2 + 2], st[kb][qb][8 * s2 + 3],
                                                               st[kb][qb][8 * s2 + 4], st[kb][qb][8 * s2 + 5], st[kb][qb][8 * s2 + 6], st[kb][qb][8 * s2 + 7]);
#pragma unroll
                for (int db = 0; db < 2; ++db)
#pragma unroll
                    for (int qb = 0; qb < 2; ++qb) o[db][qb] = MFMA32(vf[kb][s2][db], pf[qb], o[db][qb]);
            }
    }
    LAS float* red = (LAS float*)(lds + L_ARED);
#pragma unroll
    for (int qb = 0; qb < 2; ++qb) {
        const float il = 1.0f / lrun[qb]; float ss = 0.f;
#pragma unroll
        for (int db = 0; db < 2; ++db)
#pragma unroll
            for (int i = 0; i < 16; ++i) { const float v = o[db][qb][i] * il; o[db][qb][i] = v; ss += v * v; }
        ss += __shfl_xor(ss, 32);
        if (h2 == 0) red[hd * 64 + 32 * qb + r] = ss;
    }
    __syncthreads();
    bf16_t* A2 = (bf16_t*)(P->ws + WS_A2); const float* gam = P->in[9];
    f32x4 gv[2][4];
#pragma unroll
    for (int db = 0; db < 2; ++db)
#pragma unroll
        for (int gi = 0; gi < 4; ++gi) gv[db][gi] = *(const f32x4*)(gam + hd * 64 + 32 * db + 8 * gi + 4 * h2);
#pragma unroll
    for (int db = 0; db < 2; ++db)
#pragma unroll
        for (int gi = 0; gi < 4; ++gi) pin(gv[db][gi]);
#pragma unroll
    for (int qb = 0; qb < 2; ++qb) {
        const int qi = 32 * qb + r; float tot = 0.f;
#pragma unroll
        for (int hh = 0; hh < 8; ++hh) tot += red[hh * 64 + qi];
        const float rs = 1.0f / sqrtf(tot * (1.f / 512.f) + 1e-5f);
        if (qi < Lq) {
#pragma unroll
            for (int db = 0; db < 2; ++db)
#pragma unroll
                for (int gi = 0; gi < 4; ++gi) { const int d0 = 32 * db + 8 * gi + 4 * h2; const f32x4 g4 = gv[db][gi];
                    u32x2 w; w.x = pk2(o[db][qb][4 * gi] * rs * g4[0], o[db][qb][4 * gi + 1] * rs * g4[1]); w.y = pk2(o[db][qb][4 * gi + 2] * rs * g4[2], o[db][qb][4 * gi + 3] * rs * g4[3]);
                    *(u32x2*)(A2 + (size_t)(qrow0 + qi) * 1024 + hd * 64 + d0) = w; }
        }
    }
}

__global__ void __launch_bounds__(NT, 2) hybrid_fwd(Params PA) {
    extern __shared__ __attribute__((aligned(16))) unsigned char lds_raw[];
    LAS unsigned char* lds = (LAS unsigned char*)lds_raw;
    cg::grid_group grid = cg::this_grid();
    const int G = gridDim.x, bx = blockIdx.x;
    int wid_s = __builtin_amdgcn_readfirstlane(threadIdx.x >> 6); asm volatile("" : "+s"(wid_s));
#define TIDX() ({ unsigned z_ = 0u; asm volatile("" : "+s"(z_)); (wid_s << 6) | (int)__builtin_amdgcn_mbcnt_hi(~0u, __builtin_amdgcn_mbcnt_lo(~0u, z_)); })
#define KARGS() ({ KP p_ = (KP)__builtin_amdgcn_kernarg_segment_ptr(); asm volatile("" : "+s"(p_)); p_; })
    if (PA.out == nullptr) grid.sync();
    {
        volatile LAS unsigned* stw = (volatile LAS unsigned*)(lds + LDS_BYTES - 16);
        if (threadIdx.x == 0) { stw[0] = 0u; stw[1] = 0u; }
        __syncthreads();
    }
    const XcdBarrier gbar = xcd_barrier_post((unsigned*)(PA.ws + WS_BAR), (volatile LAS unsigned*)(lds + LDS_BYTES - 16));
#define GRID_SYNC() xcd_barrier(gbar, TIDX())

#ifndef PHASE_MASK
#define PHASE_MASK 0xFFFF
#endif
#ifndef REPEAT_MASK
#define REPEAT_MASK 0
#endif
#define PH(k) if (KP P = KARGS()) if (PHASE_MASK & (1 << (k))) for (int rep_ = 0; rep_ <= ((REPEAT_MASK >> (k)) & 1); ++rep_)
#ifndef NREP_ALL
#define NREP_ALL 1
#endif
    for (int outer_ = 0; outer_ < NREP_ALL; ++outer_) {
    if (outer_) GRID_SYNC();
    PH(0) phase_convert(P, lds);
    GRID_SYNC();
    PH(1) {
        pg8::AMapPlain am{(const void*)(P->ws + WS_XB), 2048}; pg8::Order S; S.init(128, 12, G, bx);
        EpiInProj E{P->out, P->ws};
        pg8::gemm_phase<EpiInProj, pg8::AMapPlain>(lds, am, (const void*)(P->ws + WS_WIN), 2048, S, E);
        small_inproj(P);
    }
    GRID_SYNC();
    PH(4) {
        unsigned* qctr = (unsigned*)(P->ws + WS_BAR) + 3584 + 64 * (rep_ + 2 * outer_);
        volatile LAS unsigned* slot = (volatile LAS unsigned*)(lds + LDS_BYTES - 32);
        constexpr int Q0 = LATE_WG_ITEMS, Q1 = Q0 + 480, Q2 = Q1 + 512, Q3 = Q2 + 32, Q4 = Q3 + 16, Q5 = Q4 + 16, Q6 = Q5 + 16;
        for (;;) {
            __syncthreads();
            if (threadIdx.x == 0) slot[0] = __hip_atomic_fetch_add(qctr, 1u, __ATOMIC_RELAXED, __HIP_MEMORY_SCOPE_AGENT);
            __syncthreads();
            const int it = (int)slot[0];
            if (it >= Q6) break;
            if (it < Q0) convert_late_item(P, lds, it);
            else if (it < Q1) { const int j = it - Q0; attn_tile(P, lds, (j / 120) * 128 + 8 + j % 120); }
            else if (it < Q2) ssd_states_tile(P, lds, it - Q1);
            else if (it < Q3) { const int j = it - Q2; attn_tile(P, lds, (j & 3) * 128 + 7 - (j >> 2)); }
            else if (it < Q4) ssd_out_tile(P, lds, 512 + it - Q3);
            else if (it < Q5) attn_tile(P, lds, 512 + it - Q4);
            else ssd_states_tile(P, lds, 512 + it - Q5);
        }
    }
    GRID_SYNC();
    PH(3) phase_scan(P, lds);
    GRID_SYNC();
    PH(5) for (int ch = bx; ch < 512; ch += G) ssd_out_tile(P, lds, ch);
    PH(5) phase_sample_state(P);
    GRID_SYNC();
    PH(6) {
        __syncthreads();
        pg8::AMapPlain am{(const void*)(P->ws + WS_A2), 2048}; pg8::Order S; S.init(128, 4, G, bx);
        EpiOutProj E{P->in[0], P->in[1], (bf16_t*)(P->out + O_Y)};
        pg8::gemm_phase<EpiOutProj, pg8::AMapPlain>(lds, am, (const void*)(P->ws + WS_WOUT), 2048, S, E);
        small_out_splitk(P, lds, TIDX());
    }
    GRID_SYNC();
    PH(7) phase_ln<true>((const bf16_t*)(P->out + O_Y), P->in[17], P->in[18], (void*)(P->ws + WS_XB), P->ws + WS_X1F8, P->ws + WS_G, TIDX());
    GRID_SYNC();
    PH(8) {
        pg8::Order S; S.init(132, 21, G, bx);
        pg8::AMapUp<126> am{(const void*)(P->ws + WS_X1F8), 1024};
        EpiUp<false> E{P->ws + WS_G, nullptr, P->in[20], P->in[21], P->in[6], nullptr};
        pg8::gemm_phase<EpiUp<false>, pg8::AMapUp<126>, true>(lds, am, (const void*)(P->ws + WS_WUP8), 1024, S, E);
        pg8::Order S2; S2.init(2, 21, G, (bx + G - (2772 % G)) % G);
        pg8::AMapUp<128> am2{(const void*)(P->ws + WS_XB), 2048};
        EpiUp<true> E2{nullptr, (bf16_t*)(P->ws + WS_GS), P->in[20], P->in[21], P->in[6], P->out + O_FCS};
        pg8::gemm_phase<EpiUp<true>, pg8::AMapUp<128>>(lds, am2, (const void*)(P->ws + WS_WUP), 2048, S2, E2);
        small_ffnconv_prompt(P, lds, TIDX());
    }
    GRID_SYNC();
    PH(9) {
        pg8::AMapPlain am{(const void*)(P->ws + WS_G), DFF * 2}; pg8::Order S; S.init(128, 4, G, bx);
        EpiDown E{(const bf16_t*)(P->ws + WS_XB), (bf16_t*)(P->ws + WS_A2)};
        pg8::gemm_phase<EpiDown, pg8::AMapPlain>(lds, am, (const void*)(P->ws + WS_WDOWN), DFF * 2, S, E);
        small_down_splitk(P, lds, TIDX());
    }
    GRID_SYNC();
    PH(10) phase_ln<false>((const bf16_t*)(P->ws + WS_A2), P->in[23], P->in[24], (void*)(P->out + O_Y), nullptr, nullptr, TIDX());
    }
}

extern "C" void kernel_launch(void* const* d_in, const int* in_sizes, int n_in, void* d_out, int out_size, void* d_ws, size_t ws_size, hipStream_t stream) {
    static int grid_blocks = 0;
    if (!grid_blocks) {
        int dev = 0, cus = 0, per_cu = 0;
        hipGetDevice(&dev);
        hipDeviceGetAttribute(&cus, hipDeviceAttributeMultiprocessorCount, dev);
        hipFuncSetAttribute((const void*)hybrid_fwd, hipFuncAttributeMaxDynamicSharedMemorySize, LDS_BYTES);
        hipOccupancyMaxActiveBlocksPerMultiprocessor(&per_cu, (const void*)hybrid_fwd, NT, LDS_BYTES);
        if (per_cu < 1) per_cu = 1;
        if (per_cu > 1) per_cu = 1;
        grid_blocks = cus * per_cu;
        if (ws_size < WS_END) fprintf(stderr, "kernel_launch: workspace too small: %zu < %zu\n", ws_size, (size_t)WS_END);
    }
    Params p{};
    for (int i = 0; i < 25; ++i) p.in[i] = (const float*)d_in[i];
    p.out = (float*)d_out; p.ws = (unsigned char*)d_ws;
    hipMemsetAsync((unsigned char*)d_ws + WS_BAR, 0, 16384, stream);
    void* args[] = {&p};
    hipError_t e = hipLaunchCooperativeKernel((const void*)hybrid_fwd, dim3(grid_blocks), dim3(NT), args, LDS_BYTES, stream);
    if (e != hipSuccess) fprintf(stderr, "cooperative launch failed: %s (grid %d)\n", hipGetErrorString(e), grid_blocks);
}
```

```cpp
#include <hip/hip_runtime.h>
#include <hip/hip_cooperative_groups.h>
#include <cstdio>
namespace cg = cooperative_groups;

#define LAS __attribute__((address_space(3)))
typedef unsigned short bf16_t;
typedef short bf16x8 __attribute__((ext_vector_type(8)));
typedef short s16x4 __attribute__((ext_vector_type(4)));
typedef float f32x2 __attribute__((ext_vector_type(2)));
typedef float f32x4 __attribute__((ext_vector_type(4)));
typedef float f32x16 __attribute__((ext_vector_type(16)));
typedef unsigned u32x2 __attribute__((ext_vector_type(2)));
typedef unsigned u32x4 __attribute__((ext_vector_type(4)));
typedef __bf16 bf2_t __attribute__((ext_vector_type(2)));
typedef int i32x4 __attribute__((ext_vector_type(4)));
typedef int i32x8 __attribute__((ext_vector_type(8)));
#define DI __device__ __forceinline__

constexpr int MP = 32768, MS = 512, MT = MP + MS;
constexpr int DM = 1024, NIN = 3080, NINP = 3328, DFF = 2688, NUP = 5376;
constexpr int NCHUNK = 528;
constexpr float ALPHA = 1.189207115002721f;
constexpr float LOG2E = 1.4426950408889634f;
constexpr int NT = 512;
constexpr int LDS_BYTES = 147456;
constexpr int GP8 = 2816;
constexpr float SC_X1 = 16.f, SC_WUP = 64.f, SC_G = 8.f, SC_WDN = 128.f;

constexpr size_t O_Y = 0;
constexpr size_t O_NKP = (size_t)MT * 1024;
constexpr size_t O_NVP = O_NKP + 1048576;
constexpr size_t O_NKS = O_NVP + 1048576;
constexpr size_t O_NVS = O_NKS + 262144;
constexpr size_t O_SSP = O_NVS + 262144;
constexpr size_t O_SSS = O_SSP + 262144;
constexpr size_t O_SCP = O_SSS + 1048576;
constexpr size_t O_SCS = O_SCP + 12288;
constexpr size_t O_FCP = O_SCS + 49152;
constexpr size_t O_FCS = O_FCP + 43008;

constexpr size_t al256(size_t x) { return (x + 255) & ~(size_t)255; }
constexpr size_t WS_WIN = 0;
constexpr size_t WS_WOUT = WS_WIN + al256((size_t)NINP * 1024 * 2);
constexpr size_t WS_WUP = WS_WOUT + al256((size_t)1024 * 1024 * 2);
constexpr size_t WS_WDOWN = WS_WUP + al256((size_t)NUP * 1024 * 2);
constexpr size_t WS_WUP8 = WS_WDOWN + al256((size_t)1024 * DFF * 2);
constexpr size_t WS_WDN8 = WS_WUP8 + al256((size_t)NUP * 1024);
constexpr size_t WS_GS = WS_WDN8 + al256((size_t)1024 * GP8);
constexpr size_t WS_DT = WS_GS + al256((size_t)MS * DFF * 2);
constexpr size_t WS_DEC = WS_DT + al256((size_t)MT * 8 * 4);
constexpr size_t WS_BAR = WS_DEC + al256((size_t)NCHUNK * 8 * 4);
constexpr size_t WS_XB = WS_BAR + 16384 + 8192;
constexpr size_t WS_R3 = WS_XB + al256((size_t)(MT + 256) * 1024 * 2);
constexpr size_t WS_G = WS_R3;
constexpr size_t WS_X1F8 = WS_R3 + al256((size_t)MP * DFF * 2) + 8192;
constexpr size_t WS_Q = WS_R3;
constexpr size_t WS_KP = WS_Q + al256((size_t)MT * 512 * 2);
constexpr size_t WS_KS = WS_KP + al256((size_t)MP * 512 * 2);
constexpr size_t WS_VFP = WS_KS + al256((size_t)16 * 544 * 512 * 2);
constexpr size_t WS_VFS = WS_VFP + al256((size_t)4 * 8 * 512 * 1024 * 2);
constexpr size_t WS_Z = WS_VFS + al256((size_t)16 * 8 * 34 * 1024 * 2) + 65536;
constexpr size_t WS_XBC = WS_Z + al256((size_t)MT * 512 * 2);
constexpr size_t WS_A2 = WS_XBC + al256((size_t)MT * 1024 * 2);
constexpr size_t WS_ST = WS_A2 + al256((size_t)MT * 1024 * 2);
constexpr size_t WS_END = WS_ST + al256((size_t)NCHUNK * 65536 * 2);
static_assert(WS_X1F8 + (size_t)(MT + 256) * 1024 <= WS_A2, "G8/X1F8 alias");
static_assert(WS_A2 + (size_t)MT * 1024 * 4 <= WS_END, "U2 alias");

struct Params {
    const float* in[25];
    float* out;
    unsigned char* ws;
};
typedef const __attribute__((address_space(4))) Params* KP;

DI unsigned pk2(float lo, float hi) { f32x2 f = {lo, hi}; return __builtin_bit_cast(unsigned, __builtin_convertvector(f, bf2_t)); }
DI unsigned pk4_f8(float a, float b, float c, float d) { int w = 0; w = __builtin_amdgcn_cvt_pk_fp8_f32(a, b, w, false); w = __builtin_amdgcn_cvt_pk_fp8_f32(c, d, w, true); return (unsigned)w; }
DI float bf_lo(unsigned w) { return __uint_as_float(w << 16); }
DI float bf_hi(unsigned w) { return __uint_as_float(w & 0xffff0000u); }
DI float silu_f(float x) { return x * __builtin_amdgcn_rcpf(1.0f + __builtin_amdgcn_exp2f(-x * LOG2E)); }
DI int crow(int reg, int h) { return (reg & 3) + 8 * (reg >> 2) + 4 * h; }
#define MFMA32(a, b, c) __builtin_amdgcn_mfma_f32_32x32x16_bf16((a), (b), (c), 0, 0, 0)
DI bf16x8 pack8(float a0, float a1, float a2, float a3, float a4, float a5, float a6, float a7) {
    u32x4 p; p.x = pk2(a0, a1); p.y = pk2(a2, a3); p.z = pk2(a4, a5); p.w = pk2(a6, a7); return __builtin_bit_cast(bf16x8, p);
}
DI void pin(bf16x8& v) { asm volatile("" : "+v"(v)); }
DI void pin(u32x2& v) { asm volatile("" : "+v"(v)); }
DI void pin(f32x4& v) { asm volatile("" : "+v"(v)); }
DI bf16x8 tr_frag(LAS unsigned char* lo, LAS unsigned char* hi) {
    s16x4 a = __builtin_amdgcn_ds_read_tr16_b64_v4i16((LAS s16x4*)lo);
    s16x4 b = __builtin_amdgcn_ds_read_tr16_b64_v4i16((LAS s16x4*)hi);
    return __builtin_shufflevector(a, b, 0, 1, 2, 3, 4, 5, 6, 7);
}


#define XB_TMO      128
#define XB_XCNT(j)  (256  + 64 * (j))
#define XB_XSUB(j)  (1280 + 64 * (j))
#define XB_XGEN(j)  (2304 + 64 * (j))
#define XB_TOP      3328
#define XB_TOPGEN   3392
#define XCD_BAR_WORDS 3456
#define XB_SPIN_CAP (1u << 20)
DI unsigned xb_ld(unsigned* p)              { return __hip_atomic_load(p, __ATOMIC_RELAXED, __HIP_MEMORY_SCOPE_AGENT); }
DI unsigned xb_add(unsigned* p, unsigned v) { return __hip_atomic_fetch_add(p, v, __ATOMIC_RELAXED, __HIP_MEMORY_SCOPE_AGENT); }
DI unsigned xb_xcc_id() { return (unsigned)__builtin_amdgcn_s_getreg((3 << 11) | 20) & 0xFu; }
#define XB_SPIN(cond, bar) do { unsigned _sp = 0; while (cond) { __builtin_amdgcn_s_sleep(1); \
    if ((++_sp & 255u) == 0u) { if (xb_ld(&(bar)[XB_TMO])) break; if (_sp > XB_SPIN_CAP) { atomicAdd(&(bar)[XB_TMO], 1u); break; } } } } while (0)
struct XcdBarrier { unsigned* bar; unsigned x; volatile LAS unsigned* st; };
DI XcdBarrier xcd_barrier_post(unsigned* bar, volatile LAS unsigned* st) {
    XcdBarrier b; b.bar = bar; b.x = xb_xcc_id(); b.st = st;
    if (threadIdx.x == 0) (void)xb_add(&bar[XB_XCNT(b.x)], 1u);
    return b;
}
DI void xcd_barrier_complete(unsigned* bar, unsigned x, unsigned& nloc, unsigned& nx) {
    const unsigned G = gridDim.x * gridDim.y * gridDim.z;
    unsigned sum, cnt, mine, sp = 0u;
    for (;;) {
        sum = 0u; cnt = 0u; mine = 0u;
#pragma unroll
        for (unsigned j = 0; j < 16; ++j) { const unsigned c = xb_ld(&bar[XB_XCNT(j)]); sum += c; cnt += (c > 0u) ? 1u : 0u; mine = (j == x) ? c : mine; }
        if (sum == G) break;
        __builtin_amdgcn_s_sleep(1);
        if ((++sp & 255u) == 0u) { if (xb_ld(&bar[XB_TMO])) break; if (sp > XB_SPIN_CAP) { atomicAdd(&bar[XB_TMO], 1u); break; } }
    }
    nloc = mine > 0u ? mine : 1u; nx = cnt > 0u ? cnt : 1u;
}
DI void xcd_barrier(const XcdBarrier& b, int tid_in) {
    asm volatile("s_waitcnt vmcnt(0)" ::: "memory");
    __syncthreads();
    if (tid_in == 0) {
        unsigned* bar = b.bar;
        __builtin_amdgcn_s_waitcnt(0);
        unsigned nloc = b.st[0], nx = b.st[1];
        if (nloc == 0u) { xcd_barrier_complete(bar, b.x, nloc, nx); b.st[0] = nloc; b.st[1] = nx; }
        const unsigned old = xb_add(&bar[XB_XSUB(b.x)], 1u);
        const unsigned gen = old / nloc;
        if (old + 1u == (gen + 1u) * nloc) {
            __builtin_amdgcn_fence(__ATOMIC_RELEASE, "agent");
            asm volatile("s_waitcnt vmcnt(0)" ::: "memory");
            const unsigned og = xb_add(&bar[XB_TOP], 1u);
            const unsigned tg = og / nx;
            if (og + 1u == (tg + 1u) * nx) xb_add(&bar[XB_TOPGEN], 1u);
            else XB_SPIN(xb_ld(&bar[XB_TOPGEN]) == tg, bar);
            __builtin_amdgcn_fence(__ATOMIC_ACQUIRE, "agent");
            xb_add(&bar[XB_XGEN(b.x)], 1u);
            asm volatile("s_waitcnt vmcnt(0)" ::: "memory");
        } else {
            XB_SPIN(xb_ld(&bar[XB_XGEN(b.x)]) == gen, bar);
            __builtin_amdgcn_fence(__ATOMIC_ACQUIRE, "agent");
            asm volatile("s_waitcnt vmcnt(0)" ::: "memory");
        }
    }
    __syncthreads();
}

namespace pg8 {
constexpr int BM = 256, BK = 64, HALF = 128, HTB = HALF * BK * 2, NXCD = 8, WGM = 8;
DI int lds_byte(int r, int c) { const int st = (r >> 4) * 2 + (c >> 5), rr = r & 15, cc = c & 31, ob = rr * 64 + cc * 2; return st * 1024 + (ob ^ (((ob >> 9) & 1) << 5)); }
DI void stage_rc(int b, int& R, int& C) { const int st = b / 1024, sb = b % 1024, swz = sb ^ (((sb >> 9) & 1) << 5); R = (st >> 1) * 16 + swz / 64; C = (st & 1) * 32 + (swz % 64) / 2; }
DI int perm32(int rho) { const int n = rho >> 4, i = rho & 15; return 8 * (i >> 2) + 4 * n + (i & 3); }
struct Unit { int pm, pn; };
struct Order {
    int nM, nN, nwg, G, c;
    DI void init(int nM_, int nN_, int G_, int c_) { nM = nM_; nN = nN_; nwg = nM * nN; G = G_; c = c_; }
    DI bool next(int i, Unit& u) const {
        const long L = (long)i * G + c; if (L >= nwg) return false;
        int wgid = (int)L; { const int q = nwg / NXCD, r = nwg % NXCD, xcd = wgid % NXCD, off = wgid / NXCD; wgid = (xcd < r ? xcd * (q + 1) : r * (q + 1) + (xcd - r) * q) + off; }
        const int nig = WGM * nN, gid = wgid / nig, fm = gid * WGM, gsz = (nM - fm) < WGM ? (nM - fm) : WGM;
        u.pm = fm + ((wgid % nig) % gsz); u.pn = (wgid % nig) / gsz; return true;
    }
};
struct AMapPlain {
    const void* A; int pitch;
    DI const char* unit_base(int pm) const { return (const char*)A + (size_t)pm * 256 * pitch; }
    DI size_t hstep() const { return (size_t)HALF * pitch; }
    DI unsigned voff(int R, int Cb) const { return (unsigned)(R * pitch + Cb); }
};
template <int WRS> struct AMapUp {
    const void* A; int pitch;
    DI const char* unit_base(int pm) const {
        if (WRS == 126) { const int b = pm / 33, ti = pm - b * 33; return (const char*)A + ((long)b * 8192 + ti * 252 - 2) * pitch; }
        return (const char*)A + ((long)MP + pm * 256) * pitch;
    }
    DI size_t hstep() const { return (size_t)4 * pitch; }
    DI unsigned voff(int R, int Cb) const { return (unsigned)((((R >> 6) * WRS + (R & 15) * 8 + ((R >> 4) & 3)) * pitch) + Cb); }
};

template <class Epi, class AMap, bool F8 = false>
DI void gemm_phase(LAS unsigned char* lds, const AMap am, const void* Bt, const int Kb, const Order& S, const Epi& E) {
    int tid = threadIdx.x; asm volatile("" : "+v"(tid));
    const int wid = __builtin_amdgcn_readfirstlane(tid >> 6), lane = tid & 63, wr = wid >> 2, wc = wid & 3, fr = lane & 15, fq = lane >> 4;
    const int nt = Kb / 128;
    unsigned voffA, voffB; size_t dA2, dB2;
    { int R, C; stage_rc(tid * 16, R, C); const int Rb = Epi::PERM ? ((R & ~31) + perm32(R & 31)) : R;
      voffA = am.voff(R, 2 * C); voffB = (unsigned)(Rb * Kb + 2 * C); dA2 = (size_t)(am.voff(64, 0) - am.voff(0, 0)); dB2 = (size_t)64 * Kb; }
    const size_t kstep = (size_t)128;
    const size_t hstepA = am.hstep();
    const size_t hstepB = (size_t)HALF * Kb;
    const size_t tstepB = 2 * hstepB;
    const unsigned ldsw = (unsigned)wid * 1024u;
    constexpr int QOFF = F8 ? 16 : 1024;
    const int aoff = F8 ? lds_byte(wr * 64 + fr, 16 * (fq & 1)) + 1024 * (fq >> 1) : lds_byte(wr * 64 + fr, fq * 8);
    const int boff = F8 ? lds_byte(wc * 32 + fr, 16 * (fq & 1)) + 1024 * (fq >> 1) : lds_byte(wc * 32 + fr, fq * 8);
#define PG8_SA(b, h) (((b) * 2 + (h)) * HTB)
#define PG8_SB(b, h) ((4 + (b) * 2 + (h)) * HTB)
#define PG8_STAGE(bufoff, gbase, voff) do { \
        __builtin_amdgcn_global_load_lds((const unsigned*)((const char*)(gbase) + (voff)), (LAS unsigned*)(lds + (bufoff) + ldsw), 16, 0, 0); \
        __builtin_amdgcn_global_load_lds((const unsigned*)((const char*)(gbase) + d2_##voff + (voff)), (LAS unsigned*)(lds + (bufoff) + ldsw + 8192), 16, 0, 0); } while (0)
#define d2_voffA dA2
#define d2_voffB dB2
#define PG8_LDA(dst, b, h) do { _Pragma("unroll") for (int m = 0; m < 4; ++m) { const i32x4 lo_ = *(const LAS i32x4*)(lds + PG8_SA(b, h) + aoff + m * 2048), hi_ = *(const LAS i32x4*)(lds + PG8_SA(b, h) + aoff + QOFF + m * 2048); \
        dst[m] = __builtin_shufflevector(lo_, hi_, 0, 1, 2, 3, 4, 5, 6, 7); } } while (0)
#define PG8_LDB(dst, b, h) do { _Pragma("unroll") for (int n = 0; n < 2; ++n) { const i32x4 lo_ = *(const LAS i32x4*)(lds + PG8_SB(b, h) + boff + n * 2048), hi_ = *(const LAS i32x4*)(lds + PG8_SB(b, h) + boff + QOFF + n * 2048); \
        dst[n] = __builtin_shufflevector(lo_, hi_, 0, 1, 2, 3, 4, 5, 6, 7); } } while (0)
#define PG8_HALF(v, k) __builtin_bit_cast(bf16x8, __builtin_shufflevector(v, v, 4 * (k), 4 * (k) + 1, 4 * (k) + 2, 4 * (k) + 3))
#define PG8_MMA(ai, bj, At, Bt_) do { __builtin_amdgcn_s_setprio(1); _Pragma("unroll") for (int m = 0; m < 4; ++m) _Pragma("unroll") for (int n = 0; n < 2; ++n) { \
        if (F8) acc[ai][bj][m][n] = __builtin_amdgcn_mfma_scale_f32_16x16x128_f8f6f4(Bt_[n], At[m], acc[ai][bj][m][n], 0, 0, 0, 0, 0, 0); \
        else { acc[ai][bj][m][n] = __builtin_amdgcn_mfma_f32_16x16x32_bf16(PG8_HALF(Bt_[n], 0), PG8_HALF(At[m], 0), acc[ai][bj][m][n], 0, 0, 0); \
               acc[ai][bj][m][n] = __builtin_amdgcn_mfma_f32_16x16x32_bf16(PG8_HALF(Bt_[n], 1), PG8_HALF(At[m], 1), acc[ai][bj][m][n], 0, 0, 0); } } \
        __builtin_amdgcn_s_setprio(0); } while (0)
#define PG8_WAIT_V(n) asm volatile("s_waitcnt vmcnt(" #n ")" ::: "memory")
#define PG8_WAIT_L(n) asm volatile("s_waitcnt lgkmcnt(" #n ")" ::: "memory")
#define PG8_BAR __builtin_amdgcn_s_barrier()
#define PG8_SCHED __builtin_amdgcn_sched_barrier(0)
    Unit cur, nxt; int ui = 0;
    if (!S.next(0, cur)) return;
    f32x4 acc[2][2][4][2];
#pragma unroll
    for (int a = 0; a < 2; ++a)
#pragma unroll
        for (int b = 0; b < 2; ++b)
#pragma unroll
            for (int m = 0; m < 4; ++m)
#pragma unroll
                for (int n = 0; n < 2; ++n) acc[a][b][m][n] = (f32x4){0.f, 0.f, 0.f, 0.f};
    i32x8 At[4], B0[2], B1[2];
    const char* cA = am.unit_base(cur.pm); const char* cB = (const char*)Bt + (size_t)cur.pn * tstepB;
    PG8_STAGE(PG8_SB(0, 0), cB, voffB); PG8_STAGE(PG8_SA(0, 0), cA, voffA); PG8_STAGE(PG8_SB(0, 1), cB + hstepB, voffB); PG8_STAGE(PG8_SA(0, 1), cA + hstepA, voffA);
    if (wr == 1) PG8_BAR;
    PG8_WAIT_V(4); PG8_BAR;
    PG8_STAGE(PG8_SB(1, 0), cB + kstep, voffB); PG8_STAGE(PG8_SA(1, 0), cA + kstep, voffA); PG8_STAGE(PG8_SB(1, 1), cB + hstepB + kstep, voffB);
    PG8_WAIT_V(6); PG8_BAR;
    for (;;) {
        const bool has_next = S.next(ui + 1, nxt);
        const char* nA = has_next ? am.unit_base(nxt.pm) : cA; const char* nB = has_next ? (const char*)Bt + (size_t)nxt.pn * tstepB : cB;
        for (int t = 0; t < nt; t += 2) {
            const bool last = (t == nt - 2);
            const char* a1 = cA + (size_t)(t + 1) * kstep;
            const char* a2 = last ? nA : cA + (size_t)(t + 2) * kstep; const char* b2 = last ? nB : cB + (size_t)(t + 2) * kstep;
            const char* a3 = a2 + kstep; const char* b3 = b2 + kstep;
            PG8_LDB(B0, 0, 0); PG8_SCHED; PG8_LDA(At, 0, 0); PG8_STAGE(PG8_SA(1, 1), a1 + hstepA, voffA);
            PG8_WAIT_L(8); PG8_BAR; PG8_WAIT_L(0); PG8_MMA(0, 0, At, B0); PG8_BAR; PG8_SCHED;
            PG8_LDB(B1, 0, 1); PG8_STAGE(PG8_SB(0, 0), b2, voffB);
            PG8_BAR; PG8_WAIT_L(0); PG8_MMA(0, 1, At, B1); PG8_BAR;
            PG8_LDA(At, 0, 1); PG8_STAGE(PG8_SA(0, 0), a2, voffA);
            PG8_BAR; PG8_WAIT_L(0); PG8_MMA(1, 0, At, B0); PG8_BAR; PG8_SCHED;
            PG8_STAGE(PG8_SB(0, 1), b2 + hstepB, voffB);
            PG8_WAIT_V(6); PG8_BAR; PG8_MMA(1, 1, At, B1); PG8_BAR;
            PG8_LDB(B0, 1, 0); PG8_SCHED; PG8_LDA(At, 1, 0); PG8_STAGE(PG8_SA(0, 1), a2 + hstepA, voffA);
            PG8_WAIT_L(8); PG8_BAR; PG8_WAIT_L(0); PG8_MMA(0, 0, At, B0); PG8_BAR; PG8_SCHED;
            PG8_LDB(B1, 1, 1); PG8_STAGE(PG8_SB(1, 0), b3, voffB);
            PG8_BAR; PG8_WAIT_L(0); PG8_MMA(0, 1, At, B1); PG8_BAR;
            PG8_LDA(At, 1, 1); PG8_STAGE(PG8_SA(1, 0), a3, voffA);
            PG8_BAR; PG8_WAIT_L(0); PG8_MMA(1, 0, At, B0); PG8_BAR; PG8_SCHED;
            PG8_STAGE(PG8_SB(1, 1), b3 + hstepB, voffB);
            PG8_WAIT_V(6); PG8_BAR; PG8_MMA(1, 1, At, B1); PG8_BAR;
        }
        { unsigned z_ = 0u; asm volatile("" : "+s"(z_)); int l2_ = (int)__builtin_amdgcn_mbcnt_hi(~0u, __builtin_amdgcn_mbcnt_lo(~0u, z_)); asm volatile("" : "+v"(l2_));
          E(acc, cur, wr, wc, l2_ & 15, l2_ >> 4); }
        if (!has_next) break;
#pragma unroll
        for (int a = 0; a < 2; ++a)
#pragma unroll
            for (int b = 0; b < 2; ++b)
#pragma unroll
                for (int m = 0; m < 4; ++m)
#pragma unroll
                    for (int n = 0; n < 2; ++n) acc[a][b][m][n] = (f32x4){0.f, 0.f, 0.f, 0.f};
        cur = nxt; cA = nA; cB = nB; ++ui;
    }
    PG8_WAIT_V(0);
    if (wr == 0) PG8_BAR;
    PG8_BAR;
#undef PG8_SA
#undef PG8_SB
#undef PG8_STAGE
#undef d2_voffA
#undef d2_voffB
#undef PG8_LDA
#undef PG8_LDB
#undef PG8_HALF
#undef PG8_MMA
#undef PG8_WAIT_V
#undef PG8_WAIT_L
#undef PG8_BAR
#undef PG8_SCHED
}
}

typedef f32x4 AccT[2][2][4][2];

struct EpiInProj {
    static constexpr bool PERM = true;
    float* out; unsigned char* ws;
    DI void operator()(const AccT& acc, const pg8::Unit& u, int wr, int wc, int fr, int fq) const {
        const int pn = u.pn, r0 = u.pm * 256 + wr * 64 + fr, ct = wc * 32 + 8 * fq;
        const bool samp = u.pm >= 128;
        if (pn == 12) {
            if (wc == 0 && fq == 0) {
                float* DT = (float*)(ws + WS_DT);
#pragma unroll
                for (int ai = 0; ai < 2; ++ai)
#pragma unroll
                    for (int m = 0; m < 4; ++m) { const int row = r0 + ai * 128 + m * 16;
                        *(f32x4*)(DT + (size_t)row * 8) = acc[ai][0][m][0]; *(f32x4*)(DT + (size_t)row * 8 + 4) = acc[ai][0][m][1]; }
            }
            return;
        }
#pragma unroll
        for (int ai = 0; ai < 2; ++ai)
#pragma unroll
            for (int m = 0; m < 4; ++m) {
                const int row = r0 + ai * 128 + m * 16;
                const int rs = row - MP, sb = rs >> 5, st = rs & 31;
                const int pb = row >> 13, pt = row & 8191;
#pragma unroll
                for (int bj = 0; bj < 2; ++bj) {
                    const f32x4 v0 = acc[ai][bj][m][0], v1 = acc[ai][bj][m][1];
                    u32x4 w; w.x = pk2(v0[0], v0[1]); w.y = pk2(v0[2], v0[3]); w.z = pk2(v1[0], v1[1]); w.w = pk2(v1[2], v1[3]);
                    const int ctile = bj * 128 + ct;
                    if (pn < 2) {
                        *(u32x4*)((bf16_t*)(ws + WS_Q) + (size_t)row * 512 + pn * 256 + ctile) = w;
                    } else if (pn < 4) {
                        const int col = (pn - 2) * 256 + ctile;
                        if (!samp) {
                            *(u32x4*)((bf16_t*)(ws + WS_KP) + (size_t)row * 512 + col) = w;
                            if (pt >= 7680) { float* o = out + O_NKP + ((size_t)(pb * 512 + pt - 7680)) * 512 + col; *(f32x4*)o = v0; *(f32x4*)(o + 4) = v1; }
                        } else {
                            *(u32x4*)((bf16_t*)(ws + WS_KS) + ((size_t)sb * 544 + 512 + st) * 512 + col) = w;
                            float* o = out + O_NKS + (size_t)rs * 512 + col; *(f32x4*)o = v0; *(f32x4*)(o + 4) = v1;
                        }
                    } else if (pn < 6) {
                        const int col = (pn - 4) * 256 + ctile, head = col >> 6, d0 = col & 63;
                        bf16_t* vb; int t;
                        if (!samp) { t = pt; vb = (bf16_t*)(ws + WS_VFP) + ((size_t)(pb * 8 + head) * 512 + (t >> 4)) * 1024;
                            if (pt >= 7680) { float* o = out + O_NVP + ((size_t)(pb * 512 + pt - 7680)) * 512 + col; *(f32x4*)o = v0; *(f32x4*)(o + 4) = v1; } }
                        else { t = 512 + st; vb = (bf16_t*)(ws + WS_VFS) + ((size_t)(sb * 8 + head) * 34 + (t >> 4)) * 1024;
                            float* o = out + O_NVS + (size_t)rs * 512 + col; *(f32x4*)o = v0; *(f32x4*)(o + 4) = v1; }
                        const int tt = t & 15, hh = (tt >> 2) & 1, jj = ((tt >> 3) << 2) | (tt & 3);
                        bf16_t* p = vb + (hh * 64 + d0) * 8 + jj;
                        p[0] = (bf16_t)(w.x & 0xffff); p[8] = (bf16_t)(w.x >> 16); p[16] = (bf16_t)(w.y & 0xffff); p[24] = (bf16_t)(w.y >> 16);
                        p[32] = (bf16_t)(w.z & 0xffff); p[40] = (bf16_t)(w.z >> 16); p[48] = (bf16_t)(w.w & 0xffff); p[56] = (bf16_t)(w.w >> 16);
                    } else if (pn < 8) {
                        *(u32x4*)((bf16_t*)(ws + WS_Z) + (size_t)row * 512 + (pn - 6) * 256 + ctile) = w;
                    } else {
                        const int col = (pn - 8) * 256 + ctile;
                        *(u32x4*)((bf16_t*)(ws + WS_XBC) + (size_t)row * 1024 + col) = w;
                        if (!samp) { if (pt >= 8189) { float* o = out + O_SCP + ((size_t)(pb * 3 + pt - 8189)) * 1024 + col; *(f32x4*)o = v0; *(f32x4*)(o + 4) = v1; } }
                        else { if (st >= 29) { float* o = out + O_SCS + ((size_t)(sb * 3 + st - 29)) * 1024 + col; *(f32x4*)o = v0; *(f32x4*)(o + 4) = v1; } }
                    }
                }
            }
    }
};

struct EpiOutProj {
    static constexpr bool PERM = false;
    const float* xp; const float* xs; bf16_t* U;
    DI void operator()(const AccT& acc, const pg8::Unit& u, int wr, int wc, int fr, int fq) const {
        const int r0 = u.pm * 256 + wr * 64 + fr, c0 = u.pn * 256 + wc * 32 + 4 * fq;
#pragma unroll
        for (int ai = 0; ai < 2; ++ai) {
            f32x4 xv[4][2][2];
#pragma unroll
            for (int m = 0; m < 4; ++m) { const int row = r0 + ai * 128 + m * 16; const float* xr = (row < MP) ? xp + (size_t)row * 1024 : xs + (size_t)(row - MP) * 1024;
#pragma unroll
                for (int bj = 0; bj < 2; ++bj)
#pragma unroll
                    for (int n = 0; n < 2; ++n) xv[m][bj][n] = *(const f32x4*)(xr + c0 + bj * 128 + n * 16); }
#pragma unroll
            for (int m = 0; m < 4; ++m)
#pragma unroll
                for (int bj = 0; bj < 2; ++bj)
#pragma unroll
                    for (int n = 0; n < 2; ++n) pin(xv[m][bj][n]);
#pragma unroll
            for (int m = 0; m < 4; ++m) { const int row = r0 + ai * 128 + m * 16; bf16_t* ur = U + (size_t)row * 1024;
#pragma unroll
                for (int bj = 0; bj < 2; ++bj)
#pragma unroll
                    for (int n = 0; n < 2; ++n) { const f32x4 o = xv[m][bj][n] * ALPHA + acc[ai][bj][m][n];
                        u32x2 w; w.x = pk2(o[0], o[1]); w.y = pk2(o[2], o[3]); *(u32x2*)(ur + c0 + bj * 128 + n * 16) = w; } }
        }
    }
};
struct EpiDown {
    static constexpr bool PERM = false;
    const bf16_t* X1; bf16_t* U;
    DI void operator()(const AccT& acc, const pg8::Unit& u, int wr, int wc, int fr, int fq) const {
        const int r0 = u.pm * 256 + wr * 64 + fr, c0 = u.pn * 256 + wc * 32 + 4 * fq;
        u32x2 xw[2][4][2][2];
#pragma unroll
        for (int ai = 0; ai < 2; ++ai)
#pragma unroll
            for (int m = 0; m < 4; ++m) { const bf16_t* xr = X1 + (size_t)(r0 + ai * 128 + m * 16) * 1024;
#pragma unroll
                for (int bj = 0; bj < 2; ++bj)
#pragma unroll
                    for (int n = 0; n < 2; ++n) xw[ai][m][bj][n] = *(const u32x2*)(xr + c0 + bj * 128 + n * 16); }
#pragma unroll
        for (int ai = 0; ai < 2; ++ai)
#pragma unroll
            for (int m = 0; m < 4; ++m)
#pragma unroll
                for (int bj = 0; bj < 2; ++bj)
#pragma unroll
                    for (int n = 0; n < 2; ++n) pin(xw[ai][m][bj][n]);
#pragma unroll
        for (int ai = 0; ai < 2; ++ai)
#pragma unroll
            for (int m = 0; m < 4; ++m) { bf16_t* ur = U + (size_t)(r0 + ai * 128 + m * 16) * 1024;
#pragma unroll
                for (int bj = 0; bj < 2; ++bj)
#pragma unroll
                    for (int n = 0; n < 2; ++n) { const u32x2 w = xw[ai][m][bj][n];
                        const f32x4 xv = {bf_lo(w.x), bf_hi(w.x), bf_lo(w.y), bf_hi(w.y)}; const f32x4 o = xv * ALPHA + acc[ai][bj][m][n];
                        u32x2 wo; wo.x = pk2(o[0], o[1]); wo.y = pk2(o[2], o[3]); *(u32x2*)(ur + c0 + bj * 128 + n * 16) = wo; } }
    }
};

DI float dpp_shr1(float v) { return __builtin_bit_cast(float, __builtin_amdgcn_update_dpp(0, __builtin_bit_cast(int, v), 0x111, 0xf, 0xf, false)); }
template <bool SAMP> struct EpiUp {
    static constexpr bool PERM = true;
    unsigned char* G8; bf16_t* GS; const float* cw; const float* cb; const float* past; float* onf;
    DI void operator()(const AccT& acc, const pg8::Unit& u, int wr, int wc, int fr, int fq) const {
        const int colv = u.pn * 128 + wc * 32 + 8 * fq;
        int bb, tb; long grow0;
        if (!SAMP) { bb = u.pm / 33; const int ti = u.pm - bb * 33; tb = ti * 252 + wr * 126 + fr * 8 - 2; grow0 = (long)bb * 8192 + tb; }
        else { const int lg = wr * 16 + fr; bb = u.pm * 8 + (lg >> 2); tb = (lg & 3) * 8; grow0 = (long)bb * 32 + tb; }
        const bool first = SAMP ? ((fr & 3) == 0) : (fr == 0);
        const float asc = SAMP ? 1.0f : 1.0f / (SC_X1 * SC_WUP);
#pragma unroll
        for (int n = 0; n < 2; ++n) {
            const int cv = colv + 4 * n, cgt = DFF + cv;
            const f32x4 wv0 = *(const f32x4*)(cw + cv), wv1 = *(const f32x4*)(cw + NUP + cv), wv2 = *(const f32x4*)(cw + 2 * NUP + cv), bv = *(const f32x4*)(cb + cv);
            const f32x4 wg0 = *(const f32x4*)(cw + cgt), wg1 = *(const f32x4*)(cw + NUP + cgt), wg2 = *(const f32x4*)(cw + 2 * NUP + cgt), bg = *(const f32x4*)(cb + cgt);
            f32x4 hv[8], hg[8];
#pragma unroll
            for (int tau = 0; tau < 8; ++tau) { hv[tau] = acc[tau >> 2][0][tau & 3][n] * asc; hg[tau] = acc[tau >> 2][1][tau & 3][n] * asc; }
            if (SAMP) {
                if ((fr & 3) == 3) { float* o = onf + ((size_t)(bb * 2)) * NUP; *(f32x4*)(o + cv) = hv[6]; *(f32x4*)(o + cgt) = hg[6]; *(f32x4*)(o + NUP + cv) = hv[7]; *(f32x4*)(o + NUP + cgt) = hg[7]; }
            }
            if (!SAMP) { if (tb < 0) { hv[0] = (f32x4){0.f, 0.f, 0.f, 0.f}; hv[1] = hv[0]; hg[0] = hv[0]; hg[1] = hv[0]; } }
            f32x4 pv2, pv1, pg2, pg1;
#pragma unroll
            for (int j = 0; j < 4; ++j) { pv2[j] = dpp_shr1(hv[6][j]); pv1[j] = dpp_shr1(hv[7][j]); pg2[j] = dpp_shr1(hg[6][j]); pg1[j] = dpp_shr1(hg[7][j]); }
            if (SAMP) { if (first) { const float* ps = past + (size_t)bb * 2 * NUP; pv2 = *(const f32x4*)(ps + cv); pv1 = *(const f32x4*)(ps + NUP + cv); pg2 = *(const f32x4*)(ps + cgt); pg1 = *(const f32x4*)(ps + NUP + cgt); } }
#pragma unroll
            for (int tau = 0; tau < 8; ++tau) {
                const f32x4 a2v = (tau >= 2) ? hv[tau >= 2 ? tau - 2 : 0] : (tau == 0 ? pv2 : pv1);
                const f32x4 a1v = (tau >= 1) ? hv[tau >= 1 ? tau - 1 : 0] : pv1;
                const f32x4 a2g = (tau >= 2) ? hg[tau >= 2 ? tau - 2 : 0] : (tau == 0 ? pg2 : pg1);
                const f32x4 a1g = (tau >= 1) ? hg[tau >= 1 ? tau - 1 : 0] : pg1;
                const f32x4 ov = bv + wv0 * a2v + wv1 * a1v + wv2 * hv[tau];
                const f32x4 og = bg + wg0 * a2g + wg1 * a1g + wg2 * hg[tau];
                const float g0 = ov[0] * silu_f(og[0]), g1 = ov[1] * silu_f(og[1]), g2 = ov[2] * silu_f(og[2]), g3 = ov[3] * silu_f(og[3]);
                if (!SAMP) { const int t = tb + tau; const bool ok = (t >= 0) && (t < 8192) && (fr > 0 || tau >= 2);
                    const unsigned off = ok ? (unsigned)(((int)grow0 + tau) * DFF + cv) * 2u : (unsigned)((size_t)MP * DFF * 2) + (unsigned)(fr + 16 * fq) * 8u;
                    u32x2 w; w.x = pk2(g0, g1); w.y = pk2(g2, g3); *(u32x2*)(G8 + off) = w; }
                else { u32x2 w; w.x = pk2(g0, g1); w.y = pk2(g2, g3); *(u32x2*)(GS + (size_t)(grow0 + tau) * DFF + cv) = w; }
            }
        }
    }
};

DI f32x16 small_block_p(const bf16_t* xp, const bf16_t* wp, int K);
DI f32x16 small_block(const bf16_t* X, const bf16_t* Wt, int K, int row0, int col0, int lane) {
    const int r = lane & 31, h2 = lane >> 5;
    return small_block_p(X + (size_t)(row0 + r) * K + 8 * h2, Wt + (size_t)(col0 + r) * K + 8 * h2, K);
}
DI f32x16 small_block_p(const bf16_t* xp, const bf16_t* wp, int K) {
    f32x16 acc;
#pragma unroll
    for (int i = 0; i < 16; ++i) acc[i] = 0.f;
    int k0 = 0;
#pragma unroll 1
    for (; k0 + 256 <= K; k0 += 256) {
        bf16x8 a[16], b[16];
#pragma unroll
        for (int j = 0; j < 16; ++j) { a[j] = *(const bf16x8*)(wp + k0 + 16 * j); b[j] = *(const bf16x8*)(xp + k0 + 16 * j); }
#pragma unroll
        for (int j = 0; j < 16; ++j) { pin(a[j]); pin(b[j]); }
#pragma unroll
        for (int j = 0; j < 16; ++j) acc = MFMA32(a[j], b[j], acc);
    }
    if (k0 < K) {
        bf16x8 a[8], b[8];
#pragma unroll
        for (int j = 0; j < 8; ++j) { a[j] = *(const bf16x8*)(wp + k0 + 16 * j); b[j] = *(const bf16x8*)(xp + k0 + 16 * j); }
#pragma unroll
        for (int j = 0; j < 8; ++j) { pin(a[j]); pin(b[j]); }
#pragma unroll
        for (int j = 0; j < 8; ++j) acc = MFMA32(a[j], b[j], acc);
    }
    return acc;
}
DI void small_inproj(KP P) {
    int tid = threadIdx.x; asm volatile("" : "+v"(tid));
    const int lane = tid & 63, wave = tid >> 6, gw = blockIdx.x * 8 + wave, NGW = gridDim.x * 8, r = lane & 31, h2 = lane >> 5;
    const bf16_t* XB = (const bf16_t*)(P->ws + WS_XB); const bf16_t* WI = (const bf16_t*)(P->ws + WS_WIN);
    float* DT = (float*)(P->ws + WS_DT); float* out = P->out;
    for (int task = gw; task < 1024 + 16 * 97; task += NGW) {
        if (task < 1024) {
            const f32x16 acc = small_block(XB, WI, 1024, task * 32, 3072, lane);
            *(f32x4*)(DT + (size_t)(task * 32 + r) * 8 + 4 * h2) = (f32x4){acc[0], acc[1], acc[2], acc[3]};
            continue;
        }
        const int t2 = task - 1024, sb = t2 / 97, cb = t2 - sb * 97, row = MP + sb * 32 + r, col0 = cb * 32;
        const f32x16 acc = small_block(XB, WI, 1024, MP + sb * 32, col0, lane);
#pragma unroll
        for (int g = 0; g < 4; ++g) {
            const int col = col0 + 8 * g + 4 * h2; const f32x4 v = {acc[4 * g], acc[4 * g + 1], acc[4 * g + 2], acc[4 * g + 3]};
            u32x2 w; w.x = pk2(v[0], v[1]); w.y = pk2(v[2], v[3]);
            if (col < 512) *(u32x2*)((bf16_t*)(P->ws + WS_Q) + (size_t)row * 512 + col) = w;
            else if (col < 1024) { *(u32x2*)((bf16_t*)(P->ws + WS_KS) + ((size_t)sb * 544 + 512 + r) * 512 + col - 512) = w; *(f32x4*)(out + O_NKS + (size_t)(sb * 32 + r) * 512 + col - 512) = v; }
            else if (col < 1536) { const int c = col - 1024, head = c >> 6, d0 = c & 63, t = 512 + r, tt = t & 15, hh = (tt >> 2) & 1, jj = ((tt >> 3) << 2) | (tt & 3);
                bf16_t* p = (bf16_t*)(P->ws + WS_VFS) + ((size_t)(sb * 8 + head) * 34 + (t >> 4)) * 1024 + (hh * 64 + d0) * 8 + jj;
                p[0] = (bf16_t)(w.x & 0xffff); p[8] = (bf16_t)(w.x >> 16); p[16] = (bf16_t)(w.y & 0xffff); p[24] = (bf16_t)(w.y >> 16);
                *(f32x4*)(out + O_NVS + (size_t)(sb * 32 + r) * 512 + c) = v; }
            else if (col < 2048) *(u32x2*)((bf16_t*)(P->ws + WS_Z) + (size_t)row * 512 + col - 1536) = w;
            else if (col < 3072) { *(u32x2*)((bf16_t*)(P->ws + WS_XBC) + (size_t)row * 1024 + col - 2048) = w;
                if (r >= 29) *(f32x4*)(out + O_SCS + ((size_t)(sb * 3 + r - 29)) * 1024 + col - 2048) = v; }
            else if (col < 3080) *(f32x4*)(DT + (size_t)row * 8 + col - 3072) = v;
        }
    }
}
DI void small_down_splitk(KP P, LAS unsigned char* lds, int tid_in) {
    int tid = tid_in; asm volatile("" : "+v"(tid));
    const int lane = tid & 63, wave = __builtin_amdgcn_readfirstlane(tid >> 6), r = lane & 31, h2 = lane >> 5;
    const int tl = wave / 3, kq = wave - 3 * tl;
    const bf16_t* X = (const bf16_t*)(P->ws + WS_GS); const bf16_t* Wt = (const bf16_t*)(P->ws + WS_WDOWN);
    LAS float* part = (LAS float*)lds;
    for (int pair = blockIdx.x; pair < 256; pair += gridDim.x) {
        const int task = pair * 2 + tl, sb = task >> 5, cb = task & 31, col0 = cb * 32;
        __syncthreads();
        if (tl < 2) {
            const f32x16 acc = small_block_p(X + (size_t)(sb * 32 + r) * DFF + kq * 896 + 8 * h2, Wt + (size_t)(col0 + r) * DFF + kq * 896 + 8 * h2, 896);
#pragma unroll
            for (int i = 0; i < 16; ++i) part[((tl * 3 + kq) * 16 + i) * 64 + lane] = acc[i];
        }
        __syncthreads();
        if (tl < 2 && kq == 0) {
            const int row = MP + sb * 32 + r;
#pragma unroll
            for (int g = 0; g < 4; ++g) {
                f32x4 v;
#pragma unroll
                for (int e = 0; e < 4; ++e) { const int i = 4 * g + e; v[e] = part[((tl * 3 + 0) * 16 + i) * 64 + lane] + part[((tl * 3 + 1) * 16 + i) * 64 + lane] + part[((tl * 3 + 2) * 16 + i) * 64 + lane]; }
                const int col = col0 + 8 * g + 4 * h2;
                const u32x2 w = *(const u32x2*)((const bf16_t*)(P->ws + WS_XB) + (size_t)row * 1024 + col); const f32x4 xv = {bf_lo(w.x), bf_hi(w.x), bf_lo(w.y), bf_hi(w.y)};
                const f32x4 o = xv * ALPHA + v; u32x2 wo; wo.x = pk2(o[0], o[1]); wo.y = pk2(o[2], o[3]);
                *(u32x2*)((bf16_t*)(P->ws + WS_A2) + (size_t)row * 1024 + col) = wo;
            }
        }
    }
}
DI void small_out_splitk(KP P, LAS unsigned char* lds, int tid_in) {
    int tid = tid_in; asm volatile("" : "+v"(tid));
    const int lane = tid & 63, wave = __builtin_amdgcn_readfirstlane(tid >> 6), r = lane & 31, h2 = lane >> 5;
    const int tl = wave >> 2, kq = wave & 3;
    const bf16_t* X = (const bf16_t*)(P->ws + WS_A2); const bf16_t* Wt = (const bf16_t*)(P->ws + WS_WOUT);
    LAS float* part = (LAS float*)lds;
    for (int pair = blockIdx.x; pair < 256; pair += gridDim.x) {
        const int task = pair * 2 + tl, sb = task >> 5, cb = task & 31, col0 = cb * 32;
        __syncthreads();
        const f32x16 acc = small_block_p(X + (size_t)(MP + sb * 32 + r) * 1024 + kq * 256 + 8 * h2, Wt + (size_t)(col0 + r) * 1024 + kq * 256 + 8 * h2, 256);
#pragma unroll
        for (int i = 0; i < 16; ++i) part[((tl * 4 + kq) * 16 + i) * 64 + lane] = acc[i];
        __syncthreads();
        if (kq == 0) {
            const int row = MP + sb * 32 + r;
#pragma unroll
            for (int g = 0; g < 4; ++g) {
                f32x4 v;
#pragma unroll
                for (int e = 0; e < 4; ++e) { const int i = 4 * g + e; v[e] = (part[((tl * 4 + 0) * 16 + i) * 64 + lane] + part[((tl * 4 + 1) * 16 + i) * 64 + lane]) + (part[((tl * 4 + 2) * 16 + i) * 64 + lane] + part[((tl * 4 + 3) * 16 + i) * 64 + lane]); }
                const int col = col0 + 8 * g + 4 * h2;
                const f32x4 xv = *(const f32x4*)(P->in[1] + (size_t)(row - MP) * 1024 + col);
                const f32x4 o = xv * ALPHA + v; u32x2 wo; wo.x = pk2(o[0], o[1]); wo.y = pk2(o[2], o[3]);
                *(u32x2*)((bf16_t*)(P->out + O_Y) + (size_t)row * 1024 + col) = wo;
            }
        }
    }
}
DI void small_ffnconv_prompt(KP P, LAS unsigned char* lds, int tid_in) {
    int tid = tid_in; asm volatile("" : "+v"(tid));
    const int lane = tid & 63, kq = __builtin_amdgcn_readfirstlane(tid >> 6), r = lane & 31, h2 = lane >> 5;
    const bf16_t* X1 = (const bf16_t*)(P->ws + WS_XB); const bf16_t* WU = (const bf16_t*)(P->ws + WS_WUP);
    const int rr = r & 7, b = rr >> 1, t = 8190 + (rr & 1);
    LAS float* part = (LAS float*)lds;
    for (int task = blockIdx.x; task < 168; task += gridDim.x) {
        const int rho0 = task * 32, n0 = ((rho0 >> 7) & 1) * DFF + (rho0 >> 8) * 128 + (rho0 & 127);
        __syncthreads();
        const f32x16 acc = small_block_p(X1 + ((size_t)b * 8192 + t) * 1024 + kq * 128 + 8 * h2, WU + (size_t)(rho0 + r) * 1024 + kq * 128 + 8 * h2, 128);
#pragma unroll
        for (int i = 0; i < 16; ++i) part[(kq * 16 + i) * 64 + lane] = acc[i];
        __syncthreads();
        if (kq == 0 && r < 8) {
#pragma unroll
            for (int g = 0; g < 4; ++g) { f32x4 v;
#pragma unroll
                for (int e = 0; e < 4; ++e) { float s = 0.f;
#pragma unroll
                    for (int q = 0; q < 8; ++q) s += part[(q * 16 + 4 * g + e) * 64 + lane];
                    v[e] = s; }
                *(f32x4*)(P->out + O_FCP + (size_t)(b * 2 + (rr & 1)) * NUP + n0 + 8 * g + 4 * h2) = v; }
        }
    }
}
template <bool DOWN> DI void small_resid(KP P, int tid_in) {
    int tid = tid_in; asm volatile("" : "+v"(tid));
    const int lane = tid & 63, wave = tid >> 6, gw = blockIdx.x * 8 + wave, NGW = gridDim.x * 8, r = lane & 31, h2 = lane >> 5;
    const bf16_t* X = DOWN ? (const bf16_t*)(P->ws + WS_GS) - (size_t)MP * DFF : (const bf16_t*)(P->ws + WS_A2); const bf16_t* Wt = (const bf16_t*)(P->ws + (DOWN ? WS_WDOWN : WS_WOUT));
    const int K = DOWN ? DFF : 1024;
    for (int task = gw; task < 512; task += NGW) {
        const int sb = task >> 5, cb = task & 31, row = MP + sb * 32 + r, col0 = cb * 32;
        const f32x16 acc = small_block(X, Wt, K, MP + sb * 32, col0, lane);
#pragma unroll
        for (int g = 0; g < 4; ++g) {
            const int col = col0 + 8 * g + 4 * h2; const f32x4 v = {acc[4 * g], acc[4 * g + 1], acc[4 * g + 2], acc[4 * g + 3]};
            f32x4 xv;
            if (DOWN) { const u32x2 w = *(const u32x2*)((const bf16_t*)(P->ws + WS_XB) + (size_t)row * 1024 + col); xv = (f32x4){bf_lo(w.x), bf_hi(w.x), bf_lo(w.y), bf_hi(w.y)}; }
            else xv = *(const f32x4*)(P->in[1] + (size_t)(row - MP) * 1024 + col);
            bf16_t* U = DOWN ? (bf16_t*)(P->ws + WS_A2) : (bf16_t*)(P->out + O_Y);
            const f32x4 o = xv * ALPHA + v; u32x2 wo; wo.x = pk2(o[0], o[1]); wo.y = pk2(o[2], o[3]); *(u32x2*)(U + (size_t)row * 1024 + col) = wo;
        }
    }
}

DI void p0_transpose_item(const float* W, int K, int N, bf16_t* WT, int drow0, LAS float* scr, int k0, int n0, int lane) {
    const int nn = n0 + (lane & 31); const int nc = (nn < N) ? nn : N - 1;
    float tv[32];
#pragma unroll
    for (int i = 0; i < 32; ++i) tv[i] = W[(size_t)(k0 + 2 * i + (lane >> 5)) * N + nc];
#pragma unroll
    for (int i = 0; i < 32; ++i) scr[(2 * i + (lane >> 5)) * 33 + (lane & 31)] = tv[i];
    asm volatile("s_waitcnt lgkmcnt(0)" ::: "memory");
    const int c = lane & 7;
#pragma unroll
    for (int j = 0; j < 4; ++j) { const int n = (lane >> 3) + 8 * j; const LAS float* s = scr + (8 * c) * 33 + n;
        u32x4 o; o.x = pk2(s[0 * 33], s[1 * 33]); o.y = pk2(s[2 * 33], s[3 * 33]); o.z = pk2(s[4 * 33], s[5 * 33]); o.w = pk2(s[6 * 33], s[7 * 33]);
        if (n0 + n < N) *(u32x4*)(WT + (size_t)(drow0 + n) * K + k0 + 8 * c) = o; }
    asm volatile("s_waitcnt lgkmcnt(0)" ::: "memory");
}
DI void p0_transpose_item_f8(const float* W, int K, int N, unsigned char* WT, int pitch, int drow0, LAS float* scr, int k0, int n0, int lane, float sc) {
    const int nn = n0 + (lane & 31); const int nc = (nn < N) ? nn : N - 1;
    float tv[32];
#pragma unroll
    for (int i = 0; i < 32; ++i) tv[i] = W[(size_t)(k0 + 2 * i + (lane >> 5)) * N + nc];
#pragma unroll
    for (int i = 0; i < 32; ++i) scr[(2 * i + (lane >> 5)) * 33 + (lane & 31)] = tv[i] * sc;
    asm volatile("s_waitcnt lgkmcnt(0)" ::: "memory");
    const int c = lane & 7;
#pragma unroll
    for (int j = 0; j < 4; ++j) { const int n = (lane >> 3) + 8 * j; const LAS float* s = scr + (8 * c) * 33 + n;
        u32x2 o; o.x = pk4_f8(s[0 * 33], s[1 * 33], s[2 * 33], s[3 * 33]); o.y = pk4_f8(s[4 * 33], s[5 * 33], s[6 * 33], s[7 * 33]);
        if (n0 + n < N) *(u32x2*)(WT + (size_t)(drow0 + n) * pitch + k0 + 8 * c) = o; }
    asm volatile("s_waitcnt lgkmcnt(0)" ::: "memory");
}
constexpr int LATE_ITEMS = 16 * 32 + 16 * 168 + 42 * 32, LATE_WG_ITEMS = LATE_ITEMS / 64;
DI void convert_late_item(KP P, LAS unsigned char* lds, int wi) {
    int tid = threadIdx.x; asm volatile("" : "+v"(tid));
    const int lane = tid & 63, wave = tid >> 6;
    __syncthreads();
    LAS float* scr = (LAS float*)(lds + wave * 8448);
    constexpr int I_OUT = 16 * 32, I_UP = 16 * 168;
#pragma unroll 1
    for (int j = 0; j < 8; ++j) {
        int r = wi * 64 + wave * 8 + j;
        if (r < I_OUT) { const int kb = r / 32, nb = r % 32; p0_transpose_item(P->in[16], 1024, 1024, (bf16_t*)(P->ws + WS_WOUT), nb * 32, scr, kb * 64, nb * 32, lane); continue; } r -= I_OUT;
        if (r < I_UP) { const int kb = r / 168, nb = r % 168; const int n0 = nb * 32; const int np = (n0 < DFF) ? n0 : n0 - DFF;
            const int drow = (np >> 7) * 256 + ((n0 < DFF) ? 0 : 128) + (np & 127);
            p0_transpose_item(P->in[19], 1024, NUP, (bf16_t*)(P->ws + WS_WUP), drow, scr, kb * 64, n0, lane);
            p0_transpose_item_f8(P->in[19], 1024, NUP, P->ws + WS_WUP8, 1024, drow, scr, kb * 64, n0, lane, SC_WUP); continue; } r -= I_UP;
        { const int kb = r / 32, nb = r % 32; p0_transpose_item(P->in[22], DFF, 1024, (bf16_t*)(P->ws + WS_WDOWN), nb * 32, scr, kb * 64, nb * 32, lane); }
    }
}
DI void phase_convert(KP P, LAS unsigned char* lds) {
    int tid = threadIdx.x; asm volatile("" : "+v"(tid));
    const int lane = tid & 63, wave = tid >> 6, G = gridDim.x;
    LAS float* scr = (LAS float*)(lds + wave * 8448);
    const int gw = blockIdx.x * 8 + wave, NGW = G * 8;
    constexpr int I_IN = 16 * 97;
    for (int it = gw; it < I_IN; it += NGW) { const int kb = it / 97, nb = it % 97; p0_transpose_item(P->in[7], 1024, NIN, (bf16_t*)(P->ws + WS_WIN), nb * 32, scr, kb * 64, nb * 32, lane); }
    const size_t gt = (size_t)blockIdx.x * NT + tid, NGT = (size_t)G * NT;
    { bf16_t* XB = (bf16_t*)(P->ws + WS_XB);
      constexpr size_t NCH = (size_t)MT * 128;
      size_t i0 = gt;
      for (; i0 + 3 * NGT < NCH; i0 += 4 * NGT) {
          f32x4 a[4], b[4];
#pragma unroll
          for (int u = 0; u < 4; ++u) { const size_t e = (i0 + u * NGT) * 8; const float* src = (e < (size_t)MP * 1024) ? P->in[0] + e : P->in[1] + (e - (size_t)MP * 1024);
              a[u] = __builtin_nontemporal_load((const f32x4*)src); b[u] = __builtin_nontemporal_load((const f32x4*)(src + 4)); }
#pragma unroll
          for (int u = 0; u < 4; ++u) { pin(a[u]); pin(b[u]); }
#pragma unroll
          for (int u = 0; u < 4; ++u) { u32x4 w; w.x = pk2(a[u][0], a[u][1]); w.y = pk2(a[u][2], a[u][3]); w.z = pk2(b[u][0], b[u][1]); w.w = pk2(b[u][2], b[u][3]); *(u32x4*)(XB + (i0 + u * NGT) * 8) = w; }
      }
      for (; i0 < NCH; i0 += NGT) { const size_t e = i0 * 8; const float* src = (e < (size_t)MP * 1024) ? P->in[0] + e : P->in[1] + (e - (size_t)MP * 1024);
          const f32x4 a = *(const f32x4*)src, b = *(const f32x4*)(src + 4); u32x4 w; w.x = pk2(a[0], a[1]); w.y = pk2(a[2], a[3]); w.z = pk2(b[0], b[1]); w.w = pk2(b[2], b[3]); *(u32x4*)(XB + e) = w; }
    }
    { bf16_t* WI = (bf16_t*)(P->ws + WS_WIN) + (size_t)NIN * 1024;
      for (size_t i = gt; i < (size_t)(NINP - NIN) * 128; i += NGT) *(u32x4*)(WI + i * 8) = (u32x4){0u, 0u, 0u, 0u}; }
    { bf16_t* KS = (bf16_t*)(P->ws + WS_KS); bf16_t* VF = (bf16_t*)(P->ws + WS_VFS);
      for (size_t i = gt; i < (size_t)16 * 512 * 64; i += NGT) {
          const int cgp = (int)(i & 63), t = (int)((i >> 6) & 511), b = (int)(i >> 15);
          const float* ks = P->in[2] + ((size_t)(b * 512 + t)) * 512 + cgp * 8; const float* vs = P->in[3] + ((size_t)(b * 512 + t)) * 512 + cgp * 8;
          const f32x4 a = *(const f32x4*)ks, c = *(const f32x4*)(ks + 4); u32x4 w; w.x = pk2(a[0], a[1]); w.y = pk2(a[2], a[3]); w.z = pk2(c[0], c[1]); w.w = pk2(c[2], c[3]);
          *(u32x4*)(KS + ((size_t)b * 544 + t) * 512 + cgp * 8) = w;
          const f32x4 va = *(const f32x4*)vs, vc = *(const f32x4*)(vs + 4);
          const int head = cgp >> 3, d0 = (cgp & 7) * 8, tt = t & 15, hh = (tt >> 2) & 1, jj = ((tt >> 3) << 2) | (tt & 3);
          bf16_t* p = VF + ((size_t)(b * 8 + head) * 34 + (t >> 4)) * 1024 + (hh * 64 + d0) * 8 + jj;
          const unsigned w0 = pk2(va[0], va[1]), w1 = pk2(va[2], va[3]), w2 = pk2(vc[0], vc[1]), w3 = pk2(vc[2], vc[3]);
          p[0] = (bf16_t)(w0 & 0xffff); p[8] = (bf16_t)(w0 >> 16); p[16] = (bf16_t)(w1 & 0xffff); p[24] = (bf16_t)(w1 >> 16);
          p[32] = (bf16_t)(w2 & 0xffff); p[40] = (bf16_t)(w2 >> 16); p[48] = (bf16_t)(w3 & 0xffff); p[56] = (bf16_t)(w3 >> 16);
      } }
}

template <bool OUT_BF16>
DI void phase_ln(const bf16_t* src, const float* gam, const float* bet, void* dst, unsigned char* dst8, unsigned char* g8pad, int tid_in) {
    int tid = tid_in; asm volatile("" : "+v"(tid));
    const int lane = tid & 63, wave = tid >> 6, gw = blockIdx.x * 8 + wave, NGW = gridDim.x * 8;
    f32x4 g4[4], b4[4];
#pragma unroll
    for (int j = 0; j < 4; ++j) { g4[j] = *(const f32x4*)(gam + (lane + 64 * j) * 4); b4[j] = *(const f32x4*)(bet + (lane + 64 * j) * 4); }
    for (int row0 = gw; row0 < MT; row0 += 2 * NGW) {
        u32x2 wv[2][4];
#pragma unroll
        for (int u = 0; u < 2; ++u) { const int row = row0 + u * NGW;
#pragma unroll
            for (int j = 0; j < 4; ++j) { wv[u][j] = (u32x2){0u, 0u}; if (row < MT) wv[u][j] = __builtin_nontemporal_load((const u32x2*)(src + (size_t)row * 1024 + (lane + 64 * j) * 4)); } }
#pragma unroll
        for (int u = 0; u < 2; ++u) { const int row = row0 + u * NGW; if (row >= MT) continue;
            f32x4 v[4]; float s = 0.f;
#pragma unroll
            for (int j = 0; j < 4; ++j) { const u32x2 w = wv[u][j]; v[j] = (f32x4){bf_lo(w.x), bf_hi(w.x), bf_lo(w.y), bf_hi(w.y)}; s += (v[j][0] + v[j][1]) + (v[j][2] + v[j][3]); }
#pragma unroll
            for (int o = 1; o < 64; o <<= 1) s += __shfl_xor(s, o);
            const float mean = s * (1.f / 1024.f); float q = 0.f;
#pragma unroll
            for (int j = 0; j < 4; ++j) { v[j] = v[j] - mean; q += (v[j][0] * v[j][0] + v[j][1] * v[j][1]) + (v[j][2] * v[j][2] + v[j][3] * v[j][3]); }
#pragma unroll
            for (int o = 1; o < 64; o <<= 1) q += __shfl_xor(q, o);
            const float rstd = 1.0f / sqrtf(q * (1.f / 1024.f) + 1e-5f);
#pragma unroll
            for (int j = 0; j < 4; ++j) { const f32x4 o = v[j] * rstd * g4[j] + b4[j];
                if (OUT_BF16) { u32x2 w; w.x = pk2(o[0], o[1]); w.y = pk2(o[2], o[3]); *(u32x2*)((bf16_t*)dst + (size_t)row * 1024 + (lane + 64 * j) * 4) = w;
                    *(unsigned*)(dst8 + (size_t)row * 1024 + (lane + 64 * j) * 4) = pk4_f8(o[0] * SC_X1, o[1] * SC_X1, o[2] * SC_X1, o[3] * SC_X1); }
                else *(f32x4*)((float*)dst + (size_t)row * 1024 + (lane + 64 * j) * 4) = o; }
        }
    }
}

constexpr int XCS = 2080;
constexpr int L_DT = 64 * XCS;
constexpr int L_AC = L_DT + 2048;
constexpr int L_RED = L_AC + 2048;

DI float ssd_dt_scan(KP P, LAS unsigned char* lds, int r0, int Lv, int h, int lane) {
    const float* DT = (const float*)(P->ws + WS_DT);
    float dt = 0.f;
    if (lane < Lv) { const float x = DT[(size_t)(r0 + lane) * 8 + h] + P->in[12][h]; dt = (x > 20.f) ? x : log1pf(expf(x)); }
    const float A = -expf(P->in[13][h]);
    float a = dt * A;
#pragma unroll
    for (int off = 1; off < 64; off <<= 1) { const float v = __shfl_up(a, off); if (lane >= off) a += v; }
    ((LAS float*)(lds + L_DT))[h * 64 + lane] = dt;
    ((LAS float*)(lds + L_AC))[h * 64 + lane] = a;
    return __shfl(a, 63);
}
template <bool DEC, int NCG>
DI void ssd_conv_to_lds(KP P, LAS unsigned char* lds, int tid, int r0, int Lv, bool samp, int sb, bool has_prev) {
    const int tblk = tid >> 7, cgp = tid & 127;
    if (cgp >= NCG) return;
    const int ch0 = cgp * 8, t0 = tblk * 16;
    const bf16_t* XBC = (const bf16_t*)(P->ws + WS_XBC);
    const float* cwp = P->in[10]; const float* cbp = P->in[11];
    float w[4][8], bias[8];
#pragma unroll
    for (int k = 0; k < 4; ++k) { const f32x4 a = *(const f32x4*)(cwp + k * 1024 + ch0), b = *(const f32x4*)(cwp + k * 1024 + ch0 + 4);
#pragma unroll
        for (int e = 0; e < 4; ++e) { w[k][e] = a[e]; w[k][4 + e] = b[e]; } }
    { const f32x4 a = *(const f32x4*)(cbp + ch0), b = *(const f32x4*)(cbp + ch0 + 4);
#pragma unroll
        for (int e = 0; e < 4; ++e) { bias[e] = a[e]; bias[4 + e] = b[e]; } }
    u32x4 raw[19]; f32x4 pa[3], pb[3];
    const bool halo_f32 = samp && (t0 == 0);
#pragma unroll
    for (int k = 0; k < 19; ++k) {
        const int tt = t0 - 3 + k;
        raw[k] = (u32x4){0u, 0u, 0u, 0u};
        if (tt >= 0) { if (tt < Lv) raw[k] = *(const u32x4*)(XBC + (size_t)(r0 + tt) * 1024 + ch0); }
        else if (!samp && has_prev) raw[k] = *(const u32x4*)(XBC + (size_t)(r0 + tt) * 1024 + ch0);
    }
#pragma unroll
    for (int k = 0; k < 3; ++k) { pa[k] = (f32x4){0.f, 0.f, 0.f, 0.f}; pb[k] = pa[k];
        if (halo_f32) { const float* s = P->in[5] + ((size_t)(sb * 3 + k)) * 1024 + ch0; pa[k] = *(const f32x4*)s; pb[k] = *(const f32x4*)(s + 4); } }
    float xw[3][8];
#pragma unroll
    for (int k = 0; k < 3; ++k) {
        const u32x4 q = raw[k];
        xw[k][0] = bf_lo(q.x); xw[k][1] = bf_hi(q.x); xw[k][2] = bf_lo(q.y); xw[k][3] = bf_hi(q.y); xw[k][4] = bf_lo(q.z); xw[k][5] = bf_hi(q.z); xw[k][6] = bf_lo(q.w); xw[k][7] = bf_hi(q.w);
        if (halo_f32) {
#pragma unroll
            for (int e = 0; e < 4; ++e) { xw[k][e] = pa[k][e]; xw[k][4 + e] = pb[k][e]; } }
    }
    const int head = cgp >> 3;
    const LAS float* sdt = (const LAS float*)(lds + L_DT) + head * 64; const LAS float* sac = (const LAS float*)(lds + L_AC) + head * 64;
    const float atot = (cgp < 64) ? sac[63] : 0.f;
#pragma unroll
    for (int i = 0; i < 16; ++i) {
        const int t = t0 + i; float xc[8];
        { const u32x4 q = raw[3 + i];
          xc[0] = bf_lo(q.x); xc[1] = bf_hi(q.x); xc[2] = bf_lo(q.y); xc[3] = bf_hi(q.y); xc[4] = bf_lo(q.z); xc[5] = bf_hi(q.z); xc[6] = bf_lo(q.w); xc[7] = bf_hi(q.w); }
        float f = 1.f;
        if (cgp < 64) { f = sdt[t]; if (DEC) f *= __builtin_amdgcn_exp2f((atot - sac[t]) * LOG2E); }
        if (t >= Lv) f = 0.f;
        float o[8];
#pragma unroll
        for (int e = 0; e < 8; ++e) { const float v = bias[e] + w[0][e] * xw[0][e] + w[1][e] * xw[1][e] + w[2][e] * xw[2][e] + w[3][e] * xc[e]; o[e] = silu_f(v) * f; }
        u32x4 q; q.x = pk2(o[0], o[1]); q.y = pk2(o[2], o[3]); q.z = pk2(o[4], o[5]); q.w = pk2(o[6], o[7]);
        *(LAS u32x4*)(lds + t * XCS + ch0 * 2) = q;
#pragma unroll
        for (int e = 0; e < 8; ++e) { xw[0][e] = xw[1][e]; xw[1][e] = xw[2][e]; xw[2][e] = xc[e]; }
    }
}
DI void chunk_geom(int ch, bool& samp, int& sb, int& r0, int& Lv, bool& has_prev) {
    samp = ch >= 512; sb = ch - 512;
    if (!samp) { r0 = ch * 64; Lv = 64; has_prev = (ch & 127) != 0; } else { r0 = MP + sb * 32; Lv = 32; has_prev = false; }
}
DI void ssd_states_tile(KP P, LAS unsigned char* lds, int ch) {
    int tid = threadIdx.x; asm volatile("" : "+v"(tid));
    const int lane = tid & 63, h = __builtin_amdgcn_readfirstlane(tid >> 6);
    bool samp, has_prev; int sb, r0, Lv; chunk_geom(ch, samp, sb, r0, Lv, has_prev);
    __syncthreads();
    const float atot = ssd_dt_scan(P, lds, r0, Lv, h, lane);
    if (lane == 0) ((float*)(P->ws + WS_DEC))[ch * 8 + h] = expf(atot);
    __syncthreads();
    ssd_conv_to_lds<true, 96>(P, lds, tid, r0, Lv, samp, sb, has_prev);
    __syncthreads();
    const int r = lane & 31, h2 = lane >> 5, blk = (lane >> 4) & 1, i16 = lane & 15, q = i16 >> 2, pp = i16 & 3, g = h >> 2;
    bf16_t* ST = (bf16_t*)(P->ws + WS_ST) + ((size_t)ch * 8 + h) * 8192;
#pragma unroll 1
    for (int nh = 0; nh < 2; ++nh) {
        f32x16 acc[2][2];
#pragma unroll
        for (int a = 0; a < 2; ++a)
#pragma unroll
            for (int b = 0; b < 2; ++b)
#pragma unroll
                for (int i = 0; i < 16; ++i) acc[a][b][i] = 0.f;
#pragma unroll
        for (int sp = 0; sp < 4; ++sp) {
            LAS unsigned char* rlo = lds + (16 * sp + 8 * h2 + q) * XCS + (16 * blk + 4 * pp) * 2;
            LAS unsigned char* rhi = rlo + 4 * XCS;
            bf16x8 af[2], bfr[2];
#pragma unroll
            for (int pb = 0; pb < 2; ++pb) af[pb] = tr_frag(rlo + (h * 64 + 32 * pb) * 2, rhi + (h * 64 + 32 * pb) * 2);
#pragma unroll
            for (int nb = 0; nb < 2; ++nb) bfr[nb] = tr_frag(rlo + (512 + g * 128 + 64 * nh + 32 * nb) * 2, rhi + (512 + g * 128 + 64 * nh + 32 * nb) * 2);
#pragma unroll
            for (int pb = 0; pb < 2; ++pb)
#pragma unroll
                for (int nb = 0; nb < 2; ++nb) acc[pb][nb] = MFMA32(af[pb], bfr[nb], acc[pb][nb]);
        }
#pragma unroll
        for (int pb = 0; pb < 2; ++pb)
#pragma unroll
            for (int nb = 0; nb < 2; ++nb) {
                bf16_t* sp_ = ST + (32 * pb + 4 * h2) * 128 + 64 * nh + 32 * nb + r;
#pragma unroll
                for (int i = 0; i < 16; ++i) sp_[((i & 3) + 8 * (i >> 2)) * 128] = (bf16_t)(pk2(acc[pb][nb][i], 0.f) & 0xffff);
            }
    }
}
DI void phase_scan(KP P, LAS unsigned char* lds) {
    int tid = threadIdx.x; asm volatile("" : "+v"(tid));
    unsigned* ST = (unsigned*)(P->ws + WS_ST); const float* DEC = (const float*)(P->ws + WS_DEC);
    LAS float* sdec = (LAS float*)lds;
    for (int blk = blockIdx.x; blk < 256; blk += gridDim.x) {
        const int b = blk >> 6, h = (blk >> 3) & 7, rem = (blk & 63) * 512 + tid;
        __syncthreads();
        if (tid < 128) sdec[tid] = DEC[(b * 128 + tid) * 8 + h];
        __syncthreads();
        float H0 = 0.f, H1 = 0.f;
        unsigned* sp = ST + (size_t)b * 128 * 32768 + rem;
#pragma unroll 1
        for (int c0 = 0; c0 < 128; c0 += 64) {
            unsigned w[64];
#pragma unroll
            for (int k = 0; k < 64; ++k) w[k] = sp[(size_t)(c0 + k) * 32768];
#pragma unroll
            for (int k = 0; k < 64; ++k) { const float d = sdec[c0 + k]; sp[(size_t)(c0 + k) * 32768] = pk2(H0, H1); H0 = H0 * d + bf_lo(w[k]); H1 = H1 * d + bf_hi(w[k]); }
        }
        *(f32x2*)(P->out + O_SSP + ((size_t)blk * 512 + tid) * 2) = (f32x2){H0, H1};
    }
}
DI void phase_sample_state(KP P) {
    int tid = threadIdx.x; asm volatile("" : "+v"(tid));
    const size_t gt = (size_t)blockIdx.x * NT + tid, NGT = (size_t)gridDim.x * NT;
    const unsigned* ST = (const unsigned*)(P->ws + WS_ST); const float* DEC = (const float*)(P->ws + WS_DEC);
    for (size_t pr0 = gt; pr0 < 524288; pr0 += 4 * NGT) {
        f32x2 h0[4]; unsigned w[4]; float d[4];
#pragma unroll
        for (int u = 0; u < 4; ++u) { const size_t pr = pr0 + u * NGT; h0[u] = (f32x2){0.f, 0.f}; w[u] = 0u; d[u] = 0.f;
            if (pr < 524288) { const int b = (int)(pr >> 15), rem = (int)(pr & 32767), h = rem >> 12, chq = 512 + b;
                h0[u] = *(const f32x2*)(P->in[4] + pr * 2); w[u] = ST[(size_t)chq * 32768 + rem]; d[u] = DEC[chq * 8 + h]; } }
#pragma unroll
        for (int u = 0; u < 4; ++u) { const size_t pr = pr0 + u * NGT;
            if (pr < 524288) *(f32x2*)(P->out + O_SSS + pr * 2) = (f32x2){h0[u][0] * d[u] + bf_lo(w[u]), h0[u][1] * d[u] + bf_hi(w[u])}; }
    }
}
DI void ssd_out_tile(KP P, LAS unsigned char* lds, int ch) {
    int tid = threadIdx.x; asm volatile("" : "+v"(tid));
    const int lane = tid & 63, h = __builtin_amdgcn_readfirstlane(tid >> 6);
    bool samp, has_prev; int sb, r0, Lv; chunk_geom(ch, samp, sb, r0, Lv, has_prev);
    __syncthreads();
    ssd_dt_scan(P, lds, r0, Lv, h, lane);
    __syncthreads();
    ssd_conv_to_lds<false, 128>(P, lds, tid, r0, Lv, samp, sb, has_prev);
    __syncthreads();
    const int r = lane & 31, h2 = lane >> 5, blk = (lane >> 4) & 1, i16 = lane & 15, q = i16 >> 2, pp = i16 & 3, g = h >> 2;
    const LAS float* sac = (const LAS float*)(lds + L_AC) + h * 64; const LAS float* sdt = (const LAS float*)(lds + L_DT) + h * 64;
    f32x16 cb[2][2];
#pragma unroll
    for (int a = 0; a < 2; ++a)
#pragma unroll
        for (int b = 0; b < 2; ++b)
#pragma unroll
            for (int i = 0; i < 16; ++i) cb[a][b][i] = 0.f;
    const bf16_t* PREV = (const bf16_t*)(P->ws + WS_ST) + ((size_t)ch * 8 + h) * 8192;
#pragma unroll 2
    for (int kk = 0; kk < 8; ++kk) {
        bf16x8 bm[2], cm[2];
#pragma unroll
        for (int x = 0; x < 2; ++x) {
            bm[x] = *(const LAS bf16x8*)(lds + (32 * x + r) * XCS + (512 + g * 128 + 16 * kk + 8 * h2) * 2);
            cm[x] = *(const LAS bf16x8*)(lds + (32 * x + r) * XCS + (768 + g * 128 + 16 * kk + 8 * h2) * 2);
        }
#pragma unroll
        for (int a = 0; a < 2; ++a)
#pragma unroll
            for (int b = 0; b < 2; ++b) cb[a][b] = MFMA32(bm[a], cm[b], cb[a][b]);
    }
    __builtin_amdgcn_sched_barrier(0);
    float acl[2]; acl[0] = sac[r]; acl[1] = sac[32 + r];
    f32x16 y[2][2];
#pragma unroll
    for (int a = 0; a < 2; ++a)
#pragma unroll
        for (int b = 0; b < 2; ++b)
#pragma unroll
            for (int i = 0; i < 16; ++i) y[a][b][i] = 0.f;
#pragma unroll
    for (int sbk = 0; sbk < 2; ++sbk) {
        float acs[16];
#pragma unroll
        for (int gi = 0; gi < 4; ++gi) { const f32x4 t4 = *(const LAS f32x4*)(sac + 32 * sbk + 8 * gi + 4 * h2); acs[4 * gi] = t4[0]; acs[4 * gi + 1] = t4[1]; acs[4 * gi + 2] = t4[2]; acs[4 * gi + 3] = t4[3]; }
#pragma unroll
        for (int s2 = 0; s2 < 2; ++s2) {
            bf16x8 pf[2];
#pragma unroll
            for (int lb = 0; lb < 2; ++lb) {
                const int l = 32 * lb + r; float m[8];
#pragma unroll
                for (int j = 0; j < 8; ++j) { const int i = 8 * s2 + j, s = 32 * sbk + crow(i, h2);
                    m[j] = (s <= l) ? cb[sbk][lb][i] * __builtin_amdgcn_exp2f((acl[lb] - acs[i]) * LOG2E) : 0.f; }
                pf[lb] = pack8(m[0], m[1], m[2], m[3], m[4], m[5], m[6], m[7]);
            }
            LAS unsigned char* rlo = lds + (32 * sbk + 16 * s2 + 4 * h2 + q) * XCS + (h * 64 + 16 * blk + 4 * pp) * 2;
            LAS unsigned char* rhi = rlo + 8 * XCS;
#pragma unroll
            for (int pb = 0; pb < 2; ++pb) { const bf16x8 xa = tr_frag(rlo + 64 * pb, rhi + 64 * pb);
#pragma unroll
                for (int lb = 0; lb < 2; ++lb) y[pb][lb] = MFMA32(xa, pf[lb], y[pb][lb]); }
        }
    }
    __builtin_amdgcn_sched_barrier(0);
    {
        f32x16 yo[2][2];
#pragma unroll
        for (int a = 0; a < 2; ++a)
#pragma unroll
            for (int b = 0; b < 2; ++b)
#pragma unroll
                for (int i = 0; i < 16; ++i) yo[a][b][i] = 0.f;
        bf16x8 pv[8][2];
#pragma unroll
        for (int kk = 0; kk < 8; ++kk)
#pragma unroll
            for (int x = 0; x < 2; ++x) {
                if (!samp) pv[kk][x] = *(const bf16x8*)(PREV + (32 * x + r) * 128 + 16 * kk + 8 * h2);
                else { const float* hp = P->in[4] + ((size_t)(sb * 8 + h) * 64 + 32 * x + r) * 128 + 16 * kk + 8 * h2; const f32x4 ha = *(const f32x4*)hp, hb = *(const f32x4*)(hp + 4);
                    pv[kk][x] = pack8(ha[0], ha[1], ha[2], ha[3], hb[0], hb[1], hb[2], hb[3]); }
            }
#pragma unroll
        for (int kk = 0; kk < 8; ++kk)
#pragma unroll
            for (int x = 0; x < 2; ++x) pin(pv[kk][x]);
#pragma unroll
        for (int kk = 0; kk < 8; ++kk) {
            bf16x8 cm[2];
#pragma unroll
            for (int x = 0; x < 2; ++x) cm[x] = *(const LAS bf16x8*)(lds + (32 * x + r) * XCS + (768 + g * 128 + 16 * kk + 8 * h2) * 2);
#pragma unroll
            for (int a = 0; a < 2; ++a)
#pragma unroll
                for (int b = 0; b < 2; ++b) yo[a][b] = MFMA32(pv[kk][a], cm[b], yo[a][b]);
        }
#pragma unroll
        for (int lb = 0; lb < 2; ++lb) { const float eo = __builtin_amdgcn_exp2f(acl[lb] * LOG2E);
#pragma unroll
            for (int pb = 0; pb < 2; ++pb)
#pragma unroll
                for (int i = 0; i < 16; ++i) y[pb][lb][i] += eo * yo[pb][lb][i]; }
    }
    __builtin_amdgcn_sched_barrier(0);
    const float Dh = P->in[14][h];
    const bf16_t* Z = (const bf16_t*)(P->ws + WS_Z);
    float ss[2] = {0.f, 0.f};
    u32x2 zq[2][2][4];
#pragma unroll
    for (int lb = 0; lb < 2; ++lb)
#pragma unroll
        for (int pb = 0; pb < 2; ++pb)
#pragma unroll
            for (int gi = 0; gi < 4; ++gi) { const int l = 32 * lb + r; zq[lb][pb][gi] = (u32x2){0u, 0u};
                if (l < Lv) zq[lb][pb][gi] = *(const u32x2*)(Z + (size_t)(r0 + l) * 512 + h * 64 + 32 * pb + 8 * gi + 4 * h2); }
#pragma unroll
    for (int lb = 0; lb < 2; ++lb)
#pragma unroll
        for (int pb = 0; pb < 2; ++pb)
#pragma unroll
            for (int gi = 0; gi < 4; ++gi) pin(zq[lb][pb][gi]);
#pragma unroll
    for (int lb = 0; lb < 2; ++lb) {
        const int l = 32 * lb + r; const bool ok = l < Lv;
        const float dtl = sdt[l]; const float dsk = ok ? Dh / dtl : 0.f;
#pragma unroll
        for (int pb = 0; pb < 2; ++pb)
#pragma unroll
            for (int gi = 0; gi < 4; ++gi) {
                const int p0 = 32 * pb + 8 * gi + 4 * h2;
                const u32x2 xq = *(const LAS u32x2*)(lds + l * XCS + (h * 64 + p0) * 2);
                const u32x2 zv2 = zq[lb][pb][gi];
                const float xv[4] = {bf_lo(xq.x), bf_hi(xq.x), bf_lo(xq.y), bf_hi(xq.y)}; const float zv[4] = {bf_lo(zv2.x), bf_hi(zv2.x), bf_lo(zv2.y), bf_hi(zv2.y)};
#pragma unroll
                for (int e = 0; e < 4; ++e) { const int i = 4 * gi + e; float v = y[pb][lb][i] + xv[e] * dsk; v *= silu_f(zv[e]); y[pb][lb][i] = v; ss[lb] += v * v; }
            }
    }
    LAS float* red = (LAS float*)(lds + L_RED);
#pragma unroll
    for (int lb = 0; lb < 2; ++lb) { ss[lb] += __shfl_xor(ss[lb], 32); if (h2 == 0) red[h * 64 + 32 * lb + r] = ss[lb]; }
    __syncthreads();
    bf16_t* A2 = (bf16_t*)(P->ws + WS_A2); const float* gam = P->in[15];
    f32x4 gv[2][4];
#pragma unroll
    for (int pb = 0; pb < 2; ++pb)
#pragma unroll
        for (int gi = 0; gi < 4; ++gi) gv[pb][gi] = *(const f32x4*)(gam + h * 64 + 32 * pb + 8 * gi + 4 * h2);
#pragma unroll
    for (int pb = 0; pb < 2; ++pb)
#pragma unroll
        for (int gi = 0; gi < 4; ++gi) pin(gv[pb][gi]);
#pragma unroll
    for (int lb = 0; lb < 2; ++lb) {
        const int l = 32 * lb + r; float tot = 0.f;
#pragma unroll
        for (int hh = 0; hh < 8; ++hh) tot += red[hh * 64 + l];
        const float rs = 1.0f / sqrtf(tot * (1.f / 512.f) + 1e-5f);
        if (l < Lv) {
#pragma unroll
            for (int pb = 0; pb < 2; ++pb)
#pragma unroll
                for (int gi = 0; gi < 4; ++gi) { const int p0 = 32 * pb + 8 * gi + 4 * h2; const f32x4 g4 = gv[pb][gi];
                    u32x2 w; w.x = pk2(y[pb][lb][4 * gi] * rs * g4[0], y[pb][lb][4 * gi + 1] * rs * g4[1]); w.y = pk2(y[pb][lb][4 * gi + 2] * rs * g4[2], y[pb][lb][4 * gi + 3] * rs * g4[3]);
                    *(u32x2*)(A2 + (size_t)(r0 + l) * 1024 + 512 + h * 64 + p0) = w; }
        }
    }
}

constexpr int L_TBL = 0;
constexpr int L_ARED = 8 * 260 * 4;
constexpr int L_AQ = 16384;
DI void attn_tile(KP P, LAS unsigned char* lds, int ch) {
    int tid = threadIdx.x; asm volatile("" : "+v"(tid));
    const int lane = tid & 63, hd = __builtin_amdgcn_readfirstlane(tid >> 6), r = lane & 31, h2 = lane >> 5;
    const bool samp = ch >= 512;
    int Lq, jt_lo, nkeys, ngr; long qrow0; const bf16_t* Kb; const bf16_t* Vb;
    if (!samp) { const int b = ch >> 7, c = ch & 127; qrow0 = (long)ch * 64; Lq = 64; jt_lo = (c < 8) ? 8 - c : 0; nkeys = 576; ngr = 36;
        Kb = (const bf16_t*)(P->ws + WS_KP) + ((long)b * 8192 + (long)(c - 8) * 64) * 512 + hd * 64;
        Vb = (const bf16_t*)(P->ws + WS_VFP) + ((long)(b * 8 + hd) * 512 + (long)(c - 8) * 4) * 1024; }
    else { const int b = ch - 512; qrow0 = (long)MP + b * 32; Lq = 32; jt_lo = 0; nkeys = 544; ngr = 34;
        Kb = (const bf16_t*)(P->ws + WS_KS) + (long)b * 544 * 512 + hd * 64;
        Vb = (const bf16_t*)(P->ws + WS_VFS) + (long)(b * 8 + hd) * 34 * 1024; }
    __syncthreads();
    LAS float* tbl = (LAS float*)(lds + L_TBL) + hd * 260;
    for (int i = lane; i < 257; i += 64) tbl[i] = P->in[8][hd * 257 + i] * LOG2E;
    __syncthreads();
    const bf16_t* Q = (const bf16_t*)(P->ws + WS_Q);
    LAS unsigned char* qlds = lds + L_AQ + hd * 8192 + lane * 16;
    { bf16x8 qtmp[2][4];
#pragma unroll
      for (int qb = 0; qb < 2; ++qb) { int qi = 32 * qb + r; if (qi > Lq - 1) qi = Lq - 1;
#pragma unroll
          for (int s = 0; s < 4; ++s) qtmp[qb][s] = *(const bf16x8*)(Q + (size_t)(qrow0 + qi) * 512 + hd * 64 + 16 * s + 8 * h2); }
#pragma unroll
      for (int qb = 0; qb < 2; ++qb)
#pragma unroll
          for (int s = 0; s < 4; ++s) pin(qtmp[qb][s]);
#pragma unroll
      for (int qb = 0; qb < 2; ++qb)
#pragma unroll
          for (int s = 0; s < 4; ++s) *(LAS bf16x8*)(qlds + (qb * 4 + s) * 1024) = qtmp[qb][s]; }
    f32x16 o[2][2];
#pragma unroll
    for (int a = 0; a < 2; ++a)
#pragma unroll
        for (int b = 0; b < 2; ++b)
#pragma unroll
            for (int i = 0; i < 16; ++i) o[a][b][i] = 0.f;
    float mrun[2] = {-1e30f, -1e30f}, lrun[2] = {0.f, 0.f};
    const float SC = 0.125f * LOG2E;
    for (int jt = jt_lo; jt < 9; ++jt) {
        bf16x8 kf[2][4];
#pragma unroll
        for (int kb = 0; kb < 2; ++kb) {
            int kj = 64 * jt + 32 * kb + r; if (kj > nkeys - 1) kj = nkeys - 1;
#pragma unroll
            for (int s = 0; s < 4; ++s) kf[kb][s] = *(const bf16x8*)(Kb + (long)kj * 512 + 16 * s + 8 * h2);
        }
#pragma unroll
        for (int kb = 0; kb < 2; ++kb)
#pragma unroll
            for (int s = 0; s < 4; ++s) pin(kf[kb][s]);
        f32x16 st[2][2];
#pragma unroll
        for (int kb = 0; kb < 2; ++kb)
#pragma unroll
            for (int qb = 0; qb < 2; ++qb) {
#pragma unroll
                for (int i = 0; i < 16; ++i) st[kb][qb][i] = 0.f;
#pragma unroll
                for (int s = 0; s < 4; ++s) st[kb][qb] = MFMA32(kf[kb][s], *(const LAS bf16x8*)(qlds + (qb * 4 + s) * 1024), st[kb][qb]);
            }
        __builtin_amdgcn_sched_barrier(0);
        bf16x8 vf[2][2][2];
#pragma unroll
        for (int kb = 0; kb < 2; ++kb)
#pragma unroll
            for (int s2 = 0; s2 < 2; ++s2) {
                int gidx = 4 * jt + 2 * kb + s2; if (gidx > ngr - 1) gidx = ngr - 1;
#pragma unroll
                for (int db = 0; db < 2; ++db) vf[kb][s2][db] = *(const bf16x8*)(Vb + (long)gidx * 1024 + (h2 * 64 + 32 * db + r) * 8);
            }
        __builtin_amdgcn_sched_barrier(0);
        const bool far = (jt <= 5);
        const bool tailmask = samp && (jt == 8);
        const float bfar = tbl[256];
#pragma unroll
        for (int qb = 0; qb < 2; ++qb) {
            const int qi = 32 * qb + r;
            float mx = -1e30f;
#pragma unroll
            for (int kb = 0; kb < 2; ++kb)
#pragma unroll
                for (int i = 0; i < 16; ++i) {
                    const int kj = 64 * jt + 32 * kb + crow(i, h2);
                    float bias = bfar;
                    if (!far) { int rel = 512 + qi - kj; rel = rel > 128 ? 128 : rel; rel = rel < -128 ? -128 : rel; bias = tbl[rel + 128]; }
                    float sc = st[kb][qb][i] * SC + bias;
                    if (tailmask && kj >= nkeys) sc = -1e30f;
                    st[kb][qb][i] = sc; mx = fmaxf(mx, sc);
                }
            mx = fmaxf(mx, __shfl_xor(mx, 32));
            const float mnew = fmaxf(mrun[qb], mx), alpha = __builtin_amdgcn_exp2f(mrun[qb] - mnew);
            float ls = 0.f;
#pragma unroll
            for (int kb = 0; kb < 2; ++kb)
#pragma unroll
                for (int i = 0; i < 16; ++i) { const float p = __builtin_amdgcn_exp2f(st[kb][qb][i] - mnew); st[kb][qb][i] = p; ls += p; }
            ls += __shfl_xor(ls, 32);
            lrun[qb] = lrun[qb] * alpha + ls; mrun[qb] = mnew;
            if (__builtin_amdgcn_ballot_w64(alpha != 1.0f) != 0ull) {
#pragma unroll
                for (int db = 0; db < 2; ++db)
#pragma unroll
                    for (int i = 0; i < 16; ++i) o[db][qb][i] *= alpha;
            }
        }
#pragma unroll
        for (int kb = 0; kb < 2; ++kb)
#pragma unroll
            for (int s2 = 0; s2 < 2; ++s2) {
                bf16x8 pf[2];
#pragma unroll
                for (int qb = 0; qb < 2; ++qb) pf[qb] = pack8(st[kb][qb][8 * s2], st[kb][qb][8 * s2 + 1], st[kb][qb][8 * s2 + 2], st[kb][qb][8 * s2 + 3],
                                                               st[kb][qb][8 * s2 + 4], st[kb][qb][8 * s2 + 5], st[kb][qb][8 * s2 + 6], st[kb][qb][8 * s2 + 7]);
#pragma unroll
                for (int db = 0; db < 2; ++db)
#pragma unroll
                    for (int qb = 0; qb < 2; ++qb) o[db][qb] = MFMA32(vf[kb][s2][db], pf[qb], o[db][qb]);
            }
    }
    LAS float* red = (LAS float*)(lds + L_ARED);
#pragma unroll
    for (int qb = 0; qb < 2; ++qb) {
        const float il = 1.0f / lrun[qb]; float ss = 0.f;
#pragma unroll
        for (int db = 0; db < 2; ++db)
#pragma unroll
            for (int i = 0; i < 16; ++i) { const float v = o[db][qb][i] * il; o[db][qb][i] = v; ss += v * v; }
        ss += __shfl_xor(ss, 32);
        if (h2 == 0) red[hd * 64 + 32 * qb + r] = ss;
    }
    __syncthreads();
    bf16_t* A2 = (bf16_t*)(P->ws + WS_A2); const float* gam = P->in[9];
    f32x4 gv[2][4];
#pragma unroll
    for (int db = 0; db < 2; ++db)
#pragma unroll
        for (int gi = 0; gi < 4; ++gi) gv[db][gi] = *(const f32x4*)(gam + hd * 64 + 32 * db + 8 * gi + 4 * h2);
#pragma unroll
    for (int db = 0; db < 2; ++db)
#pragma unroll
        for (int gi = 0; gi < 4; ++gi) pin(gv[db][gi]);
#pragma unroll
    for (int qb = 0; qb < 2; ++qb) {
        const int qi = 32 * qb + r; float tot = 0.f;
#pragma unroll
        for (int hh = 0; hh < 8; ++hh) tot += red[hh * 64 + qi];
        const float rs = 1.0f / sqrtf(tot * (1.f / 512.f) + 1e-5f);
        if (qi < Lq) {
#pragma unroll
            for (int db = 0; db < 2; ++db)
#pragma unroll
                for (int gi = 0; gi < 4; ++gi) { const int d0 = 32 * db + 8 * gi + 4 * h2; const f32x4 g4 = gv[db][gi];
                    u32x2 w; w.x = pk2(o[db][qb][4 * gi] * rs * g4[0], o[db][qb][4 * gi + 1] * rs * g4[1]); w.y = pk2(o[db][qb][4 * gi + 2] * rs * g4[2], o[db][qb][4 * gi + 3] * rs * g4[3]);
                    *(u32x2*)(A2 + (size_t)(qrow0 + qi) * 1024 + hd * 64 + d0) = w; }
        }
    }
}

__global__ void __launch_bounds__(NT, 2) hybrid_fwd(Params PA) {
    extern __shared__ __attribute__((aligned(16))) unsigned char lds_raw[];
    LAS unsigned char* lds = (LAS unsigned char*)lds_raw;
    cg::grid_group grid = cg::this_grid();
    const int G = gridDim.x, bx = blockIdx.x;
    int wid_s = __builtin_amdgcn_readfirstlane(threadIdx.x >> 6); asm volatile("" : "+s"(wid_s));
#define TIDX() ({ unsigned z_ = 0u; asm volatile("" : "+s"(z_)); (wid_s << 6) | (int)__builtin_amdgcn_mbcnt_hi(~0u, __builtin_amdgcn_mbcnt_lo(~0u, z_)); })
#define KARGS() ({ KP p_ = (KP)__builtin_amdgcn_kernarg_segment_ptr(); asm volatile("" : "+s"(p_)); p_; })
    if (PA.out == nullptr) grid.sync();
    {
        volatile LAS unsigned* stw = (volatile LAS unsigned*)(lds + LDS_BYTES - 16);
        if (threadIdx.x == 0) { stw[0] = 0u; stw[1] = 0u; }
        __syncthreads();
    }
    const XcdBarrier gbar = xcd_barrier_post((unsigned*)(PA.ws + WS_BAR), (volatile LAS unsigned*)(lds + LDS_BYTES - 16));
#define GRID_SYNC() xcd_barrier(gbar, TIDX())

#ifndef PHASE_MASK
#define PHASE_MASK 0xFFFF
#endif
#ifndef REPEAT_MASK
#define REPEAT_MASK 0
#endif
#define PH(k) if (KP P = KARGS()) if (PHASE_MASK & (1 << (k))) for (int rep_ = 0; rep_ <= ((REPEAT_MASK >> (k)) & 1); ++rep_)
#ifndef NREP_ALL
#define NREP_ALL 1
#endif
    for (int outer_ = 0; outer_ < NREP_ALL; ++outer_) {
    if (outer_) GRID_SYNC();
    PH(0) phase_convert(P, lds);
    GRID_SYNC();
    PH(1) {
        pg8::AMapPlain am{(const void*)(P->ws + WS_XB), 2048}; pg8::Order S; S.init(128, 12, G, bx);
        EpiInProj E{P->out, P->ws};
        pg8::gemm_phase<EpiInProj, pg8::AMapPlain>(lds, am, (const void*)(P->ws + WS_WIN), 2048, S, E);
        small_inproj(P);
    }
    GRID_SYNC();
    PH(4) {
        unsigned* qctr = (unsigned*)(P->ws + WS_BAR) + 3584 + 64 * (rep_ + 2 * outer_);
        volatile LAS unsigned* slot = (volatile LAS unsigned*)(lds + LDS_BYTES - 32);
        constexpr int Q0 = LATE_WG_ITEMS, Q1 = Q0 + 480, Q2 = Q1 + 512, Q3 = Q2 + 32, Q4 = Q3 + 16, Q5 = Q4 + 16, Q6 = Q5 + 16;
        for (;;) {
            __syncthreads();
            if (threadIdx.x == 0) slot[0] = __hip_atomic_fetch_add(qctr, 1u, __ATOMIC_RELAXED, __HIP_MEMORY_SCOPE_AGENT);
            __syncthreads();
            const int it = (int)slot[0];
            if (it >= Q6) break;
            if (it < Q0) convert_late_item(P, lds, it);
            else if (it < Q1) { const int j = it - Q0; attn_tile(P, lds, (j / 120) * 128 + 8 + j % 120); }
            else if (it < Q2) ssd_states_tile(P, lds, it - Q1);
            else if (it < Q3) { const int j = it - Q2; attn_tile(P, lds, (j & 3) * 128 + 7 - (j >> 2)); }
            else if (it < Q4) ssd_out_tile(P, lds, 512 + it - Q3);
            else if (it < Q5) attn_tile(P, lds, 512 + it - Q4);
            else ssd_states_tile(P, lds, 512 + it - Q5);
        }
    }
    GRID_SYNC();
    PH(3) phase_scan(P, lds);
    GRID_SYNC();
    PH(5) for (int ch = bx; ch < 512; ch += G) ssd_out_tile(P, lds, ch);
    PH(5) phase_sample_state(P);
    GRID_SYNC();
    PH(6) {
        __syncthreads();
        pg8::AMapPlain am{(const void*)(P->ws + WS_A2), 2048}; pg8::Order S; S.init(128, 4, G, bx);
        EpiOutProj E{P->in[0], P->in[1], (bf16_t*)(P->out + O_Y)};
        pg8::gemm_phase<EpiOutProj, pg8::AMapPlain>(lds, am, (const void*)(P->ws + WS_WOUT), 2048, S, E);
        small_out_splitk(P, lds, TIDX());
    }
    GRID_SYNC();
    PH(7) phase_ln<true>((const bf16_t*)(P->out + O_Y), P->in[17], P->in[18], (void*)(P->ws + WS_XB), P->ws + WS_X1F8, P->ws + WS_G, TIDX());
    GRID_SYNC();
    PH(8) {
        pg8::Order S; S.init(132, 21, G, bx);
        pg8::AMapUp<126> am{(const void*)(P->ws + WS_X1F8), 1024};
        EpiUp<false> E{P->ws + WS_G, nullptr, P->in[20], P->in[21], P->in[6], nullptr};
        pg8::gemm_phase<EpiUp<false>, pg8::AMapUp<126>, true>(lds, am, (const void*)(P->ws + WS_WUP8), 1024, S, E);
        pg8::Order S2; S2.init(2, 21, G, (bx + G - (2772 % G)) % G);
        pg8::AMapUp<128> am2{(const void*)(P->ws + WS_XB), 2048};
        EpiUp<true> E2{nullptr, (bf16_t*)(P->ws + WS_GS), P->in[20], P->in[21], P->in[6], P->out + O_FCS};
        pg8::gemm_phase<EpiUp<true>, pg8::AMapUp<128>>(lds, am2, (const void*)(P->ws + WS_WUP), 2048, S2, E2);
        small_ffnconv_prompt(P, lds, TIDX());
    }
    GRID_SYNC();
    PH(9) {
        pg8::AMapPlain am{(const void*)(P->ws + WS_G), DFF * 2}; pg8::Order S; S.init(128, 4, G, bx);
        EpiDown E{(const bf16_t*)(P->ws + WS_XB), (bf16_t*)(P->ws + WS_A2)};
        pg8::gemm_phase<EpiDown, pg8::AMapPlain>(lds, am, (const void*)(P->ws + WS_WDOWN), DFF * 2, S, E);
        small_down_splitk(P, lds, TIDX());
    }
    GRID_SYNC();
    PH(10) phase_ln<false>((const bf16_t*)(P->ws + WS_A2), P->in[23], P->in[24], (void*)(P->out + O_Y), nullptr, nullptr, TIDX());
    }
}

extern "C" void kernel_launch(void* const* d_in, const int* in_sizes, int n_in, void* d_out, int out_size, void* d_ws, size_t ws_size, hipStream_t stream) {
    static int grid_blocks = 0;
    if (!grid_blocks) {
        int dev = 0, cus = 0, per_cu = 0;
        hipGetDevice(&dev);
        hipDeviceGetAttribute(&cus, hipDeviceAttributeMultiprocessorCount, dev);
        hipFuncSetAttribute((const void*)hybrid_fwd, hipFuncAttributeMaxDynamicSharedMemorySize, LDS_BYTES);
        hipOccupancyMaxActiveBlocksPerMultiprocessor(&per_cu, (const void*)hybrid_fwd, NT, LDS_BYTES);
        if (per_cu < 1) per_cu = 1;
        if (per_cu > 1) per_cu = 1;
        grid_blocks = cus * per_cu;
        if (ws_size < WS_END) fprintf(stderr, "kernel_launch: workspace too small: %zu < %zu\n", ws_size, (size_t)WS_END);
    }
    Params p{};
    for (int i = 0; i < 25; ++i) p.in[i] = (const float*)d_in[i];
    p.out = (float*)d_out; p.ws = (unsigned char*)d_ws;
    hipMemsetAsync((unsigned char*)d_ws + WS_BAR, 0, 16384, stream);
    void* args[] = {&p};
    hipError_t e = hipLaunchCooperativeKernel((const void*)hybrid_fwd, dim3(grid_blocks), dim3(NT), args, LDS_BYTES, stream);
    if (e != hipSuccess) fprintf(stderr, "cooperative launch failed: %s (grid %d)\n", hipGetErrorString(e), grid_blocks);
}
```

```cpp
#include <hip/hip_runtime.h>
#include <hip/hip_cooperative_groups.h>
#include <cstdio>
namespace cg = cooperative_groups;

#define LAS __attribute__((address_space(3)))
typedef unsigned short bf16_t;
typedef short bf16x8 __attribute__((ext_vector_type(8)));
typedef short s16x4 __attribute__((ext_vector_type(4)));
typedef float f32x2 __attribute__((ext_vector_type(2)));
typedef float f32x4 __attribute__((ext_vector_type(4)));
typedef float f32x16 __attribute__((ext_vector_type(16)));
typedef unsigned u32x2 __attribute__((ext_vector_type(2)));
typedef unsigned u32x4 __attribute__((ext_vector_type(4)));
typedef __bf16 bf2_t __attribute__((ext_vector_type(2)));
typedef int i32x4 __attribute__((ext_vector_type(4)));
typedef int i32x8 __attribute__((ext_vector_type(8)));
#define DI __device__ __forceinline__

constexpr int MP = 32768, MS = 512, MT = MP + MS;
constexpr int DM = 1024, NIN = 3080, NINP = 3328, DFF = 2688, NUP = 5376;
constexpr int NCHUNK = 528;
constexpr float ALPHA = 1.189207115002721f;
constexpr float LOG2E = 1.4426950408889634f;
constexpr int NT = 512;
constexpr int LDS_BYTES = 147456;
constexpr int GP8 = 2816;
constexpr float SC_X1 = 16.f, SC_WUP = 64.f, SC_G = 8.f, SC_WDN = 128.f;

constexpr size_t O_Y = 0;
constexpr size_t O_NKP = (size_t)MT * 1024;
constexpr size_t O_NVP = O_NKP + 1048576;
constexpr size_t O_NKS = O_NVP + 1048576;
constexpr size_t O_NVS = O_NKS + 262144;
constexpr size_t O_SSP = O_NVS + 262144;
constexpr size_t O_SSS = O_SSP + 262144;
constexpr size_t O_SCP = O_SSS + 1048576;
constexpr size_t O_SCS = O_SCP + 12288;
constexpr size_t O_FCP = O_SCS + 49152;
constexpr size_t O_FCS = O_FCP + 43008;

constexpr size_t al256(size_t x) { return (x + 255) & ~(size_t)255; }
constexpr size_t WS_WIN = 0;
constexpr size_t WS_WOUT = WS_WIN + al256((size_t)NINP * 1024 * 2);
constexpr size_t WS_WUP = WS_WOUT + al256((size_t)1024 * 1024 * 2);
constexpr size_t WS_WDOWN = WS_WUP + al256((size_t)NUP * 1024 * 2);
constexpr size_t WS_WUP8 = WS_WDOWN + al256((size_t)1024 * DFF * 2);
constexpr size_t WS_WDN8 = WS_WUP8 + al256((size_t)NUP * 1024);
constexpr size_t WS_GS = WS_WDN8 + al256((size_t)1024 * GP8);
constexpr size_t WS_DT = WS_GS + al256((size_t)MS * DFF * 2);
constexpr size_t WS_DEC = WS_DT + al256((size_t)MT * 8 * 4);
constexpr size_t WS_BAR = WS_DEC + al256((size_t)NCHUNK * 8 * 4);
constexpr size_t WS_XB = WS_BAR + 16384 + 8192;
constexpr size_t WS_R3 = WS_XB + al256((size_t)(MT + 256) * 1024 * 2);
constexpr size_t WS_G = WS_R3;
constexpr size_t WS_X1F8 = WS_R3 + al256((size_t)MP * DFF * 2) + 8192;
constexpr size_t WS_Q = WS_R3;
constexpr size_t WS_KP = WS_Q + al256((size_t)MT * 512 * 2);
constexpr size_t WS_KS = WS_KP + al256((size_t)MP * 512 * 2);
constexpr size_t WS_VFP = WS_KS + al256((size_t)16 * 544 * 512 * 2);
constexpr size_t WS_VFS = WS_VFP + al256((size_t)4 * 8 * 512 * 1024 * 2);
constexpr size_t WS_Z = WS_VFS + al256((size_t)16 * 8 * 34 * 1024 * 2) + 65536;
constexpr size_t WS_XBC = WS_Z + al256((size_t)MT * 512 * 2);
constexpr size_t WS_A2 = WS_XBC + al256((size_t)MT * 1024 * 2);
constexpr size_t WS_ST = WS_A2 + al256((size_t)MT * 1024 * 2);
constexpr size_t WS_END = WS_ST + al256((size_t)NCHUNK * 65536 * 2);
static_assert(WS_X1F8 + (size_t)(MT + 256) * 1024 <= WS_A2, "G8/X1F8 alias");
static_assert(WS_A2 + (size_t)MT * 1024 * 4 <= WS_END, "U2 alias");

struct Params {
    const float* in[25];
    float* out;
    unsigned char* ws;
};
typedef const __attribute__((address_space(4))) Params* KP;

DI unsigned pk2(float lo, float hi) { f32x2 f = {lo, hi}; return __builtin_bit_cast(unsigned, __builtin_convertvector(f, bf2_t)); }
DI unsigned pk4_f8(float a, float b, float c, float d) { int w = 0; w = __builtin_amdgcn_cvt_pk_fp8_f32(a, b, w, false); w = __builtin_amdgcn_cvt_pk_fp8_f32(c, d, w, true); return (unsigned)w; }
DI float bf_lo(unsigned w) { return __uint_as_float(w << 16); }
DI float bf_hi(unsigned w) { return __uint_as_float(w & 0xffff0000u); }
DI float silu_f(float x) { return x * __builtin_amdgcn_rcpf(1.0f + __builtin_amdgcn_exp2f(-x * LOG2E)); }
DI int crow(int reg, int h) { return (reg & 3) + 8 * (reg >> 2) + 4 * h; }
#define MFMA32(a, b, c) __builtin_amdgcn_mfma_f32_32x32x16_bf16((a), (b), (c), 0, 0, 0)
DI bf16x8 pack8(float a0, float a1, float a2, float a3, float a4, float a5, float a6, float a7) {
    u32x4 p; p.x = pk2(a0, a1); p.y = pk2(a2, a3); p.z = pk2(a4, a5); p.w = pk2(a6, a7); return __builtin_bit_cast(bf16x8, p);
}
DI void pin(bf16x8& v) { asm volatile("" : "+v"(v)); }
DI void pin(u32x2& v) { asm volatile("" : "+v"(v)); }
DI void pin(f32x4& v) { asm volatile("" : "+v"(v)); }
DI bf16x8 tr_frag(LAS unsigned char* lo, LAS unsigned char* hi) {
    s16x4 a = __builtin_amdgcn_ds_read_tr16_b64_v4i16((LAS s16x4*)lo);
    s16x4 b = __builtin_amdgcn_ds_read_tr16_b64_v4i16((LAS s16x4*)hi);
    return __builtin_shufflevector(a, b, 0, 1, 2, 3, 4, 5, 6, 7);
}


#define XB_TMO      128
#define XB_XCNT(j)  (256  + 64 * (j))
#define XB_XSUB(j)  (1280 + 64 * (j))
#define XB_XGEN(j)  (2304 + 64 * (j))
#define XB_TOP      3328
#define XB_TOPGEN   3392
#define XCD_BAR_WORDS 3456
#define XB_SPIN_CAP (1u << 20)
DI unsigned xb_ld(unsigned* p)              { return __hip_atomic_load(p, __ATOMIC_RELAXED, __HIP_MEMORY_SCOPE_AGENT); }
DI unsigned xb_add(unsigned* p, unsigned v) { return __hip_atomic_fetch_add(p, v, __ATOMIC_RELAXED, __HIP_MEMORY_SCOPE_AGENT); }
DI unsigned xb_xcc_id() { return (unsigned)__builtin_amdgcn_s_getreg((3 << 11) | 20) & 0xFu; }
#define XB_SPIN(cond, bar) do { unsigned _sp = 0; while (cond) { __builtin_amdgcn_s_sleep(1); \
    if ((++_sp & 255u) == 0u) { if (xb_ld(&(bar)[XB_TMO])) break; if (_sp > XB_SPIN_CAP) { atomicAdd(&(bar)[XB_TMO], 1u); break; } } } } while (0)
struct XcdBarrier { unsigned* bar; unsigned x; volatile LAS unsigned* st; };
DI XcdBarrier xcd_barrier_post(unsigned* bar, volatile LAS unsigned* st) {
    XcdBarrier b; b.bar = bar; b.x = xb_xcc_id(); b.st = st;
    if (threadIdx.x == 0) (void)xb_add(&bar[XB_XCNT(b.x)], 1u);
    return b;
}
DI void xcd_barrier_complete(unsigned* bar, unsigned x, unsigned& nloc, unsigned& nx) {
    const unsigned G = gridDim.x * gridDim.y * gridDim.z;
    unsigned sum, cnt, mine, sp = 0u;
    for (;;) {
        sum = 0u; cnt = 0u; mine = 0u;
#pragma unroll
        for (unsigned j = 0; j < 16; ++j) { const unsigned c = xb_ld(&bar[XB_XCNT(j)]); sum += c; cnt += (c > 0u) ? 1u : 0u; mine = (j == x) ? c : mine; }
        if (sum == G) break;
        __builtin_amdgcn_s_sleep(1);
        if ((++sp & 255u) == 0u) { if (xb_ld(&bar[XB_TMO])) break; if (sp > XB_SPIN_CAP) { atomicAdd(&bar[XB_TMO], 1u); break; } }
    }
    nloc = mine > 0u ? mine : 1u; nx = cnt > 0u ? cnt : 1u;
}
DI void xcd_barrier(const XcdBarrier& b, int tid_in) {
    asm volatile("s_waitcnt vmcnt(0)" ::: "memory");
    __syncthreads();
    if (tid_in == 0) {
        unsigned* bar = b.bar;
        __builtin_amdgcn_s_waitcnt(0);
        unsigned nloc = b.st[0], nx = b.st[1];
        if (nloc == 0u) { xcd_barrier_complete(bar, b.x, nloc, nx); b.st[0] = nloc; b.st[1] = nx; }
        const unsigned old = xb_add(&bar[XB_XSUB(b.x)], 1u);
        const unsigned gen = old / nloc;
        if (old + 1u == (gen + 1u) * nloc) {
            __builtin_amdgcn_fence(__ATOMIC_RELEASE, "agent");
            asm volatile("s_waitcnt vmcnt(0)" ::: "memory");
            const unsigned og = xb_add(&bar[XB_TOP], 1u);
            const unsigned tg = og / nx;
            if (og + 1u == (tg + 1u) * nx) xb_add(&bar[XB_TOPGEN], 1u);
            else XB_SPIN(xb_ld(&bar[XB_TOPGEN]) == tg, bar);
            __builtin_amdgcn_fence(__ATOMIC_ACQUIRE, "agent");
            xb_add(&bar[XB_XGEN(b.x)], 1u);
            asm volatile("s_waitcnt vmcnt(0)" ::: "memory");
        } else {
            XB_SPIN(xb_ld(&bar[XB_XGEN(b.x)]) == gen, bar);
            __builtin_amdgcn_fence(__ATOMIC_ACQUIRE, "agent");
            asm volatile("s_waitcnt vmcnt(0)" ::: "memory");
        }
    }
    __syncthreads();
}

namespace pg8 {
constexpr int BM = 256, BK = 64, HALF = 128, HTB = HALF * BK * 2, NXCD = 8, WGM = 8;
DI int lds_byte(int r, int c) { const int st = (r >> 4) * 2 + (c >> 5), rr = r & 15, cc = c & 31, ob = rr * 64 + cc * 2; return st * 1024 + (ob ^ (((ob >> 9) & 1) << 5)); }
DI void stage_rc(int b, int& R, int& C) { const int st = b / 1024, sb = b % 1024, swz = sb ^ (((sb >> 9) & 1) << 5); R = (st >> 1) * 16 + swz / 64; C = (st & 1) * 32 + (swz % 64) / 2; }
DI int perm32(int rho) { const int n = rho >> 4, i = rho & 15; return 8 * (i >> 2) + 4 * n + (i & 3); }
struct Unit { int pm, pn; };
struct Order {
    int nM, nN, nwg, G, c;
    DI void init(int nM_, int nN_, int G_, int c_) { nM = nM_; nN = nN_; nwg = nM * nN; G = G_; c = c_; }
    DI bool next(int i, Unit& u) const {
        const long L = (long)i * G + c; if (L >= nwg) return false;
        int wgid = (int)L; { const int q = nwg / NXCD, r = nwg % NXCD, xcd = wgid % NXCD, off = wgid / NXCD; wgid = (xcd < r ? xcd * (q + 1) : r * (q + 1) + (xcd - r) * q) + off; }
        const int nig = WGM * nN, gid = wgid / nig, fm = gid * WGM, gsz = (nM - fm) < WGM ? (nM - fm) : WGM;
        u.pm = fm + ((wgid % nig) % gsz); u.pn = (wgid % nig) / gsz; return true;
    }
};
struct AMapPlain {
    const void* A; int pitch;
    DI const char* unit_base(int pm) const { return (const char*)A + (size_t)pm * 256 * pitch; }
    DI size_t hstep() const { return (size_t)HALF * pitch; }
    DI unsigned voff(int R, int Cb) const { return (unsigned)(R * pitch + Cb); }
};
template <int WRS> struct AMapUp {
    const void* A; int pitch;
    DI const char* unit_base(int pm) const {
        if (WRS == 126) { const int b = pm / 33, ti = pm - b * 33; return (const char*)A + ((long)b * 8192 + ti * 252 - 2) * pitch; }
        return (const char*)A + ((long)MP + pm * 256) * pitch;
    }
    DI size_t hstep() const { return (size_t)4 * pitch; }
    DI unsigned voff(int R, int Cb) const { return (unsigned)((((R >> 6) * WRS + (R & 15) * 8 + ((R >> 4) & 3)) * pitch) + Cb); }
};

template <class Epi, class AMap, bool F8 = false>
DI void gemm_phase(LAS unsigned char* lds, const AMap am, const void* Bt, const int Kb, const Order& S, const Epi& E) {
    int tid = threadIdx.x; asm volatile("" : "+v"(tid));
    const int wid = __builtin_amdgcn_readfirstlane(tid >> 6), lane = tid & 63, wr = wid >> 2, wc = wid & 3, fr = lane & 15, fq = lane >> 4;
    const int nt = Kb / 128;
    unsigned voffA, voffB; size_t dA2, dB2;
    { int R, C; stage_rc(tid * 16, R, C); const int Rb = Epi::PERM ? ((R & ~31) + perm32(R & 31)) : R;
      voffA = am.voff(R, 2 * C); voffB = (unsigned)(Rb * Kb + 2 * C); dA2 = (size_t)(am.voff(64, 0) - am.voff(0, 0)); dB2 = (size_t)64 * Kb; }
    const size_t kstep = (size_t)128;
    const size_t hstepA = am.hstep();
    const size_t hstepB = (size_t)HALF * Kb;
    const size_t tstepB = 2 * hstepB;
    const unsigned ldsw = (unsigned)wid * 1024u;
    constexpr int QOFF = F8 ? 16 : 1024;
    const int aoff = F8 ? lds_byte(wr * 64 + fr, 16 * (fq & 1)) + 1024 * (fq >> 1) : lds_byte(wr * 64 + fr, fq * 8);
    const int boff = F8 ? lds_byte(wc * 32 + fr, 16 * (fq & 1)) + 1024 * (fq >> 1) : lds_byte(wc * 32 + fr, fq * 8);
#define PG8_SA(b, h) (((b) * 2 + (h)) * HTB)
#define PG8_SB(b, h) ((4 + (b) * 2 + (h)) * HTB)
#define PG8_STAGE(bufoff, gbase, voff) do { \
        __builtin_amdgcn_global_load_lds((const unsigned*)((const char*)(gbase) + (voff)), (LAS unsigned*)(lds + (bufoff) + ldsw), 16, 0, 0); \
        __builtin_amdgcn_global_load_lds((const unsigned*)((const char*)(gbase) + d2_##voff + (voff)), (LAS unsigned*)(lds + (bufoff) + ldsw + 8192), 16, 0, 0); } while (0)
#define d2_voffA dA2
#define d2_voffB dB2
#define PG8_LDA(dst, b, h) do { _Pragma("unroll") for (int m = 0; m < 4; ++m) { const i32x4 lo_ = *(const LAS i32x4*)(lds + PG8_SA(b, h) + aoff + m * 2048), hi_ = *(const LAS i32x4*)(lds + PG8_SA(b, h) + aoff + QOFF + m * 2048); \
        dst[m] = __builtin_shufflevector(lo_, hi_, 0, 1, 2, 3, 4, 5, 6, 7); } } while (0)
#define PG8_LDB(dst, b, h) do { _Pragma("unroll") for (int n = 0; n < 2; ++n) { const i32x4 lo_ = *(const LAS i32x4*)(lds + PG8_SB(b, h) + boff + n * 2048), hi_ = *(const LAS i32x4*)(lds + PG8_SB(b, h) + boff + QOFF + n * 2048); \
        dst[n] = __builtin_shufflevector(lo_, hi_, 0, 1, 2, 3, 4, 5, 6, 7); } } while (0)
#define PG8_HALF(v, k) __builtin_bit_cast(bf16x8, __builtin_shufflevector(v, v, 4 * (k), 4 * (k) + 1, 4 * (k) + 2, 4 * (k) + 3))
#define PG8_MMA(ai, bj, At, Bt_) do { __builtin_amdgcn_s_setprio(1); _Pragma("unroll") for (int m = 0; m < 4; ++m) _Pragma("unroll") for (int n = 0; n < 2; ++n) { \
        if (F8) acc[ai][bj][m][n] = __builtin_amdgcn_mfma_scale_f32_16x16x128_f8f6f4(Bt_[n], At[m], acc[ai][bj][m][n], 0, 0, 0, 0, 0, 0); \
        else { acc[ai][bj][m][n] = __builtin_amdgcn_mfma_f32_16x16x32_bf16(PG8_HALF(Bt_[n], 0), PG8_HALF(At[m], 0), acc[ai][bj][m][n], 0, 0, 0); \
               acc[ai][bj][m][n] = __builtin_amdgcn_mfma_f32_16x16x32_bf16(PG8_HALF(Bt_[n], 1), PG8_HALF(At[m], 1), acc[ai][bj][m][n], 0, 0, 0); } } \
        __builtin_amdgcn_s_setprio(0); } while (0)
#define PG8_WAIT_V(n) asm volatile("s_waitcnt vmcnt(" #n ")" ::: "memory")
#define PG8_WAIT_L(n) asm volatile("s_waitcnt lgkmcnt(" #n ")" ::: "memory")
#define PG8_BAR __builtin_amdgcn_s_barrier()
#define PG8_SCHED __builtin_amdgcn_sched_barrier(0)
    Unit cur, nxt; int ui = 0;
    if (!S.next(0, cur)) return;
    f32x4 acc[2][2][4][2];
#pragma unroll
    for (int a = 0; a < 2; ++a)
#pragma unroll
        for (int b = 0; b < 2; ++b)
#pragma unroll
            for (int m = 0; m < 4; ++m)
#pragma unroll
                for (int n = 0; n < 2; ++n) acc[a][b][m][n] = (f32x4){0.f, 0.f, 0.f, 0.f};
    i32x8 At[4], B0[2], B1[2];
    const char* cA = am.unit_base(cur.pm); const char* cB = (const char*)Bt + (size_t)cur.pn * tstepB;
    PG8_STAGE(PG8_SB(0, 0), cB, voffB); PG8_STAGE(PG8_SA(0, 0), cA, voffA); PG8_STAGE(PG8_SB(0, 1), cB + hstepB, voffB); PG8_STAGE(PG8_SA(0, 1), cA + hstepA, voffA);
    if (wr == 1) PG8_BAR;
    PG8_WAIT_V(4); PG8_BAR;
    PG8_STAGE(PG8_SB(1, 0), cB + kstep, voffB); PG8_STAGE(PG8_SA(1, 0), cA + kstep, voffA); PG8_STAGE(PG8_SB(1, 1), cB + hstepB + kstep, voffB);
    PG8_WAIT_V(6); PG8_BAR;
    for (;;) {
        const bool has_next = S.next(ui + 1, nxt);
        const char* nA = has_next ? am.unit_base(nxt.pm) : cA; const char* nB = has_next ? (const char*)Bt + (size_t)nxt.pn * tstepB : cB;
        for (int t = 0; t < nt; t += 2) {
            const bool last = (t == nt - 2);
            const char* a1 = cA + (size_t)(t + 1) * kstep;
            const char* a2 = last ? nA : cA + (size_t)(t + 2) * kstep; const char* b2 = last ? nB : cB + (size_t)(t + 2) * kstep;
            const char* a3 = a2 + kstep; const char* b3 = b2 + kstep;
            PG8_LDB(B0, 0, 0); PG8_SCHED; PG8_LDA(At, 0, 0); PG8_STAGE(PG8_SA(1, 1), a1 + hstepA, voffA);
            PG8_WAIT_L(8); PG8_BAR; PG8_WAIT_L(0); PG8_MMA(0, 0, At, B0); PG8_BAR; PG8_SCHED;
            PG8_LDB(B1, 0, 1); PG8_STAGE(PG8_SB(0, 0), b2, voffB);
            PG8_BAR; PG8_WAIT_L(0); PG8_MMA(0, 1, At, B1); PG8_BAR;
            PG8_LDA(At, 0, 1); PG8_STAGE(PG8_SA(0, 0), a2, voffA);
            PG8_BAR; PG8_WAIT_L(0); PG8_MMA(1, 0, At, B0); PG8_BAR; PG8_SCHED;
            PG8_STAGE(PG8_SB(0, 1), b2 + hstepB, voffB);
            PG8_WAIT_V(6); PG8_BAR; PG8_MMA(1, 1, At, B1); PG8_BAR;
            PG8_LDB(B0, 1, 0); PG8_SCHED; PG8_LDA(At, 1, 0); PG8_STAGE(PG8_SA(0, 1), a2 + hstepA, voffA);
            PG8_WAIT_L(8); PG8_BAR; PG8_WAIT_L(0); PG8_MMA(0, 0, At, B0); PG8_BAR; PG8_SCHED;
            PG8_LDB(B1, 1, 1); PG8_STAGE(PG8_SB(1, 0), b3, voffB);
            PG8_BAR; PG8_WAIT_L(0); PG8_MMA(0, 1, At, B1); PG8_BAR;
            PG8_LDA(At, 1, 1); PG8_STAGE(PG8_SA(1, 0), a3, voffA);
            PG8_BAR; PG8_WAIT_L(0); PG8_MMA(1, 0, At, B0); PG8_BAR; PG8_SCHED;
            PG8_STAGE(PG8_SB(1, 1), b3 + hstepB, voffB);
            PG8_WAIT_V(6); PG8_BAR; PG8_MMA(1, 1, At, B1); PG8_BAR;
        }
        { unsigned z_ = 0u; asm volatile("" : "+s"(z_)); int l2_ = (int)__builtin_amdgcn_mbcnt_hi(~0u, __builtin_amdgcn_mbcnt_lo(~0u, z_)); asm volatile("" : "+v"(l2_));
          E(acc, cur, wr, wc, l2_ & 15, l2_ >> 4); }
        if (!has_next) break;
#pragma unroll
        for (int a = 0; a < 2; ++a)
#pragma unroll
            for (int b = 0; b < 2; ++b)
#pragma unroll
                for (int m = 0; m < 4; ++m)
#pragma unroll
                    for (int n = 0; n < 2; ++n) acc[a][b][m][n] = (f32x4){0.f, 0.f, 0.f, 0.f};
        cur = nxt; cA = nA; cB = nB; ++ui;
    }
    PG8_WAIT_V(0);
    if (wr == 0) PG8_BAR;
    PG8_BAR;
#undef PG8_SA
#undef PG8_SB
#undef PG8_STAGE
#undef d2_voffA
#undef d2_voffB
#undef PG8_LDA
#undef PG8_LDB
#undef PG8_HALF
#undef PG8_MMA
#undef PG8_WAIT_V
#undef PG8_WAIT_L
#undef PG8_BAR
#undef PG8_SCHED
}
}

typedef f32x4 AccT[2][2][4][2];

struct EpiInProj {
    static constexpr bool PERM = true;
    float* out; unsigned char* ws;
    DI void operator()(const AccT& acc, const pg8::Unit& u, int wr, int wc, int fr, int fq) const {
        const int pn = u.pn, r0 = u.pm * 256 + wr * 64 + fr, ct = wc * 32 + 8 * fq;
        const bool samp = u.pm >= 128;
        if (pn == 12) {
            if (wc == 0 && fq == 0) {
                float* DT = (float*)(ws + WS_DT);
#pragma unroll
                for (int ai = 0; ai < 2; ++ai)
#pragma unroll
                    for (int m = 0; m < 4; ++m) { const int row = r0 + ai * 128 + m * 16;
                        *(f32x4*)(DT + (size_t)row * 8) = acc[ai][0][m][0]; *(f32x4*)(DT + (size_t)row * 8 + 4) = acc[ai][0][m][1]; }
            }
            return;
        }
#pragma unroll
        for (int ai = 0; ai < 2; ++ai)
#pragma unroll
            for (int m = 0; m < 4; ++m) {
                const int row = r0 + ai * 128 + m * 16;
                const int rs = row - MP, sb = rs >> 5, st = rs & 31;
                const int pb = row >> 13, pt = row & 8191;
#pragma unroll
                for (int bj = 0; bj < 2; ++bj) {
                    const f32x4 v0 = acc[ai][bj][m][0], v1 = acc[ai][bj][m][1];
                    u32x4 w; w.x = pk2(v0[0], v0[1]); w.y = pk2(v0[2], v0[3]); w.z = pk2(v1[0], v1[1]); w.w = pk2(v1[2], v1[3]);
                    const int ctile = bj * 128 + ct;
                    if (pn < 2) {
                        *(u32x4*)((bf16_t*)(ws + WS_Q) + (size_t)row * 512 + pn * 256 + ctile) = w;
                    } else if (pn < 4) {
                        const int col = (pn - 2) * 256 + ctile;
                        if (!samp) {
                            *(u32x4*)((bf16_t*)(ws + WS_KP) + (size_t)row * 512 + col) = w;
                            if (pt >= 7680) { float* o = out + O_NKP + ((size_t)(pb * 512 + pt - 7680)) * 512 + col; *(f32x4*)o = v0; *(f32x4*)(o + 4) = v1; }
                        } else {
                            *(u32x4*)((bf16_t*)(ws + WS_KS) + ((size_t)sb * 544 + 512 + st) * 512 + col) = w;
                            float* o = out + O_NKS + (size_t)rs * 512 + col; *(f32x4*)o = v0; *(f32x4*)(o + 4) = v1;
                        }
                    } else if (pn < 6) {
                        const int col = (pn - 4) * 256 + ctile, head = col >> 6, d0 = col & 63;
                        bf16_t* vb; int t;
                        if (!samp) { t = pt; vb = (bf16_t*)(ws + WS_VFP) + ((size_t)(pb * 8 + head) * 512 + (t >> 4)) * 1024;
                            if (pt >= 7680) { float* o = out + O_NVP + ((size_t)(pb * 512 + pt - 7680)) * 512 + col; *(f32x4*)o = v0; *(f32x4*)(o + 4) = v1; } }
                        else { t = 512 + st; vb = (bf16_t*)(ws + WS_VFS) + ((size_t)(sb * 8 + head) * 34 + (t >> 4)) * 1024;
                            float* o = out + O_NVS + (size_t)rs * 512 + col; *(f32x4*)o = v0; *(f32x4*)(o + 4) = v1; }
                        const int tt = t & 15, hh = (tt >> 2) & 1, jj = ((tt >> 3) << 2) | (tt & 3);
                        bf16_t* p = vb + (hh * 64 + d0) * 8 + jj;
                        p[0] = (bf16_t)(w.x & 0xffff); p[8] = (bf16_t)(w.x >> 16); p[16] = (bf16_t)(w.y & 0xffff); p[24] = (bf16_t)(w.y >> 16);
                        p[32] = (bf16_t)(w.z & 0xffff); p[40] = (bf16_t)(w.z >> 16); p[48] = (bf16_t)(w.w & 0xffff); p[56] = (bf16_t)(w.w >> 16);
                    } else if (pn < 8) {
                        *(u32x4*)((bf16_t*)(ws + WS_Z) + (size_t)row * 512 + (pn - 6) * 256 + ctile) = w;
                    } else {
                        const int col = (pn - 8) * 256 + ctile;
                        *(u32x4*)((bf16_t*)(ws + WS_XBC) + (size_t)row * 1024 + col) = w;
                        if (!samp) { if (pt >= 8189) { float* o = out + O_SCP + ((size_t)(pb * 3 + pt - 8189)) * 1024 + col; *(f32x4*)o = v0; *(f32x4*)(o + 4) = v1; } }
                        else { if (st >= 29) { float* o = out + O_SCS + ((size_t)(sb * 3 + st - 29)) * 1024 + col; *(f32x4*)o = v0; *(f32x4*)(o + 4) = v1; } }
                    }
                }
            }
    }
};

struct EpiOutProj {
    static constexpr bool PERM = false;
    const float* xp; const float* xs; bf16_t* U;
    DI void operator()(const AccT& acc, const pg8::Unit& u, int wr, int wc, int fr, int fq) const {
        const int r0 = u.pm * 256 + wr * 64 + fr, c0 = u.pn * 256 + wc * 32 + 4 * fq;
#pragma unroll
        for (int ai = 0; ai < 2; ++ai) {
            f32x4 xv[4][2][2];
#pragma unroll
            for (int m = 0; m < 4; ++m) { const int row = r0 + ai * 128 + m * 16; const float* xr = (row < MP) ? xp + (size_t)row * 1024 : xs + (size_t)(row - MP) * 1024;
#pragma unroll
                for (int bj = 0; bj < 2; ++bj)
#pragma unroll
                    for (int n = 0; n < 2; ++n) xv[m][bj][n] = __builtin_nontemporal_load((const f32x4*)(xr + c0 + bj * 128 + n * 16)); }
#pragma unroll
            for (int m = 0; m < 4; ++m)
#pragma unroll
                for (int bj = 0; bj < 2; ++bj)
#pragma unroll
                    for (int n = 0; n < 2; ++n) pin(xv[m][bj][n]);
#pragma unroll
            for (int m = 0; m < 4; ++m) { const int row = r0 + ai * 128 + m * 16; bf16_t* ur = U + (size_t)row * 1024;
#pragma unroll
                for (int bj = 0; bj < 2; ++bj)
#pragma unroll
                    for (int n = 0; n < 2; ++n) { const f32x4 o = xv[m][bj][n] * ALPHA + acc[ai][bj][m][n];
                        u32x2 w; w.x = pk2(o[0], o[1]); w.y = pk2(o[2], o[3]); *(u32x2*)(ur + c0 + bj * 128 + n * 16) = w; } }
        }
    }
};
struct EpiDown {
    static constexpr bool PERM = false;
    const bf16_t* X1; bf16_t* U;
    DI void operator()(const AccT& acc, const pg8::Unit& u, int wr, int wc, int fr, int fq) const {
        const int r0 = u.pm * 256 + wr * 64 + fr, c0 = u.pn * 256 + wc * 32 + 4 * fq;
        u32x2 xw[2][4][2][2];
#pragma unroll
        for (int ai = 0; ai < 2; ++ai)
#pragma unroll
            for (int m = 0; m < 4; ++m) { const bf16_t* xr = X1 + (size_t)(r0 + ai * 128 + m * 16) * 1024;
#pragma unroll
                for (int bj = 0; bj < 2; ++bj)
#pragma unroll
                    for (int n = 0; n < 2; ++n) xw[ai][m][bj][n] = *(const u32x2*)(xr + c0 + bj * 128 + n * 16); }
#pragma unroll
        for (int ai = 0; ai < 2; ++ai)
#pragma unroll
            for (int m = 0; m < 4; ++m)
#pragma unroll
                for (int bj = 0; bj < 2; ++bj)
#pragma unroll
                    for (int n = 0; n < 2; ++n) pin(xw[ai][m][bj][n]);
#pragma unroll
        for (int ai = 0; ai < 2; ++ai)
#pragma unroll
            for (int m = 0; m < 4; ++m) { bf16_t* ur = U + (size_t)(r0 + ai * 128 + m * 16) * 1024;
#pragma unroll
                for (int bj = 0; bj < 2; ++bj)
#pragma unroll
                    for (int n = 0; n < 2; ++n) { const u32x2 w = xw[ai][m][bj][n];
                        const f32x4 xv = {bf_lo(w.x), bf_hi(w.x), bf_lo(w.y), bf_hi(w.y)}; const f32x4 o = xv * ALPHA + acc[ai][bj][m][n];
                        u32x2 wo; wo.x = pk2(o[0], o[1]); wo.y = pk2(o[2], o[3]); *(u32x2*)(ur + c0 + bj * 128 + n * 16) = wo; } }
    }
};

DI float dpp_shr1(float v) { return __builtin_bit_cast(float, __builtin_amdgcn_update_dpp(0, __builtin_bit_cast(int, v), 0x111, 0xf, 0xf, false)); }
template <bool SAMP> struct EpiUp {
    static constexpr bool PERM = true;
    unsigned char* G8; bf16_t* GS; const float* cw; const float* cb; const float* past; float* onf;
    DI void operator()(const AccT& acc, const pg8::Unit& u, int wr, int wc, int fr, int fq) const {
        const int colv = u.pn * 128 + wc * 32 + 8 * fq;
        int bb, tb; long grow0;
        if (!SAMP) { bb = u.pm / 33; const int ti = u.pm - bb * 33; tb = ti * 252 + wr * 126 + fr * 8 - 2; grow0 = (long)bb * 8192 + tb; }
        else { const int lg = wr * 16 + fr; bb = u.pm * 8 + (lg >> 2); tb = (lg & 3) * 8; grow0 = (long)bb * 32 + tb; }
        const bool first = SAMP ? ((fr & 3) == 0) : (fr == 0);
        const float asc = SAMP ? 1.0f : 1.0f / (SC_X1 * SC_WUP);
#pragma unroll
        for (int n = 0; n < 2; ++n) {
            const int cv = colv + 4 * n, cgt = DFF + cv;
            const f32x4 wv0 = *(const f32x4*)(cw + cv), wv1 = *(const f32x4*)(cw + NUP + cv), wv2 = *(const f32x4*)(cw + 2 * NUP + cv), bv = *(const f32x4*)(cb + cv);
            const f32x4 wg0 = *(const f32x4*)(cw + cgt), wg1 = *(const f32x4*)(cw + NUP + cgt), wg2 = *(const f32x4*)(cw + 2 * NUP + cgt), bg = *(const f32x4*)(cb + cgt);
            f32x4 hv[8], hg[8];
#pragma unroll
            for (int tau = 0; tau < 8; ++tau) { hv[tau] = acc[tau >> 2][0][tau & 3][n] * asc; hg[tau] = acc[tau >> 2][1][tau & 3][n] * asc; }
            if (SAMP) {
                if ((fr & 3) == 3) { float* o = onf + ((size_t)(bb * 2)) * NUP; *(f32x4*)(o + cv) = hv[6]; *(f32x4*)(o + cgt) = hg[6]; *(f32x4*)(o + NUP + cv) = hv[7]; *(f32x4*)(o + NUP + cgt) = hg[7]; }
            }
            if (!SAMP) { if (tb < 0) { hv[0] = (f32x4){0.f, 0.f, 0.f, 0.f}; hv[1] = hv[0]; hg[0] = hv[0]; hg[1] = hv[0]; } }
            f32x4 pv2, pv1, pg2, pg1;
#pragma unroll
            for (int j = 0; j < 4; ++j) { pv2[j] = dpp_shr1(hv[6][j]); pv1[j] = dpp_shr1(hv[7][j]); pg2[j] = dpp_shr1(hg[6][j]); pg1[j] = dpp_shr1(hg[7][j]); }
            if (SAMP) { if (first) { const float* ps = past + (size_t)bb * 2 * NUP; pv2 = *(const f32x4*)(ps + cv); pv1 = *(const f32x4*)(ps + NUP + cv); pg2 = *(const f32x4*)(ps + cgt); pg1 = *(const f32x4*)(ps + NUP + cgt); } }
#pragma unroll
            for (int tau = 0; tau < 8; ++tau) {
                const f32x4 a2v = (tau >= 2) ? hv[tau >= 2 ? tau - 2 : 0] : (tau == 0 ? pv2 : pv1);
                const f32x4 a1v = (tau >= 1) ? hv[tau >= 1 ? tau - 1 : 0] : pv1;
                const f32x4 a2g = (tau >= 2) ? hg[tau >= 2 ? tau - 2 : 0] : (tau == 0 ? pg2 : pg1);
                const f32x4 a1g = (tau >= 1) ? hg[tau >= 1 ? tau - 1 : 0] : pg1;
                const f32x4 ov = bv + wv0 * a2v + wv1 * a1v + wv2 * hv[tau];
                const f32x4 og = bg + wg0 * a2g + wg1 * a1g + wg2 * hg[tau];
                const float g0 = ov[0] * silu_f(og[0]), g1 = ov[1] * silu_f(og[1]), g2 = ov[2] * silu_f(og[2]), g3 = ov[3] * silu_f(og[3]);
                if (!SAMP) { const int t = tb + tau; const bool ok = (t >= 0) && (t < 8192) && (fr > 0 || tau >= 2);
                    const unsigned off = ok ? (unsigned)(((int)grow0 + tau) * DFF + cv) * 2u : (unsigned)((size_t)MP * DFF * 2) + (unsigned)(fr + 16 * fq) * 8u;
                    u32x2 w; w.x = pk2(g0, g1); w.y = pk2(g2, g3); *(u32x2*)(G8 + off) = w; }
                else { u32x2 w; w.x = pk2(g0, g1); w.y = pk2(g2, g3); *(u32x2*)(GS + (size_t)(grow0 + tau) * DFF + cv) = w; }
            }
        }
    }
};

DI f32x16 small_block_p(const bf16_t* xp, const bf16_t* wp, int K);
DI f32x16 small_block(const bf16_t* X, const bf16_t* Wt, int K, int row0, int col0, int lane) {
    const int r = lane & 31, h2 = lane >> 5;
    return small_block_p(X + (size_t)(row0 + r) * K + 8 * h2, Wt + (size_t)(col0 + r) * K + 8 * h2, K);
}
DI f32x16 small_block_p(const bf16_t* xp, const bf16_t* wp, int K) {
    f32x16 acc;
#pragma unroll
    for (int i = 0; i < 16; ++i) acc[i] = 0.f;
    int k0 = 0;
#pragma unroll 1
    for (; k0 + 256 <= K; k0 += 256) {
        bf16x8 a[16], b[16];
#pragma unroll
        for (int j = 0; j < 16; ++j) { a[j] = *(const bf16x8*)(wp + k0 + 16 * j); b[j] = *(const bf16x8*)(xp + k0 + 16 * j); }
#pragma unroll
        for (int j = 0; j < 16; ++j) { pin(a[j]); pin(b[j]); }
#pragma unroll
        for (int j = 0; j < 16; ++j) acc = MFMA32(a[j], b[j], acc);
    }
    if (k0 < K) {
        bf16x8 a[8], b[8];
#pragma unroll
        for (int j = 0; j < 8; ++j) { a[j] = *(const bf16x8*)(wp + k0 + 16 * j); b[j] = *(const bf16x8*)(xp + k0 + 16 * j); }
#pragma unroll
        for (int j = 0; j < 8; ++j) { pin(a[j]); pin(b[j]); }
#pragma unroll
        for (int j = 0; j < 8; ++j) acc = MFMA32(a[j], b[j], acc);
    }
    return acc;
}
DI void small_inproj(KP P) {
    int tid = threadIdx.x; asm volatile("" : "+v"(tid));
    const int lane = tid & 63, wave = tid >> 6, gw = blockIdx.x * 8 + wave, NGW = gridDim.x * 8, r = lane & 31, h2 = lane >> 5;
    const bf16_t* XB = (const bf16_t*)(P->ws + WS_XB); const bf16_t* WI = (const bf16_t*)(P->ws + WS_WIN);
    float* DT = (float*)(P->ws + WS_DT); float* out = P->out;
    for (int task = gw; task < 1024 + 16 * 97; task += NGW) {
        if (task < 1024) {
            const f32x16 acc = small_block(XB, WI, 1024, task * 32, 3072, lane);
            *(f32x4*)(DT + (size_t)(task * 32 + r) * 8 + 4 * h2) = (f32x4){acc[0], acc[1], acc[2], acc[3]};
            continue;
        }
        const int t2 = task - 1024, sb = t2 / 97, cb = t2 - sb * 97, row = MP + sb * 32 + r, col0 = cb * 32;
        const f32x16 acc = small_block(XB, WI, 1024, MP + sb * 32, col0, lane);
#pragma unroll
        for (int g = 0; g < 4; ++g) {
            const int col = col0 + 8 * g + 4 * h2; const f32x4 v = {acc[4 * g], acc[4 * g + 1], acc[4 * g + 2], acc[4 * g + 3]};
            u32x2 w; w.x = pk2(v[0], v[1]); w.y = pk2(v[2], v[3]);
            if (col < 512) *(u32x2*)((bf16_t*)(P->ws + WS_Q) + (size_t)row * 512 + col) = w;
            else if (col < 1024) { *(u32x2*)((bf16_t*)(P->ws + WS_KS) + ((size_t)sb * 544 + 512 + r) * 512 + col - 512) = w; *(f32x4*)(out + O_NKS + (size_t)(sb * 32 + r) * 512 + col - 512) = v; }
            else if (col < 1536) { const int c = col - 1024, head = c >> 6, d0 = c & 63, t = 512 + r, tt = t & 15, hh = (tt >> 2) & 1, jj = ((tt >> 3) << 2) | (tt & 3);
                bf16_t* p = (bf16_t*)(P->ws + WS_VFS) + ((size_t)(sb * 8 + head) * 34 + (t >> 4)) * 1024 + (hh * 64 + d0) * 8 + jj;
                p[0] = (bf16_t)(w.x & 0xffff); p[8] = (bf16_t)(w.x >> 16); p[16] = (bf16_t)(w.y & 0xffff); p[24] = (bf16_t)(w.y >> 16);
                *(f32x4*)(out + O_NVS + (size_t)(sb * 32 + r) * 512 + c) = v; }
            else if (col < 2048) *(u32x2*)((bf16_t*)(P->ws + WS_Z) + (size_t)row * 512 + col - 1536) = w;
            else if (col < 3072) { *(u32x2*)((bf16_t*)(P->ws + WS_XBC) + (size_t)row * 1024 + col - 2048) = w;
                if (r >= 29) *(f32x4*)(out + O_SCS + ((size_t)(sb * 3 + r - 29)) * 1024 + col - 2048) = v; }
            else if (col < 3080) *(f32x4*)(DT + (size_t)row * 8 + col - 3072) = v;
        }
    }
}
DI void small_down_splitk(KP P, LAS unsigned char* lds, int tid_in) {
    int tid = tid_in; asm volatile("" : "+v"(tid));
    const int lane = tid & 63, wave = __builtin_amdgcn_readfirstlane(tid >> 6), r = lane & 31, h2 = lane >> 5;
    const int tl = wave / 3, kq = wave - 3 * tl;
    const bf16_t* X = (const bf16_t*)(P->ws + WS_GS); const bf16_t* Wt = (const bf16_t*)(P->ws + WS_WDOWN);
    LAS float* part = (LAS float*)lds;
    for (int pair = blockIdx.x; pair < 256; pair += gridDim.x) {
        const int task = pair * 2 + tl, sb = task >> 5, cb = task & 31, col0 = cb * 32;
        __syncthreads();
        if (tl < 2) {
            const f32x16 acc = small_block_p(X + (size_t)(sb * 32 + r) * DFF + kq * 896 + 8 * h2, Wt + (size_t)(col0 + r) * DFF + kq * 896 + 8 * h2, 896);
#pragma unroll
            for (int i = 0; i < 16; ++i) part[((tl * 3 + kq) * 16 + i) * 64 + lane] = acc[i];
        }
        __syncthreads();
        if (tl < 2 && kq == 0) {
            const int row = MP + sb * 32 + r;
#pragma unroll
            for (int g = 0; g < 4; ++g) {
                f32x4 v;
#pragma unroll
                for (int e = 0; e < 4; ++e) { const int i = 4 * g + e; v[e] = part[((tl * 3 + 0) * 16 + i) * 64 + lane] + part[((tl * 3 + 1) * 16 + i) * 64 + lane] + part[((tl * 3 + 2) * 16 + i) * 64 + lane]; }
                const int col = col0 + 8 * g + 4 * h2;
                const u32x2 w = *(const u32x2*)((const bf16_t*)(P->ws + WS_XB) + (size_t)row * 1024 + col); const f32x4 xv = {bf_lo(w.x), bf_hi(w.x), bf_lo(w.y), bf_hi(w.y)};
                const f32x4 o = xv * ALPHA + v; u32x2 wo; wo.x = pk2(o[0], o[1]); wo.y = pk2(o[2], o[3]);
                *(u32x2*)((bf16_t*)(P->ws + WS_A2) + (size_t)row * 1024 + col) = wo;
            }
        }
    }
}
DI void small_out_splitk(KP P, LAS unsigned char* lds, int tid_in) {
    int tid = tid_in; asm volatile("" : "+v"(tid));
    const int lane = tid & 63, wave = __builtin_amdgcn_readfirstlane(tid >> 6), r = lane & 31, h2 = lane >> 5;
    const int tl = wave >> 2, kq = wave & 3;
    const bf16_t* X = (const bf16_t*)(P->ws + WS_A2); const bf16_t* Wt = (const bf16_t*)(P->ws + WS_WOUT);
    LAS float* part = (LAS float*)lds;
    for (int pair = blockIdx.x; pair < 256; pair += gridDim.x) {
        const int task = pair * 2 + tl, sb = task >> 5, cb = task & 31, col0 = cb * 32;
        __syncthreads();
        const f32x16 acc = small_block_p(X + (size_t)(MP + sb * 32 + r) * 1024 + kq * 256 + 8 * h2, Wt + (size_t)(col0 + r) * 1024 + kq * 256 + 8 * h2, 256);
#pragma unroll
        for (int i = 0; i < 16; ++i) part[((tl * 4 + kq) * 16 + i) * 64 + lane] = acc[i];
        __syncthreads();
        if (kq == 0) {
            const int row = MP + sb * 32 + r;
#pragma unroll
            for (int g = 0; g < 4; ++g) {
                f32x4 v;
#pragma unroll
                for (int e = 0; e < 4; ++e) { const int i = 4 * g + e; v[e] = (part[((tl * 4 + 0) * 16 + i) * 64 + lane] + part[((tl * 4 + 1) * 16 + i) * 64 + lane]) + (part[((tl * 4 + 2) * 16 + i) * 64 + lane] + part[((tl * 4 + 3) * 16 + i) * 64 + lane]); }
                const int col = col0 + 8 * g + 4 * h2;
                const f32x4 xv = *(const f32x4*)(P->in[1] + (size_t)(row - MP) * 1024 + col);
                const f32x4 o = xv * ALPHA + v; u32x2 wo; wo.x = pk2(o[0], o[1]); wo.y = pk2(o[2], o[3]);
                *(u32x2*)((bf16_t*)(P->out + O_Y) + (size_t)row * 1024 + col) = wo;
            }
        }
    }
}
DI void small_ffnconv_prompt(KP P, LAS unsigned char* lds, int tid_in) {
    int tid = tid_in; asm volatile("" : "+v"(tid));
    const int lane = tid & 63, kq = __builtin_amdgcn_readfirstlane(tid >> 6), r = lane & 31, h2 = lane >> 5;
    const bf16_t* X1 = (const bf16_t*)(P->ws + WS_XB); const bf16_t* WU = (const bf16_t*)(P->ws + WS_WUP);
    const int rr = r & 7, b = rr >> 1, t = 8190 + (rr & 1);
    LAS float* part = (LAS float*)lds;
    for (int task = blockIdx.x; task < 168; task += gridDim.x) {
        const int rho0 = task * 32, n0 = ((rho0 >> 7) & 1) * DFF + (rho0 >> 8) * 128 + (rho0 & 127);
        __syncthreads();
        const f32x16 acc = small_block_p(X1 + ((size_t)b * 8192 + t) * 1024 + kq * 128 + 8 * h2, WU + (size_t)(rho0 + r) * 1024 + kq * 128 + 8 * h2, 128);
#pragma unroll
        for (int i = 0; i < 16; ++i) part[(kq * 16 + i) * 64 + lane] = acc[i];
        __syncthreads();
        if (kq == 0 && r < 8) {
#pragma unroll
            for (int g = 0; g < 4; ++g) { f32x4 v;
#pragma unroll
                for (int e = 0; e < 4; ++e) { float s = 0.f;
#pragma unroll
                    for (int q = 0; q < 8; ++q) s += part[(q * 16 + 4 * g + e) * 64 + lane];
                    v[e] = s; }
                *(f32x4*)(P->out + O_FCP + (size_t)(b * 2 + (rr & 1)) * NUP + n0 + 8 * g + 4 * h2) = v; }
        }
    }
}
template <bool DOWN> DI void small_resid(KP P, int tid_in) {
    int tid = tid_in; asm volatile("" : "+v"(tid));
    const int lane = tid & 63, wave = tid >> 6, gw = blockIdx.x * 8 + wave, NGW = gridDim.x * 8, r = lane & 31, h2 = lane >> 5;
    const bf16_t* X = DOWN ? (const bf16_t*)(P->ws + WS_GS) - (size_t)MP * DFF : (const bf16_t*)(P->ws + WS_A2); const bf16_t* Wt = (const bf16_t*)(P->ws + (DOWN ? WS_WDOWN : WS_WOUT));
    const int K = DOWN ? DFF : 1024;
    for (int task = gw; task < 512; task += NGW) {
        const int sb = task >> 5, cb = task & 31, row = MP + sb * 32 + r, col0 = cb * 32;
        const f32x16 acc = small_block(X, Wt, K, MP + sb * 32, col0, lane);
#pragma unroll
        for (int g = 0; g < 4; ++g) {
            const int col = col0 + 8 * g + 4 * h2; const f32x4 v = {acc[4 * g], acc[4 * g + 1], acc[4 * g + 2], acc[4 * g + 3]};
            f32x4 xv;
            if (DOWN) { const u32x2 w = *(const u32x2*)((const bf16_t*)(P->ws + WS_XB) + (size_t)row * 1024 + col); xv = (f32x4){bf_lo(w.x), bf_hi(w.x), bf_lo(w.y), bf_hi(w.y)}; }
            else xv = *(const f32x4*)(P->in[1] + (size_t)(row - MP) * 1024 + col);
            bf16_t* U = DOWN ? (bf16_t*)(P->ws + WS_A2) : (bf16_t*)(P->out + O_Y);
            const f32x4 o = xv * ALPHA + v; u32x2 wo; wo.x = pk2(o[0], o[1]); wo.y = pk2(o[2], o[3]); *(u32x2*)(U + (size_t)row * 1024 + col) = wo;
        }
    }
}

DI void p0_transpose_item(const float* W, int K, int N, bf16_t* WT, int drow0, LAS float* scr, int k0, int n0, int lane) {
    const int nn = n0 + (lane & 31); const int nc = (nn < N) ? nn : N - 1;
    float tv[32];
#pragma unroll
    for (int i = 0; i < 32; ++i) tv[i] = W[(size_t)(k0 + 2 * i + (lane >> 5)) * N + nc];
#pragma unroll
    for (int i = 0; i < 32; ++i) scr[(2 * i + (lane >> 5)) * 33 + (lane & 31)] = tv[i];
    asm volatile("s_waitcnt lgkmcnt(0)" ::: "memory");
    const int c = lane & 7;
#pragma unroll
    for (int j = 0; j < 4; ++j) { const int n = (lane >> 3) + 8 * j; const LAS float* s = scr + (8 * c) * 33 + n;
        u32x4 o; o.x = pk2(s[0 * 33], s[1 * 33]); o.y = pk2(s[2 * 33], s[3 * 33]); o.z = pk2(s[4 * 33], s[5 * 33]); o.w = pk2(s[6 * 33], s[7 * 33]);
        if (n0 + n < N) *(u32x4*)(WT + (size_t)(drow0 + n) * K + k0 + 8 * c) = o; }
    asm volatile("s_waitcnt lgkmcnt(0)" ::: "memory");
}
DI void p0_transpose_item_f8(const float* W, int K, int N, unsigned char* WT, int pitch, int drow0, LAS float* scr, int k0, int n0, int lane, float sc) {
    const int nn = n0 + (lane & 31); const int nc = (nn < N) ? nn : N - 1;
    float tv[32];
#pragma unroll
    for (int i = 0; i < 32; ++i) tv[i] = W[(size_t)(k0 + 2 * i + (lane >> 5)) * N + nc];
#pragma unroll
    for (int i = 0; i < 32; ++i) scr[(2 * i + (lane >> 5)) * 33 + (lane & 31)] = tv[i] * sc;
    asm volatile("s_waitcnt lgkmcnt(0)" ::: "memory");
    const int c = lane & 7;
#pragma unroll
    for (int j = 0; j < 4; ++j) { const int n = (lane >> 3) + 8 * j; const LAS float* s = scr + (8 * c) * 33 + n;
        u32x2 o; o.x = pk4_f8(s[0 * 33], s[1 * 33], s[2 * 33], s[3 * 33]); o.y = pk4_f8(s[4 * 33], s[5 * 33], s[6 * 33], s[7 * 33]);
        if (n0 + n < N) *(u32x2*)(WT + (size_t)(drow0 + n) * pitch + k0 + 8 * c) = o; }
    asm volatile("s_waitcnt lgkmcnt(0)" ::: "memory");
}
constexpr int LATE_ITEMS = 16 * 32 + 16 * 168 + 42 * 32, LATE_WG_ITEMS = LATE_ITEMS / 64;
DI void convert_late_item(KP P, LAS unsigned char* lds, int wi) {
    int tid = threadIdx.x; asm volatile("" : "+v"(tid));
    const int lane = tid & 63, wave = tid >> 6;
    __syncthreads();
    LAS float* scr = (LAS float*)(lds + wave * 8448);
    constexpr int I_OUT = 16 * 32, I_UP = 16 * 168;
#pragma unroll 1
    for (int j = 0; j < 8; ++j) {
        int r = wi * 64 + wave * 8 + j;
        if (r < I_OUT) { const int kb = r / 32, nb = r % 32; p0_transpose_item(P->in[16], 1024, 1024, (bf16_t*)(P->ws + WS_WOUT), nb * 32, scr, kb * 64, nb * 32, lane); continue; } r -= I_OUT;
        if (r < I_UP) { const int kb = r / 168, nb = r % 168; const int n0 = nb * 32; const int np = (n0 < DFF) ? n0 : n0 - DFF;
            const int drow = (np >> 7) * 256 + ((n0 < DFF) ? 0 : 128) + (np & 127);
            p0_transpose_item(P->in[19], 1024, NUP, (bf16_t*)(P->ws + WS_WUP), drow, scr, kb * 64, n0, lane);
            p0_transpose_item_f8(P->in[19], 1024, NUP, P->ws + WS_WUP8, 1024, drow, scr, kb * 64, n0, lane, SC_WUP); continue; } r -= I_UP;
        { const int kb = r / 32, nb = r % 32; p0_transpose_item(P->in[22], DFF, 1024, (bf16_t*)(P->ws + WS_WDOWN), nb * 32, scr, kb * 64, nb * 32, lane); }
    }
}
DI void phase_convert(KP P, LAS unsigned char* lds) {
    int tid = threadIdx.x; asm volatile("" : "+v"(tid));
    const int lane = tid & 63, wave = tid >> 6, G = gridDim.x;
    LAS float* scr = (LAS float*)(lds + wave * 8448);
    const int gw = blockIdx.x * 8 + wave, NGW = G * 8;
    constexpr int I_IN = 16 * 97;
    for (int it = gw; it < I_IN; it += NGW) { const int kb = it / 97, nb = it % 97; p0_transpose_item(P->in[7], 1024, NIN, (bf16_t*)(P->ws + WS_WIN), nb * 32, scr, kb * 64, nb * 32, lane); }
    const size_t gt = (size_t)blockIdx.x * NT + tid, NGT = (size_t)G * NT;
    { bf16_t* XB = (bf16_t*)(P->ws + WS_XB);
      constexpr size_t NCH = (size_t)MT * 128;
      size_t i0 = gt;
      for (; i0 + 3 * NGT < NCH; i0 += 4 * NGT) {
          f32x4 a[4], b[4];
#pragma unroll
          for (int u = 0; u < 4; ++u) { const size_t e = (i0 + u * NGT) * 8; const float* src = (e < (size_t)MP * 1024) ? P->in[0] + e : P->in[1] + (e - (size_t)MP * 1024);
              a[u] = __builtin_nontemporal_load((const f32x4*)src); b[u] = __builtin_nontemporal_load((const f32x4*)(src + 4)); }
#pragma unroll
          for (int u = 0; u < 4; ++u) { pin(a[u]); pin(b[u]); }
#pragma unroll
          for (int u = 0; u < 4; ++u) { u32x4 w; w.x = pk2(a[u][0], a[u][1]); w.y = pk2(a[u][2], a[u][3]); w.z = pk2(b[u][0], b[u][1]); w.w = pk2(b[u][2], b[u][3]); *(u32x4*)(XB + (i0 + u * NGT) * 8) = w; }
      }
      for (; i0 < NCH; i0 += NGT) { const size_t e = i0 * 8; const float* src = (e < (size_t)MP * 1024) ? P->in[0] + e : P->in[1] + (e - (size_t)MP * 1024);
          const f32x4 a = *(const f32x4*)src, b = *(const f32x4*)(src + 4); u32x4 w; w.x = pk2(a[0], a[1]); w.y = pk2(a[2], a[3]); w.z = pk2(b[0], b[1]); w.w = pk2(b[2], b[3]); *(u32x4*)(XB + e) = w; }
    }
    { bf16_t* WI = (bf16_t*)(P->ws + WS_WIN) + (size_t)NIN * 1024;
      for (size_t i = gt; i < (size_t)(NINP - NIN) * 128; i += NGT) *(u32x4*)(WI + i * 8) = (u32x4){0u, 0u, 0u, 0u}; }
    { bf16_t* KS = (bf16_t*)(P->ws + WS_KS); bf16_t* VF = (bf16_t*)(P->ws + WS_VFS);
      for (size_t i = gt; i < (size_t)16 * 512 * 64; i += NGT) {
          const int cgp = (int)(i & 63), t = (int)((i >> 6) & 511), b = (int)(i >> 15);
          const float* ks = P->in[2] + ((size_t)(b * 512 + t)) * 512 + cgp * 8; const float* vs = P->in[3] + ((size_t)(b * 512 + t)) * 512 + cgp * 8;
          const f32x4 a = __builtin_nontemporal_load((const f32x4*)ks), c = __builtin_nontemporal_load((const f32x4*)(ks + 4)); u32x4 w; w.x = pk2(a[0], a[1]); w.y = pk2(a[2], a[3]); w.z = pk2(c[0], c[1]); w.w = pk2(c[2], c[3]);
          *(u32x4*)(KS + ((size_t)b * 544 + t) * 512 + cgp * 8) = w;
          const f32x4 va = __builtin_nontemporal_load((const f32x4*)vs), vc = __builtin_nontemporal_load((const f32x4*)(vs + 4));
          const int head = cgp >> 3, d0 = (cgp & 7) * 8, tt = t & 15, hh = (tt >> 2) & 1, jj = ((tt >> 3) << 2) | (tt & 3);
          bf16_t* p = VF + ((size_t)(b * 8 + head) * 34 + (t >> 4)) * 1024 + (hh * 64 + d0) * 8 + jj;
          const unsigned w0 = pk2(va[0], va[1]), w1 = pk2(va[2], va[3]), w2 = pk2(vc[0], vc[1]), w3 = pk2(vc[2], vc[3]);
          p[0] = (bf16_t)(w0 & 0xffff); p[8] = (bf16_t)(w0 >> 16); p[16] = (bf16_t)(w1 & 0xffff); p[24] = (bf16_t)(w1 >> 16);
          p[32] = (bf16_t)(w2 & 0xffff); p[40] = (bf16_t)(w2 >> 16); p[48] = (bf16_t)(w3 & 0xffff); p[56] = (bf16_t)(w3 >> 16);
      } }
}

template <bool OUT_BF16>
DI void phase_ln(const bf16_t* src, const float* gam, const float* bet, void* dst, unsigned char* dst8, unsigned char* g8pad, int tid_in) {
    int tid = tid_in; asm volatile("" : "+v"(tid));
    const int lane = tid & 63, wave = tid >> 6, gw = blockIdx.x * 8 + wave, NGW = gridDim.x * 8;
    f32x4 g4[4], b4[4];
#pragma unroll
    for (int j = 0; j < 4; ++j) { g4[j] = *(const f32x4*)(gam + (lane + 64 * j) * 4); b4[j] = *(const f32x4*)(bet + (lane + 64 * j) * 4); }
    for (int row0 = gw; row0 < MT; row0 += 2 * NGW) {
        u32x2 wv[2][4];
#pragma unroll
        for (int u = 0; u < 2; ++u) { const int row = row0 + u * NGW;
#pragma unroll
            for (int j = 0; j < 4; ++j) { wv[u][j] = (u32x2){0u, 0u}; if (row < MT) wv[u][j] = __builtin_nontemporal_load((const u32x2*)(src + (size_t)row * 1024 + (lane + 64 * j) * 4)); } }
#pragma unroll
        for (int u = 0; u < 2; ++u) { const int row = row0 + u * NGW; if (row >= MT) continue;
            f32x4 v[4]; float s = 0.f;
#pragma unroll
            for (int j = 0; j < 4; ++j) { const u32x2 w = wv[u][j]; v[j] = (f32x4){bf_lo(w.x), bf_hi(w.x), bf_lo(w.y), bf_hi(w.y)}; s += (v[j][0] + v[j][1]) + (v[j][2] + v[j][3]); }
#pragma unroll
            for (int o = 1; o < 64; o <<= 1) s += __shfl_xor(s, o);
            const float mean = s * (1.f / 1024.f); float q = 0.f;
#pragma unroll
            for (int j = 0; j < 4; ++j) { v[j] = v[j] - mean; q += (v[j][0] * v[j][0] + v[j][1] * v[j][1]) + (v[j][2] * v[j][2] + v[j][3] * v[j][3]); }
#pragma unroll
            for (int o = 1; o < 64; o <<= 1) q += __shfl_xor(q, o);
            const float rstd = 1.0f / sqrtf(q * (1.f / 1024.f) + 1e-5f);
#pragma unroll
            for (int j = 0; j < 4; ++j) { const f32x4 o = v[j] * rstd * g4[j] + b4[j];
                if (OUT_BF16) { u32x2 w; w.x = pk2(o[0], o[1]); w.y = pk2(o[2], o[3]); *(u32x2*)((bf16_t*)dst + (size_t)row * 1024 + (lane + 64 * j) * 4) = w;
                    *(unsigned*)(dst8 + (size_t)row * 1024 + (lane + 64 * j) * 4) = pk4_f8(o[0] * SC_X1, o[1] * SC_X1, o[2] * SC_X1, o[3] * SC_X1); }
                else *(f32x4*)((float*)dst + (size_t)row * 1024 + (lane + 64 * j) * 4) = o; }
        }
    }
}

constexpr int XCS = 2080;
constexpr int L_DT = 64 * XCS;
constexpr int L_AC = L_DT + 2048;
constexpr int L_RED = L_AC + 2048;

DI float ssd_dt_scan(KP P, LAS unsigned char* lds, int r0, int Lv, int h, int lane) {
    const float* DT = (const float*)(P->ws + WS_DT);
    float dt = 0.f;
    if (lane < Lv) { const float x = DT[(size_t)(r0 + lane) * 8 + h] + P->in[12][h]; dt = (x > 20.f) ? x : log1pf(expf(x)); }
    const float A = -expf(P->in[13][h]);
    float a = dt * A;
#pragma unroll
    for (int off = 1; off < 64; off <<= 1) { const float v = __shfl_up(a, off); if (lane >= off) a += v; }
    ((LAS float*)(lds + L_DT))[h * 64 + lane] = dt;
    ((LAS float*)(lds + L_AC))[h * 64 + lane] = a;
    return __shfl(a, 63);
}
template <bool DEC, int NCG>
DI void ssd_conv_to_lds(KP P, LAS unsigned char* lds, int tid, int r0, int Lv, bool samp, int sb, bool has_prev) {
    const int tblk = tid >> 7, cgp = tid & 127;
    if (cgp >= NCG) return;
    const int ch0 = cgp * 8, t0 = tblk * 16;
    const bf16_t* XBC = (const bf16_t*)(P->ws + WS_XBC);
    const float* cwp = P->in[10]; const float* cbp = P->in[11];
    float w[4][8], bias[8];
#pragma unroll
    for (int k = 0; k < 4; ++k) { const f32x4 a = *(const f32x4*)(cwp + k * 1024 + ch0), b = *(const f32x4*)(cwp + k * 1024 + ch0 + 4);
#pragma unroll
        for (int e = 0; e < 4; ++e) { w[k][e] = a[e]; w[k][4 + e] = b[e]; } }
    { const f32x4 a = *(const f32x4*)(cbp + ch0), b = *(const f32x4*)(cbp + ch0 + 4);
#pragma unroll
        for (int e = 0; e < 4; ++e) { bias[e] = a[e]; bias[4 + e] = b[e]; } }
    u32x4 raw[19]; f32x4 pa[3], pb[3];
    const bool halo_f32 = samp && (t0 == 0);
#pragma unroll
    for (int k = 0; k < 19; ++k) {
        const int tt = t0 - 3 + k;
        raw[k] = (u32x4){0u, 0u, 0u, 0u};
        if (tt >= 0) { if (tt < Lv) raw[k] = *(const u32x4*)(XBC + (size_t)(r0 + tt) * 1024 + ch0); }
        else if (!samp && has_prev) raw[k] = *(const u32x4*)(XBC + (size_t)(r0 + tt) * 1024 + ch0);
    }
#pragma unroll
    for (int k = 0; k < 3; ++k) { pa[k] = (f32x4){0.f, 0.f, 0.f, 0.f}; pb[k] = pa[k];
        if (halo_f32) { const float* s = P->in[5] + ((size_t)(sb * 3 + k)) * 1024 + ch0; pa[k] = *(const f32x4*)s; pb[k] = *(const f32x4*)(s + 4); } }
    float xw[3][8];
#pragma unroll
    for (int k = 0; k < 3; ++k) {
        const u32x4 q = raw[k];
        xw[k][0] = bf_lo(q.x); xw[k][1] = bf_hi(q.x); xw[k][2] = bf_lo(q.y); xw[k][3] = bf_hi(q.y); xw[k][4] = bf_lo(q.z); xw[k][5] = bf_hi(q.z); xw[k][6] = bf_lo(q.w); xw[k][7] = bf_hi(q.w);
        if (halo_f32) {
#pragma unroll
            for (int e = 0; e < 4; ++e) { xw[k][e] = pa[k][e]; xw[k][4 + e] = pb[k][e]; } }
    }
    const int head = cgp >> 3;
    const LAS float* sdt = (const LAS float*)(lds + L_DT) + head * 64; const LAS float* sac = (const LAS float*)(lds + L_AC) + head * 64;
    const float atot = (cgp < 64) ? sac[63] : 0.f;
#pragma unroll
    for (int i = 0; i < 16; ++i) {
        const int t = t0 + i; float xc[8];
        { const u32x4 q = raw[3 + i];
          xc[0] = bf_lo(q.x); xc[1] = bf_hi(q.x); xc[2] = bf_lo(q.y); xc[3] = bf_hi(q.y); xc[4] = bf_lo(q.z); xc[5] = bf_hi(q.z); xc[6] = bf_lo(q.w); xc[7] = bf_hi(q.w); }
        float f = 1.f;
        if (cgp < 64) { f = sdt[t]; if (DEC) f *= __builtin_amdgcn_exp2f((atot - sac[t]) * LOG2E); }
        if (t >= Lv) f = 0.f;
        float o[8];
#pragma unroll
        for (int e = 0; e < 8; ++e) { const float v = bias[e] + w[0][e] * xw[0][e] + w[1][e] * xw[1][e] + w[2][e] * xw[2][e] + w[3][e] * xc[e]; o[e] = silu_f(v) * f; }
        u32x4 q; q.x = pk2(o[0], o[1]); q.y = pk2(o[2], o[3]); q.z = pk2(o[4], o[5]); q.w = pk2(o[6], o[7]);
        *(LAS u32x4*)(lds + t * XCS + ch0 * 2) = q;
#pragma unroll
        for (int e = 0; e < 8; ++e) { xw[0][e] = xw[1][e]; xw[1][e] = xw[2][e]; xw[2][e] = xc[e]; }
    }
}
DI void chunk_geom(int ch, bool& samp, int& sb, int& r0, int& Lv, bool& has_prev) {
    samp = ch >= 512; sb = ch - 512;
    if (!samp) { r0 = ch * 64; Lv = 64; has_prev = (ch & 127) != 0; } else { r0 = MP + sb * 32; Lv = 32; has_prev = false; }
}
DI void ssd_states_tile(KP P, LAS unsigned char* lds, int ch) {
    int tid = threadIdx.x; asm volatile("" : "+v"(tid));
    const int lane = tid & 63, h = __builtin_amdgcn_readfirstlane(tid >> 6);
    bool samp, has_prev; int sb, r0, Lv; chunk_geom(ch, samp, sb, r0, Lv, has_prev);
    __syncthreads();
    const float atot = ssd_dt_scan(P, lds, r0, Lv, h, lane);
    if (lane == 0) ((float*)(P->ws + WS_DEC))[ch * 8 + h] = expf(atot);
    __syncthreads();
    ssd_conv_to_lds<true, 96>(P, lds, tid, r0, Lv, samp, sb, has_prev);
    __syncthreads();
    const int r = lane & 31, h2 = lane >> 5, blk = (lane >> 4) & 1, i16 = lane & 15, q = i16 >> 2, pp = i16 & 3, g = h >> 2;
    bf16_t* ST = (bf16_t*)(P->ws + WS_ST) + ((size_t)ch * 8 + h) * 8192;
#pragma unroll 1
    for (int nh = 0; nh < 2; ++nh) {
        f32x16 acc[2][2];
#pragma unroll
        for (int a = 0; a < 2; ++a)
#pragma unroll
            for (int b = 0; b < 2; ++b)
#pragma unroll
                for (int i = 0; i < 16; ++i) acc[a][b][i] = 0.f;
#pragma unroll
        for (int sp = 0; sp < 4; ++sp) {
            LAS unsigned char* rlo = lds + (16 * sp + 8 * h2 + q) * XCS + (16 * blk + 4 * pp) * 2;
            LAS unsigned char* rhi = rlo + 4 * XCS;
            bf16x8 af[2], bfr[2];
#pragma unroll
            for (int pb = 0; pb < 2; ++pb) af[pb] = tr_frag(rlo + (h * 64 + 32 * pb) * 2, rhi + (h * 64 + 32 * pb) * 2);
#pragma unroll
            for (int nb = 0; nb < 2; ++nb) bfr[nb] = tr_frag(rlo + (512 + g * 128 + 64 * nh + 32 * nb) * 2, rhi + (512 + g * 128 + 64 * nh + 32 * nb) * 2);
#pragma unroll
            for (int pb = 0; pb < 2; ++pb)
#pragma unroll
                for (int nb = 0; nb < 2; ++nb) acc[pb][nb] = MFMA32(af[pb], bfr[nb], acc[pb][nb]);
        }
#pragma unroll
        for (int pb = 0; pb < 2; ++pb)
#pragma unroll
            for (int nb = 0; nb < 2; ++nb) {
                bf16_t* sp_ = ST + (32 * pb + 4 * h2) * 128 + 64 * nh + 32 * nb + r;
#pragma unroll
                for (int i = 0; i < 16; ++i) sp_[((i & 3) + 8 * (i >> 2)) * 128] = (bf16_t)(pk2(acc[pb][nb][i], 0.f) & 0xffff);
            }
    }
}
DI void phase_scan(KP P, LAS unsigned char* lds) {
    int tid = threadIdx.x; asm volatile("" : "+v"(tid));
    unsigned* ST = (unsigned*)(P->ws + WS_ST); const float* DEC = (const float*)(P->ws + WS_DEC);
    LAS float* sdec = (LAS float*)lds;
    for (int blk = blockIdx.x; blk < 256; blk += gridDim.x) {
        const int b = blk >> 6, h = (blk >> 3) & 7, rem = (blk & 63) * 512 + tid;
        __syncthreads();
        if (tid < 128) sdec[tid] = DEC[(b * 128 + tid) * 8 + h];
        __syncthreads();
        float H0 = 0.f, H1 = 0.f;
        unsigned* sp = ST + (size_t)b * 128 * 32768 + rem;
#pragma unroll 1
        for (int c0 = 0; c0 < 128; c0 += 64) {
            unsigned w[64];
#pragma unroll
            for (int k = 0; k < 64; ++k) w[k] = sp[(size_t)(c0 + k) * 32768];
#pragma unroll
            for (int k = 0; k < 64; ++k) { const float d = sdec[c0 + k]; sp[(size_t)(c0 + k) * 32768] = pk2(H0, H1); H0 = H0 * d + bf_lo(w[k]); H1 = H1 * d + bf_hi(w[k]); }
        }
        *(f32x2*)(P->out + O_SSP + ((size_t)blk * 512 + tid) * 2) = (f32x2){H0, H1};
    }
}
DI void phase_sample_state(KP P) {
    int tid = threadIdx.x; asm volatile("" : "+v"(tid));
    const size_t gt = (size_t)blockIdx.x * NT + tid, NGT = (size_t)gridDim.x * NT;
    const unsigned* ST = (const unsigned*)(P->ws + WS_ST); const float* DEC = (const float*)(P->ws + WS_DEC);
    for (size_t pr0 = gt; pr0 < 524288; pr0 += 4 * NGT) {
        f32x2 h0[4]; unsigned w[4]; float d[4];
#pragma unroll
        for (int u = 0; u < 4; ++u) { const size_t pr = pr0 + u * NGT; h0[u] = (f32x2){0.f, 0.f}; w[u] = 0u; d[u] = 0.f;
            if (pr < 524288) { const int b = (int)(pr >> 15), rem = (int)(pr & 32767), h = rem >> 12, chq = 512 + b;
                h0[u] = *(const f32x2*)(P->in[4] + pr * 2); w[u] = ST[(size_t)chq * 32768 + rem]; d[u] = DEC[chq * 8 + h]; } }
#pragma unroll
        for (int u = 0; u < 4; ++u) { const size_t pr = pr0 + u * NGT;
            if (pr < 524288) *(f32x2*)(P->out + O_SSS + pr * 2) = (f32x2){h0[u][0] * d[u] + bf_lo(w[u]), h0[u][1] * d[u] + bf_hi(w[u])}; }
    }
}
DI void ssd_out_tile(KP P, LAS unsigned char* lds, int ch) {
    int tid = threadIdx.x; asm volatile("" : "+v"(tid));
    const int lane = tid & 63, h = __builtin_amdgcn_readfirstlane(tid >> 6);
    bool samp, has_prev; int sb, r0, Lv; chunk_geom(ch, samp, sb, r0, Lv, has_prev);
    __syncthreads();
    ssd_dt_scan(P, lds, r0, Lv, h, lane);
    __syncthreads();
    ssd_conv_to_lds<false, 128>(P, lds, tid, r0, Lv, samp, sb, has_prev);
    __syncthreads();
    const int r = lane & 31, h2 = lane >> 5, blk = (lane >> 4) & 1, i16 = lane & 15, q = i16 >> 2, pp = i16 & 3, g = h >> 2;
    const LAS float* sac = (const LAS float*)(lds + L_AC) + h * 64; const LAS float* sdt = (const LAS float*)(lds + L_DT) + h * 64;
    f32x16 cb[2][2];
#pragma unroll
    for (int a = 0; a < 2; ++a)
#pragma unroll
        for (int b = 0; b < 2; ++b)
#pragma unroll
            for (int i = 0; i < 16; ++i) cb[a][b][i] = 0.f;
    const bf16_t* PREV = (const bf16_t*)(P->ws + WS_ST) + ((size_t)ch * 8 + h) * 8192;
#pragma unroll 2
    for (int kk = 0; kk < 8; ++kk) {
        bf16x8 bm[2], cm[2];
#pragma unroll
        for (int x = 0; x < 2; ++x) {
            bm[x] = *(const LAS bf16x8*)(lds + (32 * x + r) * XCS + (512 + g * 128 + 16 * kk + 8 * h2) * 2);
            cm[x] = *(const LAS bf16x8*)(lds + (32 * x + r) * XCS + (768 + g * 128 + 16 * kk + 8 * h2) * 2);
        }
#pragma unroll
        for (int a = 0; a < 2; ++a)
#pragma unroll
            for (int b = 0; b < 2; ++b) cb[a][b] = MFMA32(bm[a], cm[b], cb[a][b]);
    }
    __builtin_amdgcn_sched_barrier(0);
    float acl[2]; acl[0] = sac[r]; acl[1] = sac[32 + r];
    f32x16 y[2][2];
#pragma unroll
    for (int a = 0; a < 2; ++a)
#pragma unroll
        for (int b = 0; b < 2; ++b)
#pragma unroll
            for (int i = 0; i < 16; ++i) y[a][b][i] = 0.f;
#pragma unroll
    for (int sbk = 0; sbk < 2; ++sbk) {
        float acs[16];
#pragma unroll
        for (int gi = 0; gi < 4; ++gi) { const f32x4 t4 = *(const LAS f32x4*)(sac + 32 * sbk + 8 * gi + 4 * h2); acs[4 * gi] = t4[0]; acs[4 * gi + 1] = t4[1]; acs[4 * gi + 2] = t4[2]; acs[4 * gi + 3] = t4[3]; }
#pragma unroll
        for (int s2 = 0; s2 < 2; ++s2) {
            bf16x8 pf[2];
#pragma unroll
            for (int lb = 0; lb < 2; ++lb) {
                const int l = 32 * lb + r; float m[8];
#pragma unroll
                for (int j = 0; j < 8; ++j) { const int i = 8 * s2 + j, s = 32 * sbk + crow(i, h2);
                    m[j] = (s <= l) ? cb[sbk][lb][i] * __builtin_amdgcn_exp2f((acl[lb] - acs[i]) * LOG2E) : 0.f; }
                pf[lb] = pack8(m[0], m[1], m[2], m[3], m[4], m[5], m[6], m[7]);
            }
            LAS unsigned char* rlo = lds + (32 * sbk + 16 * s2 + 4 * h2 + q) * XCS + (h * 64 + 16 * blk + 4 * pp) * 2;
            LAS unsigned char* rhi = rlo + 8 * XCS;
#pragma unroll
            for (int pb = 0; pb < 2; ++pb) { const bf16x8 xa = tr_frag(rlo + 64 * pb, rhi + 64 * pb);
#pragma unroll
                for (int lb = 0; lb < 2; ++lb) y[pb][lb] = MFMA32(xa, pf[lb], y[pb][lb]); }
        }
    }
    __builtin_amdgcn_sched_barrier(0);
    {
        f32x16 yo[2][2];
#pragma unroll
        for (int a = 0; a < 2; ++a)
#pragma unroll
            for (int b = 0; b < 2; ++b)
#pragma unroll
                for (int i = 0; i < 16; ++i) yo[a][b][i] = 0.f;
        bf16x8 pv[8][2];
#pragma unroll
        for (int kk = 0; kk < 8; ++kk)
#pragma unroll
            for (int x = 0; x < 2; ++x) {
                if (!samp) pv[kk][x] = *(const bf16x8*)(PREV + (32 * x + r) * 128 + 16 * kk + 8 * h2);
                else { const float* hp = P->in[4] + ((size_t)(sb * 8 + h) * 64 + 32 * x + r) * 128 + 16 * kk + 8 * h2; const f32x4 ha = *(const f32x4*)hp, hb = *(const f32x4*)(hp + 4);
                    pv[kk][x] = pack8(ha[0], ha[1], ha[2], ha[3], hb[0], hb[1], hb[2], hb[3]); }
            }
#pragma unroll
        for (int kk = 0; kk < 8; ++kk)
#pragma unroll
            for (int x = 0; x < 2; ++x) pin(pv[kk][x]);
#pragma unroll
        for (int kk = 0; kk < 8; ++kk) {
            bf16x8 cm[2];
#pragma unroll
            for (int x = 0; x < 2; ++x) cm[x] = *(const LAS bf16x8*)(lds + (32 * x + r) * XCS + (768 + g * 128 + 16 * kk + 8 * h2) * 2);
#pragma unroll
            for (int a = 0; a < 2; ++a)
#pragma unroll
                for (int b = 0; b < 2; ++b) yo[a][b] = MFMA32(pv[kk][a], cm[b], yo[a][b]);
        }
#pragma unroll
        for (int lb = 0; lb < 2; ++lb) { const float eo = __builtin_amdgcn_exp2f(acl[lb] * LOG2E);
#pragma unroll
            for (int pb = 0; pb < 2; ++pb)
#pragma unroll
                for (int i = 0; i < 16; ++i) y[pb][lb][i] += eo * yo[pb][lb][i]; }
    }
    __builtin_amdgcn_sched_barrier(0);
    const float Dh = P->in[14][h];
    const bf16_t* Z = (const bf16_t*)(P->ws + WS_Z);
    float ss[2] = {0.f, 0.f};
    u32x2 zq[2][2][4];
#pragma unroll
    for (int lb = 0; lb < 2; ++lb)
#pragma unroll
        for (int pb = 0; pb < 2; ++pb)
#pragma unroll
            for (int gi = 0; gi < 4; ++gi) { const int l = 32 * lb + r; zq[lb][pb][gi] = (u32x2){0u, 0u};
                if (l < Lv) zq[lb][pb][gi] = *(const u32x2*)(Z + (size_t)(r0 + l) * 512 + h * 64 + 32 * pb + 8 * gi + 4 * h2); }
#pragma unroll
    for (int lb = 0; lb < 2; ++lb)
#pragma unroll
        for (int pb = 0; pb < 2; ++pb)
#pragma unroll
            for (int gi = 0; gi < 4; ++gi) pin(zq[lb][pb][gi]);
#pragma unroll
    for (int lb = 0; lb < 2; ++lb) {
        const int l = 32 * lb + r; const bool ok = l < Lv;
        const float dtl = sdt[l]; const float dsk = ok ? Dh / dtl : 0.f;
#pragma unroll
        for (int pb = 0; pb < 2; ++pb)
#pragma unroll
            for (int gi = 0; gi < 4; ++gi) {
                const int p0 = 32 * pb + 8 * gi + 4 * h2;
                const u32x2 xq = *(const LAS u32x2*)(lds + l * XCS + (h * 64 + p0) * 2);
                const u32x2 zv2 = zq[lb][pb][gi];
                const float xv[4] = {bf_lo(xq.x), bf_hi(xq.x), bf_lo(xq.y), bf_hi(xq.y)}; const float zv[4] = {bf_lo(zv2.x), bf_hi(zv2.x), bf_lo(zv2.y), bf_hi(zv2.y)};
#pragma unroll
                for (int e = 0; e < 4; ++e) { const int i = 4 * gi + e; float v = y[pb][lb][i] + xv[e] * dsk; v *= silu_f(zv[e]); y[pb][lb][i] = v; ss[lb] += v * v; }
            }
    }
    LAS float* red = (LAS float*)(lds + L_RED);
#pragma unroll
    for (int lb = 0; lb < 2; ++lb) { ss[lb] += __shfl_xor(ss[lb], 32); if (h2 == 0) red[h * 64 + 32 * lb + r] = ss[lb]; }
    __syncthreads();
    bf16_t* A2 = (bf16_t*)(P->ws + WS_A2); const float* gam = P->in[15];
    f32x4 gv[2][4];
#pragma unroll
    for (int pb = 0; pb < 2; ++pb)
#pragma unroll
        for (int gi = 0; gi < 4; ++gi) gv[pb][gi] = *(const f32x4*)(gam + h * 64 + 32 * pb + 8 * gi + 4 * h2);
#pragma unroll
    for (int pb = 0; pb < 2; ++pb)
#pragma unroll
        for (int gi = 0; gi < 4; ++gi) pin(gv[pb][gi]);
#pragma unroll
    for (int lb = 0; lb < 2; ++lb) {
        const int l = 32 * lb + r; float tot = 0.f;
#pragma unroll
        for (int hh = 0; hh < 8; ++hh) tot += red[hh * 64 + l];
        const float rs = 1.0f / sqrtf(tot * (1.f / 512.f) + 1e-5f);
        if (l < Lv) {
#pragma unroll
            for (int pb = 0; pb < 2; ++pb)
#pragma unroll
                for (int gi = 0; gi < 4; ++gi) { const int p0 = 32 * pb + 8 * gi + 4 * h2; const f32x4 g4 = gv[pb][gi];
                    u32x2 w; w.x = pk2(y[pb][lb][4 * gi] * rs * g4[0], y[pb][lb][4 * gi + 1] * rs * g4[1]); w.y = pk2(y[pb][lb][4 * gi + 2] * rs * g4[2], y[pb][lb][4 * gi + 3] * rs * g4[3]);
                    *(u32x2*)(A2 + (size_t)(r0 + l) * 1024 + 512 + h * 64 + p0) = w; }
        }
    }
}

constexpr int L_TBL = 0;
constexpr int L_ARED = 8 * 260 * 4;
constexpr int L_AQ = 16384;
DI void attn_tile(KP P, LAS unsigned char* lds, int ch) {
    int tid = threadIdx.x; asm volatile("" : "+v"(tid));
    const int lane = tid & 63, hd = __builtin_amdgcn_readfirstlane(tid >> 6), r = lane & 31, h2 = lane >> 5;
    const bool samp = ch >= 512;
    int Lq, jt_lo, nkeys, ngr; long qrow0; const bf16_t* Kb; const bf16_t* Vb;
    if (!samp) { const int b = ch >> 7, c = ch & 127; qrow0 = (long)ch * 64; Lq = 64; jt_lo = (c < 8) ? 8 - c : 0; nkeys = 576; ngr = 36;
        Kb = (const bf16_t*)(P->ws + WS_KP) + ((long)b * 8192 + (long)(c - 8) * 64) * 512 + hd * 64;
        Vb = (const bf16_t*)(P->ws + WS_VFP) + ((long)(b * 8 + hd) * 512 + (long)(c - 8) * 4) * 1024; }
    else { const int b = ch - 512; qrow0 = (long)MP + b * 32; Lq = 32; jt_lo = 0; nkeys = 544; ngr = 34;
        Kb = (const bf16_t*)(P->ws + WS_KS) + (long)b * 544 * 512 + hd * 64;
        Vb = (const bf16_t*)(P->ws + WS_VFS) + (long)(b * 8 + hd) * 34 * 1024; }
    __syncthreads();
    LAS float* tbl = (LAS float*)(lds + L_TBL) + hd * 260;
    for (int i = lane; i < 257; i += 64) tbl[i] = P->in[8][hd * 257 + i] * LOG2E;
    __syncthreads();
    const bf16_t* Q = (const bf16_t*)(P->ws + WS_Q);
    LAS unsigned char* qlds = lds + L_AQ + hd * 8192 + lane * 16;
    { bf16x8 qtmp[2][4];
#pragma unroll
      for (int qb = 0; qb < 2; ++qb) { int qi = 32 * qb + r; if (qi > Lq - 1) qi = Lq - 1;
#pragma unroll
          for (int s = 0; s < 4; ++s) qtmp[qb][s] = *(const bf16x8*)(Q + (size_t)(qrow0 + qi) * 512 + hd * 64 + 16 * s + 8 * h2); }
#pragma unroll
      for (int qb = 0; qb < 2; ++qb)
#pragma unroll
          for (int s = 0; s < 4; ++s) pin(qtmp[qb][s]);
#pragma unroll
      for (int qb = 0; qb < 2; ++qb)
#pragma unroll
          for (int s = 0; s < 4; ++s) *(LAS bf16x8*)(qlds + (qb * 4 + s) * 1024) = qtmp[qb][s]; }
    f32x16 o[2][2];
#pragma unroll
    for (int a = 0; a < 2; ++a)
#pragma unroll
        for (int b = 0; b < 2; ++b)
#pragma unroll
            for (int i = 0; i < 16; ++i) o[a][b][i] = 0.f;
    float mrun[2] = {-1e30f, -1e30f}, lrun[2] = {0.f, 0.f};
    const float SC = 0.125f * LOG2E;
    for (int jt = jt_lo; jt < 9; ++jt) {
        bf16x8 kf[2][4];
#pragma unroll
        for (int kb = 0; kb < 2; ++kb) {
            int kj = 64 * jt + 32 * kb + r; if (kj > nkeys - 1) kj = nkeys - 1;
#pragma unroll
            for (int s = 0; s < 4; ++s) kf[kb][s] = *(const bf16x8*)(Kb + (long)kj * 512 + 16 * s + 8 * h2);
        }
#pragma unroll
        for (int kb = 0; kb < 2; ++kb)
#pragma unroll
            for (int s = 0; s < 4; ++s) pin(kf[kb][s]);
        f32x16 st[2][2];
#pragma unroll
        for (int kb = 0; kb < 2; ++kb)
#pragma unroll
            for (int qb = 0; qb < 2; ++qb) {
#pragma unroll
                for (int i = 0; i < 16; ++i) st[kb][qb][i] = 0.f;
#pragma unroll
                for (int s = 0; s < 4; ++s) st[kb][qb] = MFMA32(kf[kb][s], *(const LAS bf16x8*)(qlds + (qb * 4 + s) * 1024), st[kb][qb]);
            }
        __builtin_amdgcn_sched_barrier(0);
        bf16x8 vf[2][2][2];
#pragma unroll
        for (int kb = 0; kb < 2; ++kb)
#pragma unroll
            for (int s2 = 0; s2 < 2; ++s2) {
                int gidx = 4 * jt + 2 * kb + s2; if (gidx > ngr - 1) gidx = ngr - 1;
#pragma unroll
                for (int db = 0; db < 2; ++db) vf[kb][s2][db] = *(const bf16x8*)(Vb + (long)gidx * 1024 + (h2 * 64 + 32 * db + r) * 8);
            }
        __builtin_amdgcn_sched_barrier(0);
        const bool far = (jt <= 5);
        const bool tailmask = samp && (jt == 8);
        const float bfar = tbl[256];
#pragma unroll
        for (int qb = 0; qb < 2; ++qb) {
            const int qi = 32 * qb + r;
            float mx = -1e30f;
#pragma unroll
            for (int kb = 0; kb < 2; ++kb)
#pragma unroll
                for (int i = 0; i < 16; ++i) {
                    const int kj = 64 * jt + 32 * kb + crow(i, h2);
                    float bias = bfar;
                    if (!far) { int rel = 512 + qi - kj; rel = rel > 128 ? 128 : rel; rel = rel < -128 ? -128 : rel; bias = tbl[rel + 128]; }
                    float sc = st[kb][qb][i] * SC + bias;
                    if (tailmask && kj >= nkeys) sc = -1e30f;
                    st[kb][qb][i] = sc; mx = fmaxf(mx, sc);
                }
            mx = fmaxf(mx, __shfl_xor(mx, 32));
            const float mnew = fmaxf(mrun[qb], mx), alpha = __builtin_amdgcn_exp2f(mrun[qb] - mnew);
            float ls = 0.f;
#pragma unroll
            for (int kb = 0; kb < 2; ++kb)
#pragma unroll
                for (int i = 0; i < 16; ++i) { const float p = __builtin_amdgcn_exp2f(st[kb][qb][i] - mnew); st[kb][qb][i] = p; ls += p; }
            ls += __shfl_xor(ls, 32);
            lrun[qb] = lrun[qb] * alpha + ls; mrun[qb] = mnew;
            if (__builtin_amdgcn_ballot_w64(alpha != 1.0f) != 0ull) {
#pragma unroll
                for (int db = 0; db < 2; ++db)
#pragma unroll
                    for (int i = 0; i < 16; ++i) o[db][qb][i] *= alpha;
            }
        }
#pragma unroll
        for (int kb = 0; kb < 2; ++kb)
#pragma unroll
            for (int s2 = 0; s2 < 2; ++s2) {
                bf16x8 pf[2];
#pragma unroll
                for (int qb = 0; qb < 2; ++qb) pf[qb] = pack8(st[kb][qb][8 * s2], st[kb][qb][8 * s2 + 1], st[kb][qb][8 * s2 + 2], st[kb][qb][8 * s2 + 3],
                                                               st[kb][qb][8 * s2 + 4], st[kb][qb][8 * s2 + 5], st[kb][qb][8 * s2 + 6], st[kb][qb][8 * s2 + 7]);
#pragma unroll
                for (int db = 0; db < 2; ++db)
#pragma unroll
                    for (int qb = 0; qb < 2; ++qb) o[db][qb] = MFMA32(vf[kb][s2][db], pf[qb], o[db][qb]);
            }
    }
    LAS float* red = (LAS float*)(lds + L_ARED);
#pragma unroll
    for (int qb = 0; qb < 2; ++qb) {
        const float il = 1.0f / lrun[qb]; float ss = 0.f;
#pragma unroll
        for (int db = 0; db < 2; ++db)
#pragma unroll
            for (int i = 0; i < 16; ++i) { const float v = o[db][qb][i] * il; o[db][qb][i] = v; ss += v * v; }
        ss += __shfl_xor(ss, 32);
        if (h2 == 0) red[hd * 64 + 32 * qb + r] = ss;
    }
    __syncthreads();
    bf16_t* A2 = (bf16_t*)(P->ws + WS_A2); const float* gam = P->in[9];
    f32x4 gv[2][4];
#pragma unroll
    for (int db = 0; db < 2; ++db)
#pragma unroll
        for (int gi = 0; gi < 4; ++gi) gv[db][gi] = *(const f32x4*)(gam + hd * 64 + 32 * db + 8 * gi + 4 * h2);
#pragma unroll
    for (int db = 0; db < 2; ++db)
#pragma unroll
        for (int gi = 0; gi < 4; ++gi) pin(gv[db][gi]);
#pragma unroll
    for (int qb = 0; qb < 2; ++qb) {
        const int qi = 32 * qb + r; float tot = 0.f;
#pragma unroll
        for (int hh = 0; hh < 8; ++hh) tot += red[hh * 64 + qi];
        const float rs = 1.0f / sqrtf(tot * (1.f / 512.f) + 1e-5f);
        if (qi < Lq) {
#pragma unroll
            for (int db = 0; db < 2; ++db)
#pragma unroll
                for (int gi = 0; gi < 4; ++gi) { const int d0 = 32 * db + 8 * gi + 4 * h2; const f32x4 g4 = gv[db][gi];
                    u32x2 w; w.x = pk2(o[db][qb][4 * gi] * rs * g4[0], o[db][qb][4 * gi + 1] * rs * g4[1]); w.y = pk2(o[db][qb][4 * gi + 2] * rs * g4[2], o[db][qb][4 * gi + 3] * rs * g4[3]);
                    *(u32x2*)(A2 + (size_t)(qrow0 + qi) * 1024 + hd * 64 + d0) = w; }
        }
    }
}

__global__ void __launch_bounds__(NT, 2) hybrid_fwd(Params PA) {
    extern __shared__ __attribute__((aligned(16))) unsigned char lds_raw[];
    LAS unsigned char* lds = (LAS unsigned char*)lds_raw;
    cg::grid_group grid = cg::this_grid();
    const int G = gridDim.x, bx = blockIdx.x;
    int wid_s = __builtin_amdgcn_readfirstlane(threadIdx.x >> 6); asm volatile("" : "+s"(wid_s));
#define TIDX() ({ unsigned z_ = 0u; asm volatile("" : "+s"(z_)); (wid_s << 6) | (int)__builtin_amdgcn_mbcnt_hi(~0u, __builtin_amdgcn_mbcnt_lo(~0u, z_)); })
#define KARGS() ({ KP p_ = (KP)__builtin_amdgcn_kernarg_segment_ptr(); asm volatile("" : "+s"(p_)); p_; })
    if (PA.out == nullptr) grid.sync();
    {
        volatile LAS unsigned* stw = (volatile LAS unsigned*)(lds + LDS_BYTES - 16);
        if (threadIdx.x == 0) { stw[0] = 0u; stw[1] = 0u; }
        __syncthreads();
    }
    const XcdBarrier gbar = xcd_barrier_post((unsigned*)(PA.ws + WS_BAR), (volatile LAS unsigned*)(lds + LDS_BYTES - 16));
#define GRID_SYNC() xcd_barrier(gbar, TIDX())

#ifndef PHASE_MASK
#define PHASE_MASK 0xFFFF
#endif
#ifndef REPEAT_MASK
#define REPEAT_MASK 0
#endif
#define PH(k) if (KP P = KARGS()) if (PHASE_MASK & (1 << (k))) for (int rep_ = 0; rep_ <= ((REPEAT_MASK >> (k)) & 1); ++rep_)
#ifndef NREP_ALL
#define NREP_ALL 1
#endif
    for (int outer_ = 0; outer_ < NREP_ALL; ++outer_) {
    if (outer_) GRID_SYNC();
    PH(0) phase_convert(P, lds);
    GRID_SYNC();
    PH(1) {
        pg8::AMapPlain am{(const void*)(P->ws + WS_XB), 2048}; pg8::Order S; S.init(128, 12, G, bx);
        EpiInProj E{P->out, P->ws};
        pg8::gemm_phase<EpiInProj, pg8::AMapPlain>(lds, am, (const void*)(P->ws + WS_WIN), 2048, S, E);
        small_inproj(P);
    }
    GRID_SYNC();
    PH(4) {
        unsigned* qctr = (unsigned*)(P->ws + WS_BAR) + 3584 + 64 * (rep_ + 2 * outer_);
        volatile LAS unsigned* slot = (volatile LAS unsigned*)(lds + LDS_BYTES - 32);
        constexpr int Q0 = LATE_WG_ITEMS, Q1 = Q0 + 480, Q2 = Q1 + 512, Q3 = Q2 + 32, Q4 = Q3 + 16, Q5 = Q4 + 16, Q6 = Q5 + 16;
        for (;;) {
            __syncthreads();
            if (threadIdx.x == 0) slot[0] = __hip_atomic_fetch_add(qctr, 1u, __ATOMIC_RELAXED, __HIP_MEMORY_SCOPE_AGENT);
            __syncthreads();
            const int it = (int)slot[0];
            if (it >= Q6) break;
            if (it < Q0) convert_late_item(P, lds, it);
            else if (it < Q1) { const int j = it - Q0; attn_tile(P, lds, (j / 120) * 128 + 8 + j % 120); }
            else if (it < Q2) ssd_states_tile(P, lds, it - Q1);
            else if (it < Q3) { const int j = it - Q2; attn_tile(P, lds, (j & 3) * 128 + 7 - (j >> 2)); }
            else if (it < Q4) ssd_out_tile(P, lds, 512 + it - Q3);
            else if (it < Q5) attn_tile(P, lds, 512 + it - Q4);
            else ssd_states_tile(P, lds, 512 + it - Q5);
        }
    }
    GRID_SYNC();
    PH(3) phase_scan(P, lds);
    GRID_SYNC();
    PH(5) for (int ch = bx; ch < 512; ch += G) ssd_out_tile(P, lds, ch);
    PH(5) phase_sample_state(P);
    GRID_SYNC();
    PH(6) {
        __syncthreads();
        pg8::AMapPlain am{(const void*)(P->ws + WS_A2), 2048}; pg8::Order S; S.init(128, 4, G, bx);
        EpiOutProj E{P->in[0], P->in[1], (bf16_t*)(P->out + O_Y)};
        pg8::gemm_phase<EpiOutProj, pg8::AMapPlain>(lds, am, (const void*)(P->ws + WS_WOUT), 2048, S, E);
        small_out_splitk(P, lds, TIDX());
    }
    GRID_SYNC();
    PH(7) phase_ln<true>((const bf16_t*)(P->out + O_Y), P->in[17], P->in[18], (void*)(P->ws + WS_XB), P->ws + WS_X1F8, P->ws + WS_G, TIDX());
    GRID_SYNC();
    PH(8) {
        pg8::Order S; S.init(132, 21, G, bx);
        pg8::AMapUp<126> am{(const void*)(P->ws + WS_X1F8), 1024};
        EpiUp<false> E{P->ws + WS_G, nullptr, P->in[20], P->in[21], P->in[6], nullptr};
        pg8::gemm_phase<EpiUp<false>, pg8::AMapUp<126>, true>(lds, am, (const void*)(P->ws + WS_WUP8), 1024, S, E);
        pg8::Order S2; S2.init(2, 21, G, (bx + G - (2772 % G)) % G);
        pg8::AMapUp<128> am2{(const void*)(P->ws + WS_XB), 2048};
        EpiUp<true> E2{nullptr, (bf16_t*)(P->ws + WS_GS), P->in[20], P->in[21], P->in[6], P->out + O_FCS};
        pg8::gemm_phase<EpiUp<true>, pg8::AMapUp<128>>(lds, am2, (const void*)(P->ws + WS_WUP), 2048, S2, E2);
        small_ffnconv_prompt(P, lds, TIDX());
    }
    GRID_SYNC();
    PH(9) {
        pg8::AMapPlain am{(const void*)(P->ws + WS_G), DFF * 2}; pg8::Order S; S.init(128, 4, G, bx);
        EpiDown E{(const bf16_t*)(P->ws + WS_XB), (bf16_t*)(P->ws + WS_A2)};
        pg8::gemm_phase<EpiDown, pg8::AMapPlain>(lds, am, (const void*)(P->ws + WS_WDOWN), DFF * 2, S, E);
        small_down_splitk(P, lds, TIDX());
    }
    GRID_SYNC();
    PH(10) phase_ln<false>((const bf16_t*)(P->ws + WS_A2), P->in[23], P->in[24], (void*)(P->out + O_Y), nullptr, nullptr, TIDX());
    }
}

extern "C" void kernel_launch(void* const* d_in, const int* in_sizes, int n_in, void* d_out, int out_size, void* d_ws, size_t ws_size, hipStream_t stream) {
    static int grid_blocks = 0;
    if (!grid_blocks) {
        int dev = 0, cus = 0, per_cu = 0;
        hipGetDevice(&dev);
        hipDeviceGetAttribute(&cus, hipDeviceAttributeMultiprocessorCount, dev);
        hipFuncSetAttribute((const void*)hybrid_fwd, hipFuncAttributeMaxDynamicSharedMemorySize, LDS_BYTES);
        hipOccupancyMaxActiveBlocksPerMultiprocessor(&per_cu, (const void*)hybrid_fwd, NT, LDS_BYTES);
        if (per_cu < 1) per_cu = 1;
        if (per_cu > 1) per_cu = 1;
        grid_blocks = cus * per_cu;
        if (ws_size < WS_END) fprintf(stderr, "kernel_launch: workspace too small: %zu < %zu\n", ws_size, (size_t)WS_END);
    }
    Params p{};
    for (int i = 0; i < 25; ++i) p.in[i] = (const float*)d_in[i];
    p.out = (float*)d_out; p.ws = (unsigned char*)d_ws;
    hipMemsetAsync((unsigned char*)d_ws + WS_BAR, 0, 16384, stream);
    void* args[] = {&p};
    hipError_t e = hipLaunchCooperativeKernel((const void*)hybrid_fwd, dim3(grid_blocks), dim3(NT), args, LDS_BYTES, stream);
    if (e != hipSuccess) fprintf(stderr, "cooperative launch failed: %s (grid %d)\n", hipGetErrorString(e), grid_blocks);
}
```

```cpp
#include <hip/hip_runtime.h>
#include <hip/hip_cooperative_groups.h>
#include <cstdio>
namespace cg = cooperative_groups;

#define LAS __attribute__((address_space(3)))
typedef unsigned short bf16_t;
typedef short bf16x8 __attribute__((ext_vector_type(8)));
typedef short s16x4 __attribute__((ext_vector_type(4)));
typedef float f32x2 __attribute__((ext_vector_type(2)));
typedef float f32x4 __attribute__((ext_vector_type(4)));
typedef float f32x16 __attribute__((ext_vector_type(16)));
typedef unsigned u32x2 __attribute__((ext_vector_type(2)));
typedef unsigned u32x4 __attribute__((ext_vector_type(4)));
typedef __bf16 bf2_t __attribute__((ext_vector_type(2)));
typedef int i32x4 __attribute__((ext_vector_type(4)));
typedef int i32x8 __attribute__((ext_vector_type(8)));
#define DI __device__ __forceinline__

constexpr int MP = 32768, MS = 512, MT = MP + MS;
constexpr int DM = 1024, NIN = 3080, NINP = 3328, DFF = 2688, NUP = 5376;
constexpr int NCHUNK = 528;
constexpr float ALPHA = 1.189207115002721f;
constexpr float LOG2E = 1.4426950408889634f;
constexpr int NT = 512;
constexpr int LDS_BYTES = 147456;
constexpr int GP8 = 2816;
constexpr float SC_X1 = 16.f, SC_WUP = 64.f, SC_G = 8.f, SC_WDN = 128.f;

constexpr size_t O_Y = 0;
constexpr size_t O_NKP = (size_t)MT * 1024;
constexpr size_t O_NVP = O_NKP + 1048576;
constexpr size_t O_NKS = O_NVP + 1048576;
constexpr size_t O_NVS = O_NKS + 262144;
constexpr size_t O_SSP = O_NVS + 262144;
constexpr size_t O_SSS = O_SSP + 262144;
constexpr size_t O_SCP = O_SSS + 1048576;
constexpr size_t O_SCS = O_SCP + 12288;
constexpr size_t O_FCP = O_SCS + 49152;
constexpr size_t O_FCS = O_FCP + 43008;

constexpr size_t al256(size_t x) { return (x + 255) & ~(size_t)255; }
constexpr size_t WS_WIN = 0;
constexpr size_t WS_WOUT = WS_WIN + al256((size_t)NINP * 1024 * 2);
constexpr size_t WS_WUP = WS_WOUT + al256((size_t)1024 * 1024 * 2);
constexpr size_t WS_WDOWN = WS_WUP + al256((size_t)NUP * 1024 * 2);
constexpr size_t WS_WUP8 = WS_WDOWN + al256((size_t)1024 * DFF * 2);
constexpr size_t WS_WDN8 = WS_WUP8 + al256((size_t)NUP * 1024);
constexpr size_t WS_GS = WS_WDN8 + al256((size_t)1024 * GP8);
constexpr size_t WS_DT = WS_GS + al256((size_t)MS * DFF * 2);
constexpr size_t WS_DEC = WS_DT + al256((size_t)MT * 8 * 4);
constexpr size_t WS_BAR = WS_DEC + al256((size_t)NCHUNK * 8 * 4);
constexpr size_t WS_XB = WS_BAR + 16384 + 8192;
constexpr size_t WS_R3 = WS_XB + al256((size_t)(MT + 256) * 1024 * 2);
constexpr size_t WS_G = WS_R3;
constexpr size_t WS_X1F8 = WS_R3 + al256((size_t)MP * DFF * 2) + 8192;
constexpr size_t WS_Q = WS_R3;
constexpr size_t WS_KP = WS_Q + al256((size_t)MT * 512 * 2);
constexpr size_t WS_KS = WS_KP + al256((size_t)MP * 512 * 2);
constexpr size_t WS_VFP = WS_KS + al256((size_t)16 * 544 * 512 * 2);
constexpr size_t WS_VFS = WS_VFP + al256((size_t)4 * 8 * 512 * 1024 * 2);
constexpr size_t WS_Z = WS_VFS + al256((size_t)16 * 8 * 34 * 1024 * 2) + 65536;
constexpr size_t WS_XBC = WS_Z + al256((size_t)MT * 512 * 2);
constexpr size_t WS_A2 = WS_XBC + al256((size_t)MT * 1024 * 2);
constexpr size_t WS_ST = WS_A2 + al256((size_t)MT * 1024 * 2);
constexpr size_t WS_END = WS_ST + al256((size_t)NCHUNK * 65536 * 2);
static_assert(WS_X1F8 + (size_t)(MT + 256) * 1024 <= WS_A2, "G8/X1F8 alias");
static_assert(WS_A2 + (size_t)MT * 1024 * 4 <= WS_END, "U2 alias");

struct Params {
    const float* in[25];
    float* out;
    unsigned char* ws;
};
typedef const __attribute__((address_space(4))) Params* KP;

DI unsigned pk2(float lo, float hi) { f32x2 f = {lo, hi}; return __builtin_bit_cast(unsigned, __builtin_convertvector(f, bf2_t)); }
DI unsigned pk4_f8(float a, float b, float c, float d) { int w = 0; w = __builtin_amdgcn_cvt_pk_fp8_f32(a, b, w, false); w = __builtin_amdgcn_cvt_pk_fp8_f32(c, d, w, true); return (unsigned)w; }
DI float bf_lo(unsigned w) { return __uint_as_float(w << 16); }
DI float bf_hi(unsigned w) { return __uint_as_float(w & 0xffff0000u); }
DI float silu_f(float x) { return x * __builtin_amdgcn_rcpf(1.0f + __builtin_amdgcn_exp2f(-x * LOG2E)); }
DI int crow(int reg, int h) { return (reg & 3) + 8 * (reg >> 2) + 4 * h; }
#define MFMA32(a, b, c) __builtin_amdgcn_mfma_f32_32x32x16_bf16((a), (b), (c), 0, 0, 0)
DI bf16x8 pack8(float a0, float a1, float a2, float a3, float a4, float a5, float a6, float a7) {
    u32x4 p; p.x = pk2(a0, a1); p.y = pk2(a2, a3); p.z = pk2(a4, a5); p.w = pk2(a6, a7); return __builtin_bit_cast(bf16x8, p);
}
DI void pin(bf16x8& v) { asm volatile("" : "+v"(v)); }
DI void pin(u32x2& v) { asm volatile("" : "+v"(v)); }
DI void pin(f32x4& v) { asm volatile("" : "+v"(v)); }
DI bf16x8 tr_frag(LAS unsigned char* lo, LAS unsigned char* hi) {
    s16x4 a = __builtin_amdgcn_ds_read_tr16_b64_v4i16((LAS s16x4*)lo);
    s16x4 b = __builtin_amdgcn_ds_read_tr16_b64_v4i16((LAS s16x4*)hi);
    return __builtin_shufflevector(a, b, 0, 1, 2, 3, 4, 5, 6, 7);
}


#define XB_TMO      128
#define XB_XCNT(j)  (256  + 64 * (j))
#define XB_XSUB(j)  (1280 + 64 * (j))
#define XB_XGEN(j)  (2304 + 64 * (j))
#define XB_TOP      3328
#define XB_TOPGEN   3392
#define XCD_BAR_WORDS 3456
#define XB_SPIN_CAP (1u << 20)
DI unsigned xb_ld(unsigned* p)              { return __hip_atomic_load(p, __ATOMIC_RELAXED, __HIP_MEMORY_SCOPE_AGENT); }
DI unsigned xb_add(unsigned* p, unsigned v) { return __hip_atomic_fetch_add(p, v, __ATOMIC_RELAXED, __HIP_MEMORY_SCOPE_AGENT); }
DI unsigned xb_xcc_id() { return (unsigned)__builtin_amdgcn_s_getreg((3 << 11) | 20) & 0xFu; }
#define XB_SPIN(cond, bar) do { unsigned _sp = 0; while (cond) { __builtin_amdgcn_s_sleep(1); \
    if ((++_sp & 255u) == 0u) { if (xb_ld(&(bar)[XB_TMO])) break; if (_sp > XB_SPIN_CAP) { atomicAdd(&(bar)[XB_TMO], 1u); break; } } } } while (0)
struct XcdBarrier { unsigned* bar; unsigned x; volatile LAS unsigned* st; };
DI XcdBarrier xcd_barrier_post(unsigned* bar, volatile LAS unsigned* st) {
    XcdBarrier b; b.bar = bar; b.x = xb_xcc_id(); b.st = st;
    if (threadIdx.x == 0) (void)xb_add(&bar[XB_XCNT(b.x)], 1u);
    return b;
}
DI void xcd_barrier_complete(unsigned* bar, unsigned x, unsigned& nloc, unsigned& nx) {
    const unsigned G = gridDim.x * gridDim.y * gridDim.z;
    unsigned sum, cnt, mine, sp = 0u;
    for (;;) {
        sum = 0u; cnt = 0u; mine = 0u;
#pragma unroll
        for (unsigned j = 0; j < 16; ++j) { const unsigned c = xb_ld(&bar[XB_XCNT(j)]); sum += c; cnt += (c > 0u) ? 1u : 0u; mine = (j == x) ? c : mine; }
        if (sum == G) break;
        __builtin_amdgcn_s_sleep(1);
        if ((++sp & 255u) == 0u) { if (xb_ld(&bar[XB_TMO])) break; if (sp > XB_SPIN_CAP) { atomicAdd(&bar[XB_TMO], 1u); break; } }
    }
    nloc = mine > 0u ? mine : 1u; nx = cnt > 0u ? cnt : 1u;
}
DI void xcd_barrier(const XcdBarrier& b, int tid_in) {
    asm volatile("s_waitcnt vmcnt(0)" ::: "memory");
    __syncthreads();
    if (tid_in == 0) {
        unsigned* bar = b.bar;
        __builtin_amdgcn_s_waitcnt(0);
        unsigned nloc = b.st[0], nx = b.st[1];
        if (nloc == 0u) { xcd_barrier_complete(bar, b.x, nloc, nx); b.st[0] = nloc; b.st[1] = nx; }
        const unsigned old = xb_add(&bar[XB_XSUB(b.x)], 1u);
        const unsigned gen = old / nloc;
        if (old + 1u == (gen + 1u) * nloc) {
            __builtin_amdgcn_fence(__ATOMIC_RELEASE, "agent");
            asm volatile("s_waitcnt vmcnt(0)" ::: "memory");
            const unsigned og = xb_add(&bar[XB_TOP], 1u);
            const unsigned tg = og / nx;
            if (og + 1u == (tg + 1u) * nx) xb_add(&bar[XB_TOPGEN], 1u);
            else XB_SPIN(xb_ld(&bar[XB_TOPGEN]) == tg, bar);
            __builtin_amdgcn_fence(__ATOMIC_ACQUIRE, "agent");
            xb_add(&bar[XB_XGEN(b.x)], 1u);
            asm volatile("s_waitcnt vmcnt(0)" ::: "memory");
        } else {
            XB_SPIN(xb_ld(&bar[XB_XGEN(b.x)]) == gen, bar);
            __builtin_amdgcn_fence(__ATOMIC_ACQUIRE, "agent");
            asm volatile("s_waitcnt vmcnt(0)" ::: "memory");
        }
    }
    __syncthreads();
}

namespace pg8 {
constexpr int BM = 256, BK = 64, HALF = 128, HTB = HALF * BK * 2, NXCD = 8, WGM = 8;
DI int lds_byte(int r, int c) { const int st = (r >> 4) * 2 + (c >> 5), rr = r & 15, cc = c & 31, ob = rr * 64 + cc * 2; return st * 1024 + (ob ^ (((ob >> 9) & 1) << 5)); }
DI void stage_rc(int b, int& R, int& C) { const int st = b / 1024, sb = b % 1024, swz = sb ^ (((sb >> 9) & 1) << 5); R = (st >> 1) * 16 + swz / 64; C = (st & 1) * 32 + (swz % 64) / 2; }
DI int perm32(int rho) { const int n = rho >> 4, i = rho & 15; return 8 * (i >> 2) + 4 * n + (i & 3); }
struct Unit { int pm, pn; };
struct Order {
    int nM, nN, nwg, G, c;
    DI void init(int nM_, int nN_, int G_, int c_) { nM = nM_; nN = nN_; nwg = nM * nN; G = G_; c = c_; }
    DI bool next(int i, Unit& u) const {
        const long L = (long)i * G + c; if (L >= nwg) return false;
        int wgid = (int)L; { const int q = nwg / NXCD, r = nwg % NXCD, xcd = wgid % NXCD, off = wgid / NXCD; wgid = (xcd < r ? xcd * (q + 1) : r * (q + 1) + (xcd - r) * q) + off; }
        const int nig = WGM * nN, gid = wgid / nig, fm = gid * WGM, gsz = (nM - fm) < WGM ? (nM - fm) : WGM;
        u.pm = fm + ((wgid % nig) % gsz); u.pn = (wgid % nig) / gsz; return true;
    }
};
struct AMapPlain {
    const void* A; int pitch;
    DI const char* unit_base(int pm) const { return (const char*)A + (size_t)pm * 256 * pitch; }
    DI size_t hstep() const { return (size_t)HALF * pitch; }
    DI unsigned voff(int R, int Cb) const { return (unsigned)(R * pitch + Cb); }
};
template <int WRS> struct AMapUp {
    const void* A; int pitch;
    DI const char* unit_base(int pm) const {
        if (WRS == 126) { const int b = pm / 33, ti = pm - b * 33; return (const char*)A + ((long)b * 8192 + ti * 252 - 2) * pitch; }
        return (const char*)A + ((long)MP + pm * 256) * pitch;
    }
    DI size_t hstep() const { return (size_t)4 * pitch; }
    DI unsigned voff(int R, int Cb) const { return (unsigned)((((R >> 6) * WRS + (R & 15) * 8 + ((R >> 4) & 3)) * pitch) + Cb); }
};

template <class Epi, class AMap, bool F8 = false>
DI void gemm_phase(LAS unsigned char* lds, const AMap am, const void* Bt, const int Kb, const Order& S, const Epi& E) {
    int tid = threadIdx.x; asm volatile("" : "+v"(tid));
    const int wid = __builtin_amdgcn_readfirstlane(tid >> 6), lane = tid & 63, wr = wid >> 2, wc = wid & 3, fr = lane & 15, fq = lane >> 4;
    const int nt = Kb / 128;
    unsigned voffA, voffB; size_t dA2, dB2;
    { int R, C; stage_rc(tid * 16, R, C); const int Rb = Epi::PERM ? ((R & ~31) + perm32(R & 31)) : R;
      voffA = am.voff(R, 2 * C); voffB = (unsigned)(Rb * Kb + 2 * C); dA2 = (size_t)(am.voff(64, 0) - am.voff(0, 0)); dB2 = (size_t)64 * Kb; }
    const size_t kstep = (size_t)128;
    const size_t hstepA = am.hstep();
    const size_t hstepB = (size_t)HALF * Kb;
    const size_t tstepB = 2 * hstepB;
    const unsigned ldsw = (unsigned)wid * 1024u;
    constexpr int QOFF = F8 ? 16 : 1024;
    const int aoff = F8 ? lds_byte(wr * 64 + fr, 16 * (fq & 1)) + 1024 * (fq >> 1) : lds_byte(wr * 64 + fr, fq * 8);
    const int boff = F8 ? lds_byte(wc * 32 + fr, 16 * (fq & 1)) + 1024 * (fq >> 1) : lds_byte(wc * 32 + fr, fq * 8);
#define PG8_SA(b, h) (((b) * 2 + (h)) * HTB)
#define PG8_SB(b, h) ((4 + (b) * 2 + (h)) * HTB)
#define PG8_STAGE(bufoff, gbase, voff) do { \
        __builtin_amdgcn_global_load_lds((const unsigned*)((const char*)(gbase) + (voff)), (LAS unsigned*)(lds + (bufoff) + ldsw), 16, 0, 0); \
        __builtin_amdgcn_global_load_lds((const unsigned*)((const char*)(gbase) + d2_##voff + (voff)), (LAS unsigned*)(lds + (bufoff) + ldsw + 8192), 16, 0, 0); } while (0)
#define d2_voffA dA2
#define d2_voffB dB2
#define PG8_LDA(dst, b, h) do { _Pragma("unroll") for (int m = 0; m < 4; ++m) { const i32x4 lo_ = *(const LAS i32x4*)(lds + PG8_SA(b, h) + aoff + m * 2048), hi_ = *(const LAS i32x4*)(lds + PG8_SA(b, h) + aoff + QOFF + m * 2048); \
        dst[m] = __builtin_shufflevector(lo_, hi_, 0, 1, 2, 3, 4, 5, 6, 7); } } while (0)
#define PG8_LDB(dst, b, h) do { _Pragma("unroll") for (int n = 0; n < 2; ++n) { const i32x4 lo_ = *(const LAS i32x4*)(lds + PG8_SB(b, h) + boff + n * 2048), hi_ = *(const LAS i32x4*)(lds + PG8_SB(b, h) + boff + QOFF + n * 2048); \
        dst[n] = __builtin_shufflevector(lo_, hi_, 0, 1, 2, 3, 4, 5, 6, 7); } } while (0)
#define PG8_HALF(v, k) __builtin_bit_cast(bf16x8, __builtin_shufflevector(v, v, 4 * (k), 4 * (k) + 1, 4 * (k) + 2, 4 * (k) + 3))
#define PG8_MMA(ai, bj, At, Bt_) do { __builtin_amdgcn_s_setprio(1); _Pragma("unroll") for (int m = 0; m < 4; ++m) _Pragma("unroll") for (int n = 0; n < 2; ++n) { \
        if (F8) acc[ai][bj][m][n] = __builtin_amdgcn_mfma_scale_f32_16x16x128_f8f6f4(Bt_[n], At[m], acc[ai][bj][m][n], 0, 0, 0, 0, 0, 0); \
        else { acc[ai][bj][m][n] = __builtin_amdgcn_mfma_f32_16x16x32_bf16(PG8_HALF(Bt_[n], 0), PG8_HALF(At[m], 0), acc[ai][bj][m][n], 0, 0, 0); \
               acc[ai][bj][m][n] = __builtin_amdgcn_mfma_f32_16x16x32_bf16(PG8_HALF(Bt_[n], 1), PG8_HALF(At[m], 1), acc[ai][bj][m][n], 0, 0, 0); } } \
        __builtin_amdgcn_s_setprio(0); } while (0)
#define PG8_WAIT_V(n) asm volatile("s_waitcnt vmcnt(" #n ")" ::: "memory")
#define PG8_WAIT_L(n) asm volatile("s_waitcnt lgkmcnt(" #n ")" ::: "memory")
#define PG8_BAR __builtin_amdgcn_s_barrier()
#define PG8_SCHED __builtin_amdgcn_sched_barrier(0)
    Unit cur, nxt; int ui = 0;
    if (!S.next(0, cur)) return;
    f32x4 acc[2][2][4][2];
#pragma unroll
    for (int a = 0; a < 2; ++a)
#pragma unroll
        for (int b = 0; b < 2; ++b)
#pragma unroll
            for (int m = 0; m < 4; ++m)
#pragma unroll
                for (int n = 0; n < 2; ++n) acc[a][b][m][n] = (f32x4){0.f, 0.f, 0.f, 0.f};
    i32x8 At[4], B0[2], B1[2];
    const char* cA = am.unit_base(cur.pm); const char* cB = (const char*)Bt + (size_t)cur.pn * tstepB;
    PG8_STAGE(PG8_SB(0, 0), cB, voffB); PG8_STAGE(PG8_SA(0, 0), cA, voffA); PG8_STAGE(PG8_SB(0, 1), cB + hstepB, voffB); PG8_STAGE(PG8_SA(0, 1), cA + hstepA, voffA);
    if (wr == 1) PG8_BAR;
    PG8_WAIT_V(4); PG8_BAR;
    PG8_STAGE(PG8_SB(1, 0), cB + kstep, voffB); PG8_STAGE(PG8_SA(1, 0), cA + kstep, voffA); PG8_STAGE(PG8_SB(1, 1), cB + hstepB + kstep, voffB);
    PG8_WAIT_V(6); PG8_BAR;
    for (;;) {
        const bool has_next = S.next(ui + 1, nxt);
        const char* nA = has_next ? am.unit_base(nxt.pm) : cA; const char* nB = has_next ? (const char*)Bt + (size_t)nxt.pn * tstepB : cB;
        for (int t = 0; t < nt; t += 2) {
            const bool last = (t == nt - 2);
            const char* a1 = cA + (size_t)(t + 1) * kstep;
            const char* a2 = last ? nA : cA + (size_t)(t + 2) * kstep; const char* b2 = last ? nB : cB + (size_t)(t + 2) * kstep;
            const char* a3 = a2 + kstep; const char* b3 = b2 + kstep;
            PG8_LDB(B0, 0, 0); PG8_SCHED; PG8_LDA(At, 0, 0); PG8_STAGE(PG8_SA(1, 1), a1 + hstepA, voffA);
            PG8_WAIT_L(8); PG8_BAR; PG8_WAIT_L(0); PG8_MMA(0, 0, At, B0); PG8_BAR; PG8_SCHED;
            PG8_LDB(B1, 0, 1); PG8_STAGE(PG8_SB(0, 0), b2, voffB);
            PG8_BAR; PG8_WAIT_L(0); PG8_MMA(0, 1, At, B1); PG8_BAR;
            PG8_LDA(At, 0, 1); PG8_STAGE(PG8_SA(0, 0), a2, voffA);
            PG8_BAR; PG8_WAIT_L(0); PG8_MMA(1, 0, At, B0); PG8_BAR; PG8_SCHED;
            PG8_STAGE(PG8_SB(0, 1), b2 + hstepB, voffB);
            PG8_WAIT_V(6); PG8_BAR; PG8_MMA(1, 1, At, B1); PG8_BAR;
            PG8_LDB(B0, 1, 0); PG8_SCHED; PG8_LDA(At, 1, 0); PG8_STAGE(PG8_SA(0, 1), a2 + hstepA, voffA);
            PG8_WAIT_L(8); PG8_BAR; PG8_WAIT_L(0); PG8_MMA(0, 0, At, B0); PG8_BAR; PG8_SCHED;
            PG8_LDB(B1, 1, 1); PG8_STAGE(PG8_SB(1, 0), b3, voffB);
            PG8_BAR; PG8_WAIT_L(0); PG8_MMA(0, 1, At, B1); PG8_BAR;
            PG8_LDA(At, 1, 1); PG8_STAGE(PG8_SA(1, 0), a3, voffA);
            PG8_BAR; PG8_WAIT_L(0); PG8_MMA(1, 0, At, B0); PG8_BAR; PG8_SCHED;
            PG8_STAGE(PG8_SB(1, 1), b3 + hstepB, voffB);
            PG8_WAIT_V(6); PG8_BAR; PG8_MMA(1, 1, At, B1); PG8_BAR;
        }
        { unsigned z_ = 0u; asm volatile("" : "+s"(z_)); int l2_ = (int)__builtin_amdgcn_mbcnt_hi(~0u, __builtin_amdgcn_mbcnt_lo(~0u, z_)); asm volatile("" : "+v"(l2_));
          E(acc, cur, wr, wc, l2_ & 15, l2_ >> 4); }
        if (!has_next) break;
#pragma unroll
        for (int a = 0; a < 2; ++a)
#pragma unroll
            for (int b = 0; b < 2; ++b)
#pragma unroll
                for (int m = 0; m < 4; ++m)
#pragma unroll
                    for (int n = 0; n < 2; ++n) acc[a][b][m][n] = (f32x4){0.f, 0.f, 0.f, 0.f};
        cur = nxt; cA = nA; cB = nB; ++ui;
    }
    PG8_WAIT_V(0);
    if (wr == 0) PG8_BAR;
    PG8_BAR;
#undef PG8_SA
#undef PG8_SB
#undef PG8_STAGE
#undef d2_voffA
#undef d2_voffB
#undef PG8_LDA
#undef PG8_LDB
#undef PG8_HALF
#undef PG8_MMA
#undef PG8_WAIT_V
#undef PG8_WAIT_L
#undef PG8_BAR
#undef PG8_SCHED
}
}

typedef f32x4 AccT[2][2][4][2];

struct EpiInProj {
    static constexpr bool PERM = true;
    float* out; unsigned char* ws;
    DI void operator()(const AccT& acc, const pg8::Unit& u, int wr, int wc, int fr, int fq) const {
        const int pn = u.pn, r0 = u.pm * 256 + wr * 64 + fr, ct = wc * 32 + 8 * fq;
        const bool samp = u.pm >= 128;
        if (pn == 12) {
            if (wc == 0 && fq == 0) {
                float* DT = (float*)(ws + WS_DT);
#pragma unroll
                for (int ai = 0; ai < 2; ++ai)
#pragma unroll
                    for (int m = 0; m < 4; ++m) { const int row = r0 + ai * 128 + m * 16;
                        *(f32x4*)(DT + (size_t)row * 8) = acc[ai][0][m][0]; *(f32x4*)(DT + (size_t)row * 8 + 4) = acc[ai][0][m][1]; }
            }
            return;
        }
#pragma unroll
        for (int ai = 0; ai < 2; ++ai)
#pragma unroll
            for (int m = 0; m < 4; ++m) {
                const int row = r0 + ai * 128 + m * 16;
                const int rs = row - MP, sb = rs >> 5, st = rs & 31;
                const int pb = row >> 13, pt = row & 8191;
#pragma unroll
                for (int bj = 0; bj < 2; ++bj) {
                    const f32x4 v0 = acc[ai][bj][m][0], v1 = acc[ai][bj][m][1];
                    u32x4 w; w.x = pk2(v0[0], v0[1]); w.y = pk2(v0[2], v0[3]); w.z = pk2(v1[0], v1[1]); w.w = pk2(v1[2], v1[3]);
                    const int ctile = bj * 128 + ct;
                    if (pn < 2) {
                        *(u32x4*)((bf16_t*)(ws + WS_Q) + (size_t)row * 512 + pn * 256 + ctile) = w;
                    } else if (pn < 4) {
                        const int col = (pn - 2) * 256 + ctile;
                        if (!samp) {
                            *(u32x4*)((bf16_t*)(ws + WS_KP) + (size_t)row * 512 + col) = w;
                            if (pt >= 7680) { float* o = out + O_NKP + ((size_t)(pb * 512 + pt - 7680)) * 512 + col; *(f32x4*)o = v0; *(f32x4*)(o + 4) = v1; }
                        } else {
                            *(u32x4*)((bf16_t*)(ws + WS_KS) + ((size_t)sb * 544 + 512 + st) * 512 + col) = w;
                            float* o = out + O_NKS + (size_t)rs * 512 + col; *(f32x4*)o = v0; *(f32x4*)(o + 4) = v1;
                        }
                    } else if (pn < 6) {
                        const int col = (pn - 4) * 256 + ctile, head = col >> 6, d0 = col & 63;
                        bf16_t* vb; int t;
                        if (!samp) { t = pt; vb = (bf16_t*)(ws + WS_VFP) + ((size_t)(pb * 8 + head) * 512 + (t >> 4)) * 1024;
                            if (pt >= 7680) { float* o = out + O_NVP + ((size_t)(pb * 512 + pt - 7680)) * 512 + col; *(f32x4*)o = v0; *(f32x4*)(o + 4) = v1; } }
                        else { t = 512 + st; vb = (bf16_t*)(ws + WS_VFS) + ((size_t)(sb * 8 + head) * 34 + (t >> 4)) * 1024;
                            float* o = out + O_NVS + (size_t)rs * 512 + col; *(f32x4*)o = v0; *(f32x4*)(o + 4) = v1; }
                        const int tt = t & 15, hh = (tt >> 2) & 1, jj = ((tt >> 3) << 2) | (tt & 3);
                        bf16_t* p = vb + (hh * 64 + d0) * 8 + jj;
                        p[0] = (bf16_t)(w.x & 0xffff); p[8] = (bf16_t)(w.x >> 16); p[16] = (bf16_t)(w.y & 0xffff); p[24] = (bf16_t)(w.y >> 16);
                        p[32] = (bf16_t)(w.z & 0xffff); p[40] = (bf16_t)(w.z >> 16); p[48] = (bf16_t)(w.w & 0xffff); p[56] = (bf16_t)(w.w >> 16);
                    } else if (pn < 8) {
                        *(u32x4*)((bf16_t*)(ws + WS_Z) + (size_t)row * 512 + (pn - 6) * 256 + ctile) = w;
                    } else {
                        const int col = (pn - 8) * 256 + ctile;
                        *(u32x4*)((bf16_t*)(ws + WS_XBC) + (size_t)row * 1024 + col) = w;
                        if (!samp) { if (pt >= 8189) { float* o = out + O_SCP + ((size_t)(pb * 3 + pt - 8189)) * 1024 + col; *(f32x4*)o = v0; *(f32x4*)(o + 4) = v1; } }
                        else { if (st >= 29) { float* o = out + O_SCS + ((size_t)(sb * 3 + st - 29)) * 1024 + col; *(f32x4*)o = v0; *(f32x4*)(o + 4) = v1; } }
                    }
                }
            }
    }
};

struct EpiOutProj {
    static constexpr bool PERM = false;
    const float* xp; const float* xs; bf16_t* U;
    DI void operator()(const AccT& acc, const pg8::Unit& u, int wr, int wc, int fr, int fq) const {
        const int r0 = u.pm * 256 + wr * 64 + fr, c0 = u.pn * 256 + wc * 32 + 4 * fq;
#pragma unroll
        for (int ai = 0; ai < 2; ++ai) {
            f32x4 xv[4][2][2];
#pragma unroll
            for (int m = 0; m < 4; ++m) { const int row = r0 + ai * 128 + m * 16; const float* xr = (row < MP) ? xp + (size_t)row * 1024 : xs + (size_t)(row - MP) * 1024;
#pragma unroll
                for (int bj = 0; bj < 2; ++bj)
#pragma unroll
                    for (int n = 0; n < 2; ++n) xv[m][bj][n] = __builtin_nontemporal_load((const f32x4*)(xr + c0 + bj * 128 + n * 16)); }
#pragma unroll
            for (int m = 0; m < 4; ++m)
#pragma unroll
                for (int bj = 0; bj < 2; ++bj)
#pragma unroll
                    for (int n = 0; n < 2; ++n) pin(xv[m][bj][n]);
#pragma unroll
            for (int m = 0; m < 4; ++m) { const int row = r0 + ai * 128 + m * 16; bf16_t* ur = U + (size_t)row * 1024;
#pragma unroll
                for (int bj = 0; bj < 2; ++bj)
#pragma unroll
                    for (int n = 0; n < 2; ++n) { const f32x4 o = xv[m][bj][n] * ALPHA + acc[ai][bj][m][n];
                        u32x2 w; w.x = pk2(o[0], o[1]); w.y = pk2(o[2], o[3]); *(u32x2*)(ur + c0 + bj * 128 + n * 16) = w; } }
        }
    }
};
struct EpiDown {
    static constexpr bool PERM = false;
    const bf16_t* X1; bf16_t* U;
    DI void operator()(const AccT& acc, const pg8::Unit& u, int wr, int wc, int fr, int fq) const {
        const int r0 = u.pm * 256 + wr * 64 + fr, c0 = u.pn * 256 + wc * 32 + 4 * fq;
        u32x2 xw[2][4][2][2];
#pragma unroll
        for (int ai = 0; ai < 2; ++ai)
#pragma unroll
            for (int m = 0; m < 4; ++m) { const bf16_t* xr = X1 + (size_t)(r0 + ai * 128 + m * 16) * 1024;
#pragma unroll
                for (int bj = 0; bj < 2; ++bj)
#pragma unroll
                    for (int n = 0; n < 2; ++n) xw[ai][m][bj][n] = *(const u32x2*)(xr + c0 + bj * 128 + n * 16); }
#pragma unroll
        for (int ai = 0; ai < 2; ++ai)
#pragma unroll
            for (int m = 0; m < 4; ++m)
#pragma unroll
                for (int bj = 0; bj < 2; ++bj)
#pragma unroll
                    for (int n = 0; n < 2; ++n) pin(xw[ai][m][bj][n]);
#pragma unroll
        for (int ai = 0; ai < 2; ++ai)
#pragma unroll
            for (int m = 0; m < 4; ++m) { bf16_t* ur = U + (size_t)(r0 + ai * 128 + m * 16) * 1024;
#pragma unroll
                for (int bj = 0; bj < 2; ++bj)
#pragma unroll
                    for (int n = 0; n < 2; ++n) { const u32x2 w = xw[ai][m][bj][n];
                        const f32x4 xv = {bf_lo(w.x), bf_hi(w.x), bf_lo(w.y), bf_hi(w.y)}; const f32x4 o = xv * ALPHA + acc[ai][bj][m][n];
                        u32x2 wo; wo.x = pk2(o[0], o[1]); wo.y = pk2(o[2], o[3]); *(u32x2*)(ur + c0 + bj * 128 + n * 16) = wo; } }
    }
};

DI float dpp_shr1(float v) { return __builtin_bit_cast(float, __builtin_amdgcn_update_dpp(0, __builtin_bit_cast(int, v), 0x111, 0xf, 0xf, false)); }
template <bool SAMP> struct EpiUp {
    static constexpr bool PERM = true;
    unsigned char* G8; bf16_t* GS; const float* cw; const float* cb; const float* past; float* onf;
    DI void operator()(const AccT& acc, const pg8::Unit& u, int wr, int wc, int fr, int fq) const {
        const int colv = u.pn * 128 + wc * 32 + 8 * fq;
        int bb, tb; long grow0;
        if (!SAMP) { bb = u.pm / 33; const int ti = u.pm - bb * 33; tb = ti * 252 + wr * 126 + fr * 8 - 2; grow0 = (long)bb * 8192 + tb; }
        else { const int lg = wr * 16 + fr; bb = u.pm * 8 + (lg >> 2); tb = (lg & 3) * 8; grow0 = (long)bb * 32 + tb; }
        const bool first = SAMP ? ((fr & 3) == 0) : (fr == 0);
        const float asc = SAMP ? 1.0f : 1.0f / (SC_X1 * SC_WUP);
#pragma unroll
        for (int n = 0; n < 2; ++n) {
            const int cv = colv + 4 * n, cgt = DFF + cv;
            const f32x4 wv0 = *(const f32x4*)(cw + cv), wv1 = *(const f32x4*)(cw + NUP + cv), wv2 = *(const f32x4*)(cw + 2 * NUP + cv), bv = *(const f32x4*)(cb + cv);
            const f32x4 wg0 = *(const f32x4*)(cw + cgt), wg1 = *(const f32x4*)(cw + NUP + cgt), wg2 = *(const f32x4*)(cw + 2 * NUP + cgt), bg = *(const f32x4*)(cb + cgt);
            f32x4 hv[8], hg[8];
#pragma unroll
            for (int tau = 0; tau < 8; ++tau) { hv[tau] = acc[tau >> 2][0][tau & 3][n] * asc; hg[tau] = acc[tau >> 2][1][tau & 3][n] * asc; }
            if (SAMP) {
                if ((fr & 3) == 3) { float* o = onf + ((size_t)(bb * 2)) * NUP; *(f32x4*)(o + cv) = hv[6]; *(f32x4*)(o + cgt) = hg[6]; *(f32x4*)(o + NUP + cv) = hv[7]; *(f32x4*)(o + NUP + cgt) = hg[7]; }
            }
            if (!SAMP) { if (tb < 0) { hv[0] = (f32x4){0.f, 0.f, 0.f, 0.f}; hv[1] = hv[0]; hg[0] = hv[0]; hg[1] = hv[0]; } }
            f32x4 pv2, pv1, pg2, pg1;
#pragma unroll
            for (int j = 0; j < 4; ++j) { pv2[j] = dpp_shr1(hv[6][j]); pv1[j] = dpp_shr1(hv[7][j]); pg2[j] = dpp_shr1(hg[6][j]); pg1[j] = dpp_shr1(hg[7][j]); }
            if (SAMP) { if (first) { const float* ps = past + (size_t)bb * 2 * NUP; pv2 = *(const f32x4*)(ps + cv); pv1 = *(const f32x4*)(ps + NUP + cv); pg2 = *(const f32x4*)(ps + cgt); pg1 = *(const f32x4*)(ps + NUP + cgt); } }
#pragma unroll
            for (int tau = 0; tau < 8; ++tau) {
                const f32x4 a2v = (tau >= 2) ? hv[tau >= 2 ? tau - 2 : 0] : (tau == 0 ? pv2 : pv1);
                const f32x4 a1v = (tau >= 1) ? hv[tau >= 1 ? tau - 1 : 0] : pv1;
                const f32x4 a2g = (tau >= 2) ? hg[tau >= 2 ? tau - 2 : 0] : (tau == 0 ? pg2 : pg1);
                const f32x4 a1g = (tau >= 1) ? hg[tau >= 1 ? tau - 1 : 0] : pg1;
                const f32x4 ov = bv + wv0 * a2v + wv1 * a1v + wv2 * hv[tau];
                const f32x4 og = bg + wg0 * a2g + wg1 * a1g + wg2 * hg[tau];
                const float g0 = ov[0] * silu_f(og[0]), g1 = ov[1] * silu_f(og[1]), g2 = ov[2] * silu_f(og[2]), g3 = ov[3] * silu_f(og[3]);
                if (!SAMP) { const int t = tb + tau; const bool ok = (t >= 0) && (t < 8192) && (fr > 0 || tau >= 2);
                    const unsigned off = ok ? (unsigned)(((int)grow0 + tau) * DFF + cv) * 2u : (unsigned)((size_t)MP * DFF * 2) + (unsigned)(fr + 16 * fq) * 8u;
                    u32x2 w; w.x = pk2(g0, g1); w.y = pk2(g2, g3); *(u32x2*)(G8 + off) = w; }
                else { u32x2 w; w.x = pk2(g0, g1); w.y = pk2(g2, g3); *(u32x2*)(GS + (size_t)(grow0 + tau) * DFF + cv) = w; }
            }
        }
    }
};

DI f32x16 small_block_p(const bf16_t* xp, const bf16_t* wp, int K);
DI f32x16 small_block(const bf16_t* X, const bf16_t* Wt, int K, int row0, int col0, int lane) {
    const int r = lane & 31, h2 = lane >> 5;
    return small_block_p(X + (size_t)(row0 + r) * K + 8 * h2, Wt + (size_t)(col0 + r) * K + 8 * h2, K);
}
DI f32x16 small_block_p(const bf16_t* xp, const bf16_t* wp, int K) {
    f32x16 acc;
#pragma unroll
    for (int i = 0; i < 16; ++i) acc[i] = 0.f;
    int k0 = 0;
#pragma unroll 1
    for (; k0 + 256 <= K; k0 += 256) {
        bf16x8 a[16], b[16];
#pragma unroll
        for (int j = 0; j < 16; ++j) { a[j] = *(const bf16x8*)(wp + k0 + 16 * j); b[j] = *(const bf16x8*)(xp + k0 + 16 * j); }
#pragma unroll
        for (int j = 0; j < 16; ++j) { pin(a[j]); pin(b[j]); }
#pragma unroll
        for (int j = 0; j < 16; ++j) acc = MFMA32(a[j], b[j], acc);
    }
    if (k0 < K) {
        bf16x8 a[8], b[8];
#pragma unroll
        for (int j = 0; j < 8; ++j) { a[j] = *(const bf16x8*)(wp + k0 + 16 * j); b[j] = *(const bf16x8*)(xp + k0 + 16 * j); }
#pragma unroll
        for (int j = 0; j < 8; ++j) { pin(a[j]); pin(b[j]); }
#pragma unroll
        for (int j = 0; j < 8; ++j) acc = MFMA32(a[j], b[j], acc);
    }
    return acc;
}
DI void small_inproj(KP P) {
    int tid = threadIdx.x; asm volatile("" : "+v"(tid));
    const int lane = tid & 63, wave = tid >> 6, gw = blockIdx.x * 8 + wave, NGW = gridDim.x * 8, r = lane & 31, h2 = lane >> 5;
    const bf16_t* XB = (const bf16_t*)(P->ws + WS_XB); const bf16_t* WI = (const bf16_t*)(P->ws + WS_WIN);
    float* DT = (float*)(P->ws + WS_DT); float* out = P->out;
    for (int task = gw; task < 1024 + 16 * 97; task += NGW) {
        if (task < 1024) {
            const f32x16 acc = small_block(XB, WI, 1024, task * 32, 3072, lane);
            *(f32x4*)(DT + (size_t)(task * 32 + r) * 8 + 4 * h2) = (f32x4){acc[0], acc[1], acc[2], acc[3]};
            continue;
        }
        const int t2 = task - 1024, sb = t2 / 97, cb = t2 - sb * 97, row = MP + sb * 32 + r, col0 = cb * 32;
        const f32x16 acc = small_block(XB, WI, 1024, MP + sb * 32, col0, lane);
#pragma unroll
        for (int g = 0; g < 4; ++g) {
            const int col = col0 + 8 * g + 4 * h2; const f32x4 v = {acc[4 * g], acc[4 * g + 1], acc[4 * g + 2], acc[4 * g + 3]};
            u32x2 w; w.x = pk2(v[0], v[1]); w.y = pk2(v[2], v[3]);
            if (col < 512) *(u32x2*)((bf16_t*)(P->ws + WS_Q) + (size_t)row * 512 + col) = w;
            else if (col < 1024) { *(u32x2*)((bf16_t*)(P->ws + WS_KS) + ((size_t)sb * 544 + 512 + r) * 512 + col - 512) = w; *(f32x4*)(out + O_NKS + (size_t)(sb * 32 + r) * 512 + col - 512) = v; }
            else if (col < 1536) { const int c = col - 1024, head = c >> 6, d0 = c & 63, t = 512 + r, tt = t & 15, hh = (tt >> 2) & 1, jj = ((tt >> 3) << 2) | (tt & 3);
                bf16_t* p = (bf16_t*)(P->ws + WS_VFS) + ((size_t)(sb * 8 + head) * 34 + (t >> 4)) * 1024 + (hh * 64 + d0) * 8 + jj;
                p[0] = (bf16_t)(w.x & 0xffff); p[8] = (bf16_t)(w.x >> 16); p[16] = (bf16_t)(w.y & 0xffff); p[24] = (bf16_t)(w.y >> 16);
                *(f32x4*)(out + O_NVS + (size_t)(sb * 32 + r) * 512 + c) = v; }
            else if (col < 2048) *(u32x2*)((bf16_t*)(P->ws + WS_Z) + (size_t)row * 512 + col - 1536) = w;
            else if (col < 3072) { *(u32x2*)((bf16_t*)(P->ws + WS_XBC) + (size_t)row * 1024 + col - 2048) = w;
                if (r >= 29) *(f32x4*)(out + O_SCS + ((size_t)(sb * 3 + r - 29)) * 1024 + col - 2048) = v; }
            else if (col < 3080) *(f32x4*)(DT + (size_t)row * 8 + col - 3072) = v;
        }
    }
}
DI void small_down_splitk(KP P, LAS unsigned char* lds, int tid_in) {
    int tid = tid_in; asm volatile("" : "+v"(tid));
    const int lane = tid & 63, wave = __builtin_amdgcn_readfirstlane(tid >> 6), r = lane & 31, h2 = lane >> 5;
    const int tl = wave / 3, kq = wave - 3 * tl;
    const bf16_t* X = (const bf16_t*)(P->ws + WS_GS); const bf16_t* Wt = (const bf16_t*)(P->ws + WS_WDOWN);
    LAS float* part = (LAS float*)lds;
    for (int pair = blockIdx.x; pair < 256; pair += gridDim.x) {
        const int task = pair * 2 + tl, sb = task >> 5, cb = task & 31, col0 = cb * 32;
        __syncthreads();
        if (tl < 2) {
            const f32x16 acc = small_block_p(X + (size_t)(sb * 32 + r) * DFF + kq * 896 + 8 * h2, Wt + (size_t)(col0 + r) * DFF + kq * 896 + 8 * h2, 896);
#pragma unroll
            for (int i = 0; i < 16; ++i) part[((tl * 3 + kq) * 16 + i) * 64 + lane] = acc[i];
        }
        __syncthreads();
        if (tl < 2 && kq == 0) {
            const int row = MP + sb * 32 + r;
#pragma unroll
            for (int g = 0; g < 4; ++g) {
                f32x4 v;
#pragma unroll
                for (int e = 0; e < 4; ++e) { const int i = 4 * g + e; v[e] = part[((tl * 3 + 0) * 16 + i) * 64 + lane] + part[((tl * 3 + 1) * 16 + i) * 64 + lane] + part[((tl * 3 + 2) * 16 + i) * 64 + lane]; }
                const int col = col0 + 8 * g + 4 * h2;
                const u32x2 w = *(const u32x2*)((const bf16_t*)(P->ws + WS_XB) + (size_t)row * 1024 + col); const f32x4 xv = {bf_lo(w.x), bf_hi(w.x), bf_lo(w.y), bf_hi(w.y)};
                const f32x4 o = xv * ALPHA + v; u32x2 wo; wo.x = pk2(o[0], o[1]); wo.y = pk2(o[2], o[3]);
                *(u32x2*)((bf16_t*)(P->ws + WS_A2) + (size_t)row * 1024 + col) = wo;
            }
        }
    }
}
DI void small_out_splitk(KP P, LAS unsigned char* lds, int tid_in) {
    int tid = tid_in; asm volatile("" : "+v"(tid));
    const int lane = tid & 63, wave = __builtin_amdgcn_readfirstlane(tid >> 6), r = lane & 31, h2 = lane >> 5;
    const int tl = wave >> 2, kq = wave & 3;
    const bf16_t* X = (const bf16_t*)(P->ws + WS_A2); const bf16_t* Wt = (const bf16_t*)(P->ws + WS_WOUT);
    LAS float* part = (LAS float*)lds;
    for (int pair = blockIdx.x; pair < 256; pair += gridDim.x) {
        const int task = pair * 2 + tl, sb = task >> 5, cb = task & 31, col0 = cb * 32;
        __syncthreads();
        const f32x16 acc = small_block_p(X + (size_t)(MP + sb * 32 + r) * 1024 + kq * 256 + 8 * h2, Wt + (size_t)(col0 + r) * 1024 + kq * 256 + 8 * h2, 256);
#pragma unroll
        for (int i = 0; i < 16; ++i) part[((tl * 4 + kq) * 16 + i) * 64 + lane] = acc[i];
        __syncthreads();
        if (kq == 0) {
            const int row = MP + sb * 32 + r;
#pragma unroll
            for (int g = 0; g < 4; ++g) {
                f32x4 v;
#pragma unroll
                for (int e = 0; e < 4; ++e) { const int i = 4 * g + e; v[e] = (part[((tl * 4 + 0) * 16 + i) * 64 + lane] + part[((tl * 4 + 1) * 16 + i) * 64 + lane]) + (part[((tl * 4 + 2) * 16 + i) * 64 + lane] + part[((tl * 4 + 3) * 16 + i) * 64 + lane]); }
                const int col = col0 + 8 * g + 4 * h2;
                const f32x4 xv = *(const f32x4*)(P->in[1] + (size_t)(row - MP) * 1024 + col);
                const f32x4 o = xv * ALPHA + v; u32x2 wo; wo.x = pk2(o[0], o[1]); wo.y = pk2(o[2], o[3]);
                *(u32x2*)((bf16_t*)(P->out + O_Y) + (size_t)row * 1024 + col) = wo;
            }
        }
    }
}
DI void small_ffnconv_prompt(KP P, LAS unsigned char* lds, int tid_in) {
    int tid = tid_in; asm volatile("" : "+v"(tid));
    const int lane = tid & 63, kq = __builtin_amdgcn_readfirstlane(tid >> 6), r = lane & 31, h2 = lane >> 5;
    const bf16_t* X1 = (const bf16_t*)(P->ws + WS_XB); const bf16_t* WU = (const bf16_t*)(P->ws + WS_WUP);
    const int rr = r & 7, b = rr >> 1, t = 8190 + (rr & 1);
    LAS float* part = (LAS float*)lds;
    for (int task = blockIdx.x; task < 168; task += gridDim.x) {
        const int rho0 = task * 32, n0 = ((rho0 >> 7) & 1) * DFF + (rho0 >> 8) * 128 + (rho0 & 127);
        __syncthreads();
        const f32x16 acc = small_block_p(X1 + ((size_t)b * 8192 + t) * 1024 + kq * 128 + 8 * h2, WU + (size_t)(rho0 + r) * 1024 + kq * 128 + 8 * h2, 128);
#pragma unroll
        for (int i = 0; i < 16; ++i) part[(kq * 16 + i) * 64 + lane] = acc[i];
        __syncthreads();
        if (kq == 0 && r < 8) {
#pragma unroll
            for (int g = 0; g < 4; ++g) { f32x4 v;
#pragma unroll
                for (int e = 0; e < 4; ++e) { float s = 0.f;
#pragma unroll
                    for (int q = 0; q < 8; ++q) s += part[(q * 16 + 4 * g + e) * 64 + lane];
                    v[e] = s; }
                *(f32x4*)(P->out + O_FCP + (size_t)(b * 2 + (rr & 1)) * NUP + n0 + 8 * g + 4 * h2) = v; }
        }
    }
}
template <bool DOWN> DI void small_resid(KP P, int tid_in) {
    int tid = tid_in; asm volatile("" : "+v"(tid));
    const int lane = tid & 63, wave = tid >> 6, gw = blockIdx.x * 8 + wave, NGW = gridDim.x * 8, r = lane & 31, h2 = lane >> 5;
    const bf16_t* X = DOWN ? (const bf16_t*)(P->ws + WS_GS) - (size_t)MP * DFF : (const bf16_t*)(P->ws + WS_A2); const bf16_t* Wt = (const bf16_t*)(P->ws + (DOWN ? WS_WDOWN : WS_WOUT));
    const int K = DOWN ? DFF : 1024;
    for (int task = gw; task < 512; task += NGW) {
        const int sb = task >> 5, cb = task & 31, row = MP + sb * 32 + r, col0 = cb * 32;
        const f32x16 acc = small_block(X, Wt, K, MP + sb * 32, col0, lane);
#pragma unroll
        for (int g = 0; g < 4; ++g) {
            const int col = col0 + 8 * g + 4 * h2; const f32x4 v = {acc[4 * g], acc[4 * g + 1], acc[4 * g + 2], acc[4 * g + 3]};
            f32x4 xv;
            if (DOWN) { const u32x2 w = *(const u32x2*)((const bf16_t*)(P->ws + WS_XB) + (size_t)row * 1024 + col); xv = (f32x4){bf_lo(w.x), bf_hi(w.x), bf_lo(w.y), bf_hi(w.y)}; }
            else xv = *(const f32x4*)(P->in[1] + (size_t)(row - MP) * 1024 + col);
            bf16_t* U = DOWN ? (bf16_t*)(P->ws + WS_A2) : (bf16_t*)(P->out + O_Y);
            const f32x4 o = xv * ALPHA + v; u32x2 wo; wo.x = pk2(o[0], o[1]); wo.y = pk2(o[2], o[3]); *(u32x2*)(U + (size_t)row * 1024 + col) = wo;
        }
    }
}

DI void p0_transpose_item(const float* W, int K, int N, bf16_t* WT, int drow0, LAS float* scr, int k0, int n0, int lane) {
    const int nn = n0 + (lane & 31); const int nc = (nn < N) ? nn : N - 1;
    float tv[32];
#pragma unroll
    for (int i = 0; i < 32; ++i) tv[i] = __builtin_nontemporal_load(W + (size_t)(k0 + 2 * i + (lane >> 5)) * N + nc);
#pragma unroll
    for (int i = 0; i < 32; ++i) scr[(2 * i + (lane >> 5)) * 33 + (lane & 31)] = tv[i];
    asm volatile("s_waitcnt lgkmcnt(0)" ::: "memory");
    const int c = lane & 7;
#pragma unroll
    for (int j = 0; j < 4; ++j) { const int n = (lane >> 3) + 8 * j; const LAS float* s = scr + (8 * c) * 33 + n;
        u32x4 o; o.x = pk2(s[0 * 33], s[1 * 33]); o.y = pk2(s[2 * 33], s[3 * 33]); o.z = pk2(s[4 * 33], s[5 * 33]); o.w = pk2(s[6 * 33], s[7 * 33]);
        if (n0 + n < N) *(u32x4*)(WT + (size_t)(drow0 + n) * K + k0 + 8 * c) = o; }
    asm volatile("s_waitcnt lgkmcnt(0)" ::: "memory");
}
DI void p0_transpose_item_f8(const float* W, int K, int N, unsigned char* WT, int pitch, int drow0, LAS float* scr, int k0, int n0, int lane, float sc) {
    const int nn = n0 + (lane & 31); const int nc = (nn < N) ? nn : N - 1;
    float tv[32];
#pragma unroll
    for (int i = 0; i < 32; ++i) tv[i] = __builtin_nontemporal_load(W + (size_t)(k0 + 2 * i + (lane >> 5)) * N + nc);
#pragma unroll
    for (int i = 0; i < 32; ++i) scr[(2 * i + (lane >> 5)) * 33 + (lane & 31)] = tv[i] * sc;
    asm volatile("s_waitcnt lgkmcnt(0)" ::: "memory");
    const int c = lane & 7;
#pragma unroll
    for (int j = 0; j < 4; ++j) { const int n = (lane >> 3) + 8 * j; const LAS float* s = scr + (8 * c) * 33 + n;
        u32x2 o; o.x = pk4_f8(s[0 * 33], s[1 * 33], s[2 * 33], s[3 * 33]); o.y = pk4_f8(s[4 * 33], s[5 * 33], s[6 * 33], s[7 * 33]);
        if (n0 + n < N) *(u32x2*)(WT + (size_t)(drow0 + n) * pitch + k0 + 8 * c) = o; }
    asm volatile("s_waitcnt lgkmcnt(0)" ::: "memory");
}
constexpr int LATE_ITEMS = 16 * 32 + 16 * 168 + 42 * 32, LATE_WG_ITEMS = LATE_ITEMS / 64;
DI void convert_late_item(KP P, LAS unsigned char* lds, int wi) {
    int tid = threadIdx.x; asm volatile("" : "+v"(tid));
    const int lane = tid & 63, wave = tid >> 6;
    __syncthreads();
    LAS float* scr = (LAS float*)(lds + wave * 8448);
    constexpr int I_OUT = 16 * 32, I_UP = 16 * 168;
#pragma unroll 1
    for (int j = 0; j < 8; ++j) {
        int r = wi * 64 + wave * 8 + j;
        if (r < I_OUT) { const int kb = r / 32, nb = r % 32; p0_transpose_item(P->in[16], 1024, 1024, (bf16_t*)(P->ws + WS_WOUT), nb * 32, scr, kb * 64, nb * 32, lane); continue; } r -= I_OUT;
        if (r < I_UP) { const int kb = r / 168, nb = r % 168; const int n0 = nb * 32; const int np = (n0 < DFF) ? n0 : n0 - DFF;
            const int drow = (np >> 7) * 256 + ((n0 < DFF) ? 0 : 128) + (np & 127);
            p0_transpose_item(P->in[19], 1024, NUP, (bf16_t*)(P->ws + WS_WUP), drow, scr, kb * 64, n0, lane);
            p0_transpose_item_f8(P->in[19], 1024, NUP, P->ws + WS_WUP8, 1024, drow, scr, kb * 64, n0, lane, SC_WUP); continue; } r -= I_UP;
        { const int kb = r / 32, nb = r % 32; p0_transpose_item(P->in[22], DFF, 1024, (bf16_t*)(P->ws + WS_WDOWN), nb * 32, scr, kb * 64, nb * 32, lane); }
    }
}
DI void phase_convert(KP P, LAS unsigned char* lds) {
    int tid = threadIdx.x; asm volatile("" : "+v"(tid));
    const int lane = tid & 63, wave = tid >> 6, G = gridDim.x;
    LAS float* scr = (LAS float*)(lds + wave * 8448);
    const int gw = blockIdx.x * 8 + wave, NGW = G * 8;
    constexpr int I_IN = 16 * 97;
    for (int it = gw; it < I_IN; it += NGW) { const int kb = it / 97, nb = it % 97; p0_transpose_item(P->in[7], 1024, NIN, (bf16_t*)(P->ws + WS_WIN), nb * 32, scr, kb * 64, nb * 32, lane); }
    const size_t gt = (size_t)blockIdx.x * NT + tid, NGT = (size_t)G * NT;
    { bf16_t* XB = (bf16_t*)(P->ws + WS_XB);
      constexpr size_t NCH = (size_t)MT * 128;
      size_t i0 = gt;
      for (; i0 + 3 * NGT < NCH; i0 += 4 * NGT) {
          f32x4 a[4], b[4];
#pragma unroll
          for (int u = 0; u < 4; ++u) { const size_t e = (i0 + u * NGT) * 8; const float* src = (e < (size_t)MP * 1024) ? P->in[0] + e : P->in[1] + (e - (size_t)MP * 1024);
              a[u] = __builtin_nontemporal_load((const f32x4*)src); b[u] = __builtin_nontemporal_load((const f32x4*)(src + 4)); }
#pragma unroll
          for (int u = 0; u < 4; ++u) { pin(a[u]); pin(b[u]); }
#pragma unroll
          for (int u = 0; u < 4; ++u) { u32x4 w; w.x = pk2(a[u][0], a[u][1]); w.y = pk2(a[u][2], a[u][3]); w.z = pk2(b[u][0], b[u][1]); w.w = pk2(b[u][2], b[u][3]); *(u32x4*)(XB + (i0 + u * NGT) * 8) = w; }
      }
      for (; i0 < NCH; i0 += NGT) { const size_t e = i0 * 8; const float* src = (e < (size_t)MP * 1024) ? P->in[0] + e : P->in[1] + (e - (size_t)MP * 1024);
          const f32x4 a = *(const f32x4*)src, b = *(const f32x4*)(src + 4); u32x4 w; w.x = pk2(a[0], a[1]); w.y = pk2(a[2], a[3]); w.z = pk2(b[0], b[1]); w.w = pk2(b[2], b[3]); *(u32x4*)(XB + e) = w; }
    }
    { bf16_t* WI = (bf16_t*)(P->ws + WS_WIN) + (size_t)NIN * 1024;
      for (size_t i = gt; i < (size_t)(NINP - NIN) * 128; i += NGT) *(u32x4*)(WI + i * 8) = (u32x4){0u, 0u, 0u, 0u}; }
    { bf16_t* KS = (bf16_t*)(P->ws + WS_KS); bf16_t* VF = (bf16_t*)(P->ws + WS_VFS);
      for (size_t i = gt; i < (size_t)16 * 512 * 64; i += NGT) {
          const int cgp = (int)(i & 63), t = (int)((i >> 6) & 511), b = (int)(i >> 15);
          const float* ks = P->in[2] + ((size_t)(b * 512 + t)) * 512 + cgp * 8; const float* vs = P->in[3] + ((size_t)(b * 512 + t)) * 512 + cgp * 8;
          const f32x4 a = __builtin_nontemporal_load((const f32x4*)ks), c = __builtin_nontemporal_load((const f32x4*)(ks + 4)); u32x4 w; w.x = pk2(a[0], a[1]); w.y = pk2(a[2], a[3]); w.z = pk2(c[0], c[1]); w.w = pk2(c[2], c[3]);
          *(u32x4*)(KS + ((size_t)b * 544 + t) * 512 + cgp * 8) = w;
          const f32x4 va = __builtin_nontemporal_load((const f32x4*)vs), vc = __builtin_nontemporal_load((const f32x4*)(vs + 4));
          const int head = cgp >> 3, d0 = (cgp & 7) * 8, tt = t & 15, hh = (tt >> 2) & 1, jj = ((tt >> 3) << 2) | (tt & 3);
          bf16_t* p = VF + ((size_t)(b * 8 + head) * 34 + (t >> 4)) * 1024 + (hh * 64 + d0) * 8 + jj;
          const unsigned w0 = pk2(va[0], va[1]), w1 = pk2(va[2], va[3]), w2 = pk2(vc[0], vc[1]), w3 = pk2(vc[2], vc[3]);
          p[0] = (bf16_t)(w0 & 0xffff); p[8] = (bf16_t)(w0 >> 16); p[16] = (bf16_t)(w1 & 0xffff); p[24] = (bf16_t)(w1 >> 16);
          p[32] = (bf16_t)(w2 & 0xffff); p[40] = (bf16_t)(w2 >> 16); p[48] = (bf16_t)(w3 & 0xffff); p[56] = (bf16_t)(w3 >> 16);
      } }
}

template <bool OUT_BF16>
DI void phase_ln(const bf16_t* src, const float* gam, const float* bet, void* dst, unsigned char* dst8, unsigned char* g8pad, int tid_in) {
    int tid = tid_in; asm volatile("" : "+v"(tid));
    const int lane = tid & 63, wave = tid >> 6, gw = blockIdx.x * 8 + wave, NGW = gridDim.x * 8;
    f32x4 g4[4], b4[4];
#pragma unroll
    for (int j = 0; j < 4; ++j) { g4[j] = *(const f32x4*)(gam + (lane + 64 * j) * 4); b4[j] = *(const f32x4*)(bet + (lane + 64 * j) * 4); }
    for (int row0 = gw; row0 < MT; row0 += 2 * NGW) {
        u32x2 wv[2][4];
#pragma unroll
        for (int u = 0; u < 2; ++u) { const int row = row0 + u * NGW;
#pragma unroll
            for (int j = 0; j < 4; ++j) { wv[u][j] = (u32x2){0u, 0u}; if (row < MT) wv[u][j] = __builtin_nontemporal_load((const u32x2*)(src + (size_t)row * 1024 + (lane + 64 * j) * 4)); } }
#pragma unroll
        for (int u = 0; u < 2; ++u) { const int row = row0 + u * NGW; if (row >= MT) continue;
            f32x4 v[4]; float s = 0.f;
#pragma unroll
            for (int j = 0; j < 4; ++j) { const u32x2 w = wv[u][j]; v[j] = (f32x4){bf_lo(w.x), bf_hi(w.x), bf_lo(w.y), bf_hi(w.y)}; s += (v[j][0] + v[j][1]) + (v[j][2] + v[j][3]); }
#pragma unroll
            for (int o = 1; o < 64; o <<= 1) s += __shfl_xor(s, o);
            const float mean = s * (1.f / 1024.f); float q = 0.f;
#pragma unroll
            for (int j = 0; j < 4; ++j) { v[j] = v[j] - mean; q += (v[j][0] * v[j][0] + v[j][1] * v[j][1]) + (v[j][2] * v[j][2] + v[j][3] * v[j][3]); }
#pragma unroll
            for (int o = 1; o < 64; o <<= 1) q += __shfl_xor(q, o);
            const float rstd = 1.0f / sqrtf(q * (1.f / 1024.f) + 1e-5f);
#pragma unroll
            for (int j = 0; j < 4; ++j) { const f32x4 o = v[j] * rstd * g4[j] + b4[j];
                if (OUT_BF16) { u32x2 w; w.x = pk2(o[0], o[1]); w.y = pk2(o[2], o[3]); *(u32x2*)((bf16_t*)dst + (size_t)row * 1024 + (lane + 64 * j) * 4) = w;
                    *(unsigned*)(dst8 + (size_t)row * 1024 + (lane + 64 * j) * 4) = pk4_f8(o[0] * SC_X1, o[1] * SC_X1, o[2] * SC_X1, o[3] * SC_X1); }
                else *(f32x4*)((float*)dst + (size_t)row * 1024 + (lane + 64 * j) * 4) = o; }
        }
    }
}

constexpr int XCS = 2080;
constexpr int L_DT = 64 * XCS;
constexpr int L_AC = L_DT + 2048;
constexpr int L_RED = L_AC + 2048;

DI float ssd_dt_scan(KP P, LAS unsigned char* lds, int r0, int Lv, int h, int lane) {
    const float* DT = (const float*)(P->ws + WS_DT);
    float dt = 0.f;
    if (lane < Lv) { const float x = DT[(size_t)(r0 + lane) * 8 + h] + P->in[12][h]; dt = (x > 20.f) ? x : log1pf(expf(x)); }
    const float A = -expf(P->in[13][h]);
    float a = dt * A;
#pragma unroll
    for (int off = 1; off < 64; off <<= 1) { const float v = __shfl_up(a, off); if (lane >= off) a += v; }
    ((LAS float*)(lds + L_DT))[h * 64 + lane] = dt;
    ((LAS float*)(lds + L_AC))[h * 64 + lane] = a;
    return __shfl(a, 63);
}
template <bool DEC, int NCG>
DI void ssd_conv_to_lds(KP P, LAS unsigned char* lds, int tid, int r0, int Lv, bool samp, int sb, bool has_prev) {
    const int tblk = tid >> 7, cgp = tid & 127;
    if (cgp >= NCG) return;
    const int ch0 = cgp * 8, t0 = tblk * 16;
    const bf16_t* XBC = (const bf16_t*)(P->ws + WS_XBC);
    const float* cwp = P->in[10]; const float* cbp = P->in[11];
    float w[4][8], bias[8];
#pragma unroll
    for (int k = 0; k < 4; ++k) { const f32x4 a = *(const f32x4*)(cwp + k * 1024 + ch0), b = *(const f32x4*)(cwp + k * 1024 + ch0 + 4);
#pragma unroll
        for (int e = 0; e < 4; ++e) { w[k][e] = a[e]; w[k][4 + e] = b[e]; } }
    { const f32x4 a = *(const f32x4*)(cbp + ch0), b = *(const f32x4*)(cbp + ch0 + 4);
#pragma unroll
        for (int e = 0; e < 4; ++e) { bias[e] = a[e]; bias[4 + e] = b[e]; } }
    u32x4 raw[19]; f32x4 pa[3], pb[3];
    const bool halo_f32 = samp && (t0 == 0);
#pragma unroll
    for (int k = 0; k < 19; ++k) {
        const int tt = t0 - 3 + k;
        raw[k] = (u32x4){0u, 0u, 0u, 0u};
        if (tt >= 0) { if (tt < Lv) raw[k] = *(const u32x4*)(XBC + (size_t)(r0 + tt) * 1024 + ch0); }
        else if (!samp && has_prev) raw[k] = *(const u32x4*)(XBC + (size_t)(r0 + tt) * 1024 + ch0);
    }
#pragma unroll
    for (int k = 0; k < 3; ++k) { pa[k] = (f32x4){0.f, 0.f, 0.f, 0.f}; pb[k] = pa[k];
        if (halo_f32) { const float* s = P->in[5] + ((size_t)(sb * 3 + k)) * 1024 + ch0; pa[k] = *(const f32x4*)s; pb[k] = *(const f32x4*)(s + 4); } }
    float xw[3][8];
#pragma unroll
    for (int k = 0; k < 3; ++k) {
        const u32x4 q = raw[k];
        xw[k][0] = bf_lo(q.x); xw[k][1] = bf_hi(q.x); xw[k][2] = bf_lo(q.y); xw[k][3] = bf_hi(q.y); xw[k][4] = bf_lo(q.z); xw[k][5] = bf_hi(q.z); xw[k][6] = bf_lo(q.w); xw[k][7] = bf_hi(q.w);
        if (halo_f32) {
#pragma unroll
            for (int e = 0; e < 4; ++e) { xw[k][e] = pa[k][e]; xw[k][4 + e] = pb[k][e]; } }
    }
    const int head = cgp >> 3;
    const LAS float* sdt = (const LAS float*)(lds + L_DT) + head * 64; const LAS float* sac = (const LAS float*)(lds + L_AC) + head * 64;
    const float atot = (cgp < 64) ? sac[63] : 0.f;
#pragma unroll
    for (int i = 0; i < 16; ++i) {
        const int t = t0 + i; float xc[8];
        { const u32x4 q = raw[3 + i];
          xc[0] = bf_lo(q.x); xc[1] = bf_hi(q.x); xc[2] = bf_lo(q.y); xc[3] = bf_hi(q.y); xc[4] = bf_lo(q.z); xc[5] = bf_hi(q.z); xc[6] = bf_lo(q.w); xc[7] = bf_hi(q.w); }
        float f = 1.f;
        if (cgp < 64) { f = sdt[t]; if (DEC) f *= __builtin_amdgcn_exp2f((atot - sac[t]) * LOG2E); }
        if (t >= Lv) f = 0.f;
        float o[8];
#pragma unroll
        for (int e = 0; e < 8; ++e) { const float v = bias[e] + w[0][e] * xw[0][e] + w[1][e] * xw[1][e] + w[2][e] * xw[2][e] + w[3][e] * xc[e]; o[e] = silu_f(v) * f; }
        u32x4 q; q.x = pk2(o[0], o[1]); q.y = pk2(o[2], o[3]); q.z = pk2(o[4], o[5]); q.w = pk2(o[6], o[7]);
        *(LAS u32x4*)(lds + t * XCS + ch0 * 2) = q;
#pragma unroll
        for (int e = 0; e < 8; ++e) { xw[0][e] = xw[1][e]; xw[1][e] = xw[2][e]; xw[2][e] = xc[e]; }
    }
}
DI void chunk_geom(int ch, bool& samp, int& sb, int& r0, int& Lv, bool& has_prev) {
    samp = ch >= 512; sb = ch - 512;
    if (!samp) { r0 = ch * 64; Lv = 64; has_prev = (ch & 127) != 0; } else { r0 = MP + sb * 32; Lv = 32; has_prev = false; }
}
DI void ssd_states_tile(KP P, LAS unsigned char* lds, int ch) {
    int tid = threadIdx.x; asm volatile("" : "+v"(tid));
    const int lane = tid & 63, h = __builtin_amdgcn_readfirstlane(tid >> 6);
    bool samp, has_prev; int sb, r0, Lv; chunk_geom(ch, samp, sb, r0, Lv, has_prev);
    __syncthreads();
    const float atot = ssd_dt_scan(P, lds, r0, Lv, h, lane);
    if (lane == 0) ((float*)(P->ws + WS_DEC))[ch * 8 + h] = expf(atot);
    __syncthreads();
    ssd_conv_to_lds<true, 96>(P, lds, tid, r0, Lv, samp, sb, has_prev);
    __syncthreads();
    const int r = lane & 31, h2 = lane >> 5, blk = (lane >> 4) & 1, i16 = lane & 15, q = i16 >> 2, pp = i16 & 3, g = h >> 2;
    bf16_t* ST = (bf16_t*)(P->ws + WS_ST) + ((size_t)ch * 8 + h) * 8192;
#pragma unroll 1
    for (int nh = 0; nh < 2; ++nh) {
        f32x16 acc[2][2];
#pragma unroll
        for (int a = 0; a < 2; ++a)
#pragma unroll
            for (int b = 0; b < 2; ++b)
#pragma unroll
                for (int i = 0; i < 16; ++i) acc[a][b][i] = 0.f;
#pragma unroll
        for (int sp = 0; sp < 4; ++sp) {
            LAS unsigned char* rlo = lds + (16 * sp + 8 * h2 + q) * XCS + (16 * blk + 4 * pp) * 2;
            LAS unsigned char* rhi = rlo + 4 * XCS;
            bf16x8 af[2], bfr[2];
#pragma unroll
            for (int pb = 0; pb < 2; ++pb) af[pb] = tr_frag(rlo + (h * 64 + 32 * pb) * 2, rhi + (h * 64 + 32 * pb) * 2);
#pragma unroll
            for (int nb = 0; nb < 2; ++nb) bfr[nb] = tr_frag(rlo + (512 + g * 128 + 64 * nh + 32 * nb) * 2, rhi + (512 + g * 128 + 64 * nh + 32 * nb) * 2);
#pragma unroll
            for (int pb = 0; pb < 2; ++pb)
#pragma unroll
                for (int nb = 0; nb < 2; ++nb) acc[pb][nb] = MFMA32(af[pb], bfr[nb], acc[pb][nb]);
        }
#pragma unroll
        for (int pb = 0; pb < 2; ++pb)
#pragma unroll
            for (int nb = 0; nb < 2; ++nb) {
                bf16_t* sp_ = ST + (32 * pb + 4 * h2) * 128 + 64 * nh + 32 * nb + r;
#pragma unroll
                for (int i = 0; i < 16; ++i) sp_[((i & 3) + 8 * (i >> 2)) * 128] = (bf16_t)(pk2(acc[pb][nb][i], 0.f) & 0xffff);
            }
    }
}
DI void phase_scan(KP P, LAS unsigned char* lds) {
    int tid = threadIdx.x; asm volatile("" : "+v"(tid));
    unsigned* ST = (unsigned*)(P->ws + WS_ST); const float* DEC = (const float*)(P->ws + WS_DEC);
    LAS float* sdec = (LAS float*)lds;
    for (int blk = blockIdx.x; blk < 256; blk += gridDim.x) {
        const int b = blk >> 6, h = (blk >> 3) & 7, rem = (blk & 63) * 512 + tid;
        __syncthreads();
        if (tid < 128) sdec[tid] = DEC[(b * 128 + tid) * 8 + h];
        __syncthreads();
        float H0 = 0.f, H1 = 0.f;
        unsigned* sp = ST + (size_t)b * 128 * 32768 + rem;
#pragma unroll 1
        for (int c0 = 0; c0 < 128; c0 += 64) {
            unsigned w[64];
#pragma unroll
            for (int k = 0; k < 64; ++k) w[k] = sp[(size_t)(c0 + k) * 32768];
#pragma unroll
            for (int k = 0; k < 64; ++k) { const float d = sdec[c0 + k]; sp[(size_t)(c0 + k) * 32768] = pk2(H0, H1); H0 = H0 * d + bf_lo(w[k]); H1 = H1 * d + bf_hi(w[k]); }
        }
        *(f32x2*)(P->out + O_SSP + ((size_t)blk * 512 + tid) * 2) = (f32x2){H0, H1};
    }
}
DI void phase_sample_state(KP P) {
    int tid = threadIdx.x; asm volatile("" : "+v"(tid));
    const size_t gt = (size_t)blockIdx.x * NT + tid, NGT = (size_t)gridDim.x * NT;
    const unsigned* ST = (const unsigned*)(P->ws + WS_ST); const float* DEC = (const float*)(P->ws + WS_DEC);
    for (size_t pr0 = gt; pr0 < 524288; pr0 += 4 * NGT) {
        f32x2 h0[4]; unsigned w[4]; float d[4];
#pragma unroll
        for (int u = 0; u < 4; ++u) { const size_t pr = pr0 + u * NGT; h0[u] = (f32x2){0.f, 0.f}; w[u] = 0u; d[u] = 0.f;
            if (pr < 524288) { const int b = (int)(pr >> 15), rem = (int)(pr & 32767), h = rem >> 12, chq = 512 + b;
                h0[u] = *(const f32x2*)(P->in[4] + pr * 2); w[u] = ST[(size_t)chq * 32768 + rem]; d[u] = DEC[chq * 8 + h]; } }
#pragma unroll
        for (int u = 0; u < 4; ++u) { const size_t pr = pr0 + u * NGT;
            if (pr < 524288) *(f32x2*)(P->out + O_SSS + pr * 2) = (f32x2){h0[u][0] * d[u] + bf_lo(w[u]), h0[u][1] * d[u] + bf_hi(w[u])}; }
    }
}
DI void ssd_out_tile(KP P, LAS unsigned char* lds, int ch) {
    int tid = threadIdx.x; asm volatile("" : "+v"(tid));
    const int lane = tid & 63, h = __builtin_amdgcn_readfirstlane(tid >> 6);
    bool samp, has_prev; int sb, r0, Lv; chunk_geom(ch, samp, sb, r0, Lv, has_prev);
    __syncthreads();
    ssd_dt_scan(P, lds, r0, Lv, h, lane);
    __syncthreads();
    ssd_conv_to_lds<false, 128>(P, lds, tid, r0, Lv, samp, sb, has_prev);
    __syncthreads();
    const int r = lane & 31, h2 = lane >> 5, blk = (lane >> 4) & 1, i16 = lane & 15, q = i16 >> 2, pp = i16 & 3, g = h >> 2;
    const LAS float* sac = (const LAS float*)(lds + L_AC) + h * 64; const LAS float* sdt = (const LAS float*)(lds + L_DT) + h * 64;
    f32x16 cb[2][2];
#pragma unroll
    for (int a = 0; a < 2; ++a)
#pragma unroll
        for (int b = 0; b < 2; ++b)
#pragma unroll
            for (int i = 0; i < 16; ++i) cb[a][b][i] = 0.f;
    const bf16_t* PREV = (const bf16_t*)(P->ws + WS_ST) + ((size_t)ch * 8 + h) * 8192;
#pragma unroll 2
    for (int kk = 0; kk < 8; ++kk) {
        bf16x8 bm[2], cm[2];
#pragma unroll
        for (int x = 0; x < 2; ++x) {
            bm[x] = *(const LAS bf16x8*)(lds + (32 * x + r) * XCS + (512 + g * 128 + 16 * kk + 8 * h2) * 2);
            cm[x] = *(const LAS bf16x8*)(lds + (32 * x + r) * XCS + (768 + g * 128 + 16 * kk + 8 * h2) * 2);
        }
#pragma unroll
        for (int a = 0; a < 2; ++a)
#pragma unroll
            for (int b = 0; b < 2; ++b) cb[a][b] = MFMA32(bm[a], cm[b], cb[a][b]);
    }
    __builtin_amdgcn_sched_barrier(0);
    float acl[2]; acl[0] = sac[r]; acl[1] = sac[32 + r];
    f32x16 y[2][2];
#pragma unroll
    for (int a = 0; a < 2; ++a)
#pragma unroll
        for (int b = 0; b < 2; ++b)
#pragma unroll
            for (int i = 0; i < 16; ++i) y[a][b][i] = 0.f;
#pragma unroll
    for (int sbk = 0; sbk < 2; ++sbk) {
        float acs[16];
#pragma unroll
        for (int gi = 0; gi < 4; ++gi) { const f32x4 t4 = *(const LAS f32x4*)(sac + 32 * sbk + 8 * gi + 4 * h2); acs[4 * gi] = t4[0]; acs[4 * gi + 1] = t4[1]; acs[4 * gi + 2] = t4[2]; acs[4 * gi + 3] = t4[3]; }
#pragma unroll
        for (int s2 = 0; s2 < 2; ++s2) {
            bf16x8 pf[2];
#pragma unroll
            for (int lb = 0; lb < 2; ++lb) {
                const int l = 32 * lb + r; float m[8];
#pragma unroll
                for (int j = 0; j < 8; ++j) { const int i = 8 * s2 + j, s = 32 * sbk + crow(i, h2);
                    m[j] = (s <= l) ? cb[sbk][lb][i] * __builtin_amdgcn_exp2f((acl[lb] - acs[i]) * LOG2E) : 0.f; }
                pf[lb] = pack8(m[0], m[1], m[2], m[3], m[4], m[5], m[6], m[7]);
            }
            LAS unsigned char* rlo = lds + (32 * sbk + 16 * s2 + 4 * h2 + q) * XCS + (h * 64 + 16 * blk + 4 * pp) * 2;
            LAS unsigned char* rhi = rlo + 8 * XCS;
#pragma unroll
            for (int pb = 0; pb < 2; ++pb) { const bf16x8 xa = tr_frag(rlo + 64 * pb, rhi + 64 * pb);
#pragma unroll
                for (int lb = 0; lb < 2; ++lb) y[pb][lb] = MFMA32(xa, pf[lb], y[pb][lb]); }
        }
    }
    __builtin_amdgcn_sched_barrier(0);
    {
        f32x16 yo[2][2];
#pragma unroll
        for (int a = 0; a < 2; ++a)
#pragma unroll
            for (int b = 0; b < 2; ++b)
#pragma unroll
                for (int i = 0; i < 16; ++i) yo[a][b][i] = 0.f;
        bf16x8 pv[8][2];
#pragma unroll
        for (int kk = 0; kk < 8; ++kk)
#pragma unroll
            for (int x = 0; x < 2; ++x) {
                if (!samp) pv[kk][x] = *(const bf16x8*)(PREV + (32 * x + r) * 128 + 16 * kk + 8 * h2);
                else { const float* hp = P->in[4] + ((size_t)(sb * 8 + h) * 64 + 32 * x + r) * 128 + 16 * kk + 8 * h2; const f32x4 ha = *(const f32x4*)hp, hb = *(const f32x4*)(hp + 4);
                    pv[kk][x] = pack8(ha[0], ha[1], ha[2], ha[3], hb[0], hb[1], hb[2], hb[3]); }
            }
#pragma unroll
        for (int kk = 0; kk < 8; ++kk)
#pragma unroll
            for (int x = 0; x < 2; ++x) pin(pv[kk][x]);
#pragma unroll
        for (int kk = 0; kk < 8; ++kk) {
            bf16x8 cm[2];
#pragma unroll
            for (int x = 0; x < 2; ++x) cm[x] = *(const LAS bf16x8*)(lds + (32 * x + r) * XCS + (768 + g * 128 + 16 * kk + 8 * h2) * 2);
#pragma unroll
            for (int a = 0; a < 2; ++a)
#pragma unroll
                for (int b = 0; b < 2; ++b) yo[a][b] = MFMA32(pv[kk][a], cm[b], yo[a][b]);
        }
#pragma unroll
        for (int lb = 0; lb < 2; ++lb) { const float eo = __builtin_amdgcn_exp2f(acl[lb] * LOG2E);
#pragma unroll
            for (int pb = 0; pb < 2; ++pb)
#pragma unroll
                for (int i = 0; i < 16; ++i) y[pb][lb][i] += eo * yo[pb][lb][i]; }
    }
    __builtin_amdgcn_sched_barrier(0);
    const float Dh = P->in[14][h];
    const bf16_t* Z = (const bf16_t*)(P->ws + WS_Z);
    float ss[2] = {0.f, 0.f};
    u32x2 zq[2][2][4];
#pragma unroll
    for (int lb = 0; lb < 2; ++lb)
#pragma unroll
        for (int pb = 0; pb < 2; ++pb)
#pragma unroll
            for (int gi = 0; gi < 4; ++gi) { const int l = 32 * lb + r; zq[lb][pb][gi] = (u32x2){0u, 0u};
                if (l < Lv) zq[lb][pb][gi] = *(const u32x2*)(Z + (size_t)(r0 + l) * 512 + h * 64 + 32 * pb + 8 * gi + 4 * h2); }
#pragma unroll
    for (int lb = 0; lb < 2; ++lb)
#pragma unroll
        for (int pb = 0; pb < 2; ++pb)
#pragma unroll
            for (int gi = 0; gi < 4; ++gi) pin(zq[lb][pb][gi]);
#pragma unroll
    for (int lb = 0; lb < 2; ++lb) {
        const int l = 32 * lb + r; const bool ok = l < Lv;
        const float dtl = sdt[l]; const float dsk = ok ? Dh / dtl : 0.f;
#pragma unroll
        for (int pb = 0; pb < 2; ++pb)
#pragma unroll
            for (int gi = 0; gi < 4; ++gi) {
                const int p0 = 32 * pb + 8 * gi + 4 * h2;
                const u32x2 xq = *(const LAS u32x2*)(lds + l * XCS + (h * 64 + p0) * 2);
                const u32x2 zv2 = zq[lb][pb][gi];
                const float xv[4] = {bf_lo(xq.x), bf_hi(xq.x), bf_lo(xq.y), bf_hi(xq.y)}; const float zv[4] = {bf_lo(zv2.x), bf_hi(zv2.x), bf_lo(zv2.y), bf_hi(zv2.y)};
#pragma unroll
                for (int e = 0; e < 4; ++e) { const int i = 4 * gi + e; float v = y[pb][lb][i] + xv[e] * dsk; v *= silu_f(zv[e]); y[pb][lb][i] = v; ss[lb] += v * v; }
            }
    }
    LAS float* red = (LAS float*)(lds + L_RED);
#pragma unroll
    for (int lb = 0; lb < 2; ++lb) { ss[lb] += __shfl_xor(ss[lb], 32); if (h2 == 0) red[h * 64 + 32 * lb + r] = ss[lb]; }
    __syncthreads();
    bf16_t* A2 = (bf16_t*)(P->ws + WS_A2); const float* gam = P->in[15];
    f32x4 gv[2][4];
#pragma unroll
    for (int pb = 0; pb < 2; ++pb)
#pragma unroll
        for (int gi = 0; gi < 4; ++gi) gv[pb][gi] = *(const f32x4*)(gam + h * 64 + 32 * pb + 8 * gi + 4 * h2);
#pragma unroll
    for (int pb = 0; pb < 2; ++pb)
#pragma unroll
        for (int gi = 0; gi < 4; ++gi) pin(gv[pb][gi]);
#pragma unroll
    for (int lb = 0; lb < 2; ++lb) {
        const int l = 32 * lb + r; float tot = 0.f;
#pragma unroll
        for (int hh = 0; hh < 8; ++hh) tot += red[hh * 64 + l];
        const float rs = 1.0f / sqrtf(tot * (1.f / 512.f) + 1e-5f);
        if (l < Lv) {
#pragma unroll
            for (int pb = 0; pb < 2; ++pb)
#pragma unroll
                for (int gi = 0; gi < 4; ++gi) { const int p0 = 32 * pb + 8 * gi + 4 * h2; const f32x4 g4 = gv[pb][gi];
                    u32x2 w; w.x = pk2(y[pb][lb][4 * gi] * rs * g4[0], y[pb][lb][4 * gi + 1] * rs * g4[1]); w.y = pk2(y[pb][lb][4 * gi + 2] * rs * g4[2], y[pb][lb][4 * gi + 3] * rs * g4[3]);
                    *(u32x2*)(A2 + (size_t)(r0 + l) * 1024 + 512 + h * 64 + p0) = w; }
        }
    }
}

constexpr int L_TBL = 0;
constexpr int L_ARED = 8 * 260 * 4;
constexpr int L_AQ = 16384;
DI void attn_tile(KP P, LAS unsigned char* lds, int ch) {
    int tid = threadIdx.x; asm volatile("" : "+v"(tid));
    const int lane = tid & 63, hd = __builtin_amdgcn_readfirstlane(tid >> 6), r = lane & 31, h2 = lane >> 5;
    const bool samp = ch >= 512;
    int Lq, jt_lo, nkeys, ngr; long qrow0; const bf16_t* Kb; const bf16_t* Vb;
    if (!samp) { const int b = ch >> 7, c = ch & 127; qrow0 = (long)ch * 64; Lq = 64; jt_lo = (c < 8) ? 8 - c : 0; nkeys = 576; ngr = 36;
        Kb = (const bf16_t*)(P->ws + WS_KP) + ((long)b * 8192 + (long)(c - 8) * 64) * 512 + hd * 64;
        Vb = (const bf16_t*)(P->ws + WS_VFP) + ((long)(b * 8 + hd) * 512 + (long)(c - 8) * 4) * 1024; }
    else { const int b = ch - 512; qrow0 = (long)MP + b * 32; Lq = 32; jt_lo = 0; nkeys = 544; ngr = 34;
        Kb = (const bf16_t*)(P->ws + WS_KS) + (long)b * 544 * 512 + hd * 64;
        Vb = (const bf16_t*)(P->ws + WS_VFS) + (long)(b * 8 + hd) * 34 * 1024; }
    __syncthreads();
    LAS float* tbl = (LAS float*)(lds + L_TBL) + hd * 260;
    for (int i = lane; i < 257; i += 64) tbl[i] = P->in[8][hd * 257 + i] * LOG2E;
    __syncthreads();
    const bf16_t* Q = (const bf16_t*)(P->ws + WS_Q);
    LAS unsigned char* qlds = lds + L_AQ + hd * 8192 + lane * 16;
    { bf16x8 qtmp[2][4];
#pragma unroll
      for (int qb = 0; qb < 2; ++qb) { int qi = 32 * qb + r; if (qi > Lq - 1) qi = Lq - 1;
#pragma unroll
          for (int s = 0; s < 4; ++s) qtmp[qb][s] = *(const bf16x8*)(Q + (size_t)(qrow0 + qi) * 512 + hd * 64 + 16 * s + 8 * h2); }
#pragma unroll
      for (int qb = 0; qb < 2; ++qb)
#pragma unroll
          for (int s = 0; s < 4; ++s) pin(qtmp[qb][s]);
#pragma unroll
      for (int qb = 0; qb < 2; ++qb)
#pragma unroll
          for (int s = 0; s < 4; ++s) *(LAS bf16x8*)(qlds + (qb * 4 + s) * 1024) = qtmp[qb][s]; }
    f32x16 o[2][2];
#pragma unroll
    for (int a = 0; a < 2; ++a)
#pragma unroll
        for (int b = 0; b < 2; ++b)
#pragma unroll
            for (int i = 0; i < 16; ++i) o[a][b][i] = 0.f;
    float mrun[2] = {-1e30f, -1e30f}, lrun[2] = {0.f, 0.f};
    const float SC = 0.125f * LOG2E;
    for (int jt = jt_lo; jt < 9; ++jt) {
        bf16x8 kf[2][4];
#pragma unroll
        for (int kb = 0; kb < 2; ++kb) {
            int kj = 64 * jt + 32 * kb + r; if (kj > nkeys - 1) kj = nkeys - 1;
#pragma unroll
            for (int s = 0; s < 4; ++s) kf[kb][s] = *(const bf16x8*)(Kb + (long)kj * 512 + 16 * s + 8 * h2);
        }
#pragma unroll
        for (int kb = 0; kb < 2; ++kb)
#pragma unroll
            for (int s = 0; s < 4; ++s) pin(kf[kb][s]);
        f32x16 st[2][2];
#pragma unroll
        for (int kb = 0; kb < 2; ++kb)
#pragma unroll
            for (int qb = 0; qb < 2; ++qb) {
#pragma unroll
                for (int i = 0; i < 16; ++i) st[kb][qb][i] = 0.f;
#pragma unroll
                for (int s = 0; s < 4; ++s) st[kb][qb] = MFMA32(kf[kb][s], *(const LAS bf16x8*)(qlds + (qb * 4 + s) * 1024), st[kb][qb]);
            }
        __builtin_amdgcn_sched_barrier(0);
        bf16x8 vf[2][2][2];
#pragma unroll
        for (int kb = 0; kb < 2; ++kb)
#pragma unroll
            for (int s2 = 0; s2 < 2; ++s2) {
                int gidx = 4 * jt + 2 * kb + s2; if (gidx > ngr - 1) gidx = ngr - 1;
#pragma unroll
                for (int db = 0; db < 2; ++db) vf[kb][s2][db] = *(const bf16x8*)(Vb + (long)gidx * 1024 + (h2 * 64 + 32 * db + r) * 8);
            }
        __builtin_amdgcn_sched_barrier(0);
        const bool far = (jt <= 5);
        const bool tailmask = samp && (jt == 8);
        const float bfar = tbl[256];
#pragma unroll
        for (int qb = 0; qb < 2; ++qb) {
            const int qi = 32 * qb + r;
            float mx = -1e30f;
#pragma unroll
            for (int kb = 0; kb < 2; ++kb)
#pragma unroll
                for (int i = 0; i < 16; ++i) {
                    const int kj = 64 * jt + 32 * kb + crow(i, h2);
                    float bias = bfar;
                    if (!far) { int rel = 512 + qi - kj; rel = rel > 128 ? 128 : rel; rel = rel < -128 ? -128 : rel; bias = tbl[rel + 128]; }
                    float sc = st[kb][qb][i] * SC + bias;
                    if (tailmask && kj >= nkeys) sc = -1e30f;
                    st[kb][qb][i] = sc; mx = fmaxf(mx, sc);
                }
            mx = fmaxf(mx, __shfl_xor(mx, 32));
            const float mnew = fmaxf(mrun[qb], mx), alpha = __builtin_amdgcn_exp2f(mrun[qb] - mnew);
            float ls = 0.f;
#pragma unroll
            for (int kb = 0; kb < 2; ++kb)
#pragma unroll
                for (int i = 0; i < 16; ++i) { const float p = __builtin_amdgcn_exp2f(st[kb][qb][i] - mnew); st[kb][qb][i] = p; ls += p; }
            ls += __shfl_xor(ls, 32);
            lrun[qb] = lrun[qb] * alpha + ls; mrun[qb] = mnew;
            if (__builtin_amdgcn_ballot_w64(alpha != 1.0f) != 0ull) {
#pragma unroll
                for (int db = 0; db < 2; ++db)
#pragma unroll
                    for (int i = 0; i < 16; ++i) o[db][qb][i] *= alpha;
            }
        }
#pragma unroll
        for (int kb = 0; kb < 2; ++kb)
#pragma unroll
            for (int s2 = 0; s2 < 2; ++s2) {
                bf16x8 pf[2];
#pragma unroll
                for (int qb = 0; qb < 2; ++qb) pf[qb] = pack8(st[kb][qb][8 * s2], st[kb][qb][8 * s2 + 1], st[kb][qb][8 * s2 + 2], st[kb][qb][8 * s2 + 3],
                                                               st[kb][qb][8 * s2 + 4], st[kb][qb][8 * s2 + 5], st[kb][qb][8 * s2 + 6], st[kb][qb][8 * s2 + 7]);
#pragma unroll
                for (int db = 0; db < 2; ++db)
#pragma unroll
                    for (int qb = 0; qb < 2; ++qb) o[db][qb] = MFMA32(vf[kb][s2][db], pf[qb], o[db][qb]);
            }
    }
    LAS float* red = (LAS float*)(lds + L_ARED);
#pragma unroll
    for (int qb = 0; qb < 2; ++qb) {
        const float il = 1.0f / lrun[qb]; float ss = 0.f;
#pragma unroll
        for (int db = 0; db < 2; ++db)
#pragma unroll
            for (int i = 0; i < 16; ++i) { const float v = o[db][qb][i] * il; o[db][qb][i] = v; ss += v * v; }
        ss += __shfl_xor(ss, 32);
        if (h2 == 0) red[hd * 64 + 32 * qb + r] = ss;
    }
    __syncthreads();
    bf16_t* A2 = (bf16_t*)(P->ws + WS_A2); const float* gam = P->in[9];
    f32x4 gv[2][4];
#pragma unroll
    for (int db = 0; db < 2; ++db)
#pragma unroll
        for (int gi = 0; gi < 4; ++gi) gv[db][gi] = *(const f32x4*)(gam + hd * 64 + 32 * db + 8 * gi + 4 * h2);
#pragma unroll
    for (int db = 0; db < 2; ++db)
#pragma unroll
        for (int gi = 0; gi < 4; ++gi) pin(gv[db][gi]);
#pragma unroll
    for (int qb = 0; qb < 2; ++qb) {
        const int qi = 32 * qb + r; float tot = 0.f;
#pragma unroll
        for (int hh = 0; hh < 8; ++hh) tot += red[hh * 64 + qi];
        const float rs = 1.0f / sqrtf(tot * (1.f / 512.f) + 1e-5f);
        if (qi < Lq) {
#pragma unroll
            for (int db = 0; db < 2; ++db)
#pragma unroll
                for (int gi = 0; gi < 4; ++gi) { const int d0 = 32 * db + 8 * gi + 4 * h2; const f32x4 g4 = gv[db][gi];
                    u32x2 w; w.x = pk2(o[db][qb][4 * gi] * rs * g4[0], o[db][qb][4 * gi + 1] * rs * g4[1]); w.y = pk2(o[db][qb][4 * gi + 2] * rs * g4[2], o[db][qb][4 * gi + 3] * rs * g4[3]);
                    *(u32x2*)(A2 + (size_t)(qrow0 + qi) * 1024 + hd * 64 + d0) = w; }
        }
    }
}

__global__ void __launch_bounds__(NT, 2) hybrid_fwd(Params PA) {
    extern __shared__ __attribute__((aligned(16))) unsigned char lds_raw[];
    LAS unsigned char* lds = (LAS unsigned char*)lds_raw;
    cg::grid_group grid = cg::this_grid();
    const int G = gridDim.x, bx = blockIdx.x;
    int wid_s = __builtin_amdgcn_readfirstlane(threadIdx.x >> 6); asm volatile("" : "+s"(wid_s));
#define TIDX() ({ unsigned z_ = 0u; asm volatile("" : "+s"(z_)); (wid_s << 6) | (int)__builtin_amdgcn_mbcnt_hi(~0u, __builtin_amdgcn_mbcnt_lo(~0u, z_)); })
#define KARGS() ({ KP p_ = (KP)__builtin_amdgcn_kernarg_segment_ptr(); asm volatile("" : "+s"(p_)); p_; })
    if (PA.out == nullptr) grid.sync();
    {
        volatile LAS unsigned* stw = (volatile LAS unsigned*)(lds + LDS_BYTES - 16);
        if (threadIdx.x == 0) { stw[0] = 0u; stw[1] = 0u; }
        __syncthreads();
    }
    const XcdBarrier gbar = xcd_barrier_post((unsigned*)(PA.ws + WS_BAR), (volatile LAS unsigned*)(lds + LDS_BYTES - 16));
#define GRID_SYNC() xcd_barrier(gbar, TIDX())

#ifndef PHASE_MASK
#define PHASE_MASK 0xFFFF
#endif
#ifndef REPEAT_MASK
#define REPEAT_MASK 0
#endif
#define PH(k) if (KP P = KARGS()) if (PHASE_MASK & (1 << (k))) for (int rep_ = 0; rep_ <= ((REPEAT_MASK >> (k)) & 1); ++rep_)
#ifndef NREP_ALL
#define NREP_ALL 1
#endif
    for (int outer_ = 0; outer_ < NREP_ALL; ++outer_) {
    if (outer_) GRID_SYNC();
    PH(0) phase_convert(P, lds);
    GRID_SYNC();
    PH(1) {
        pg8::AMapPlain am{(const void*)(P->ws + WS_XB), 2048}; pg8::Order S; S.init(128, 12, G, bx);
        EpiInProj E{P->out, P->ws};
        pg8::gemm_phase<EpiInProj, pg8::AMapPlain>(lds, am, (const void*)(P->ws + WS_WIN), 2048, S, E);
        small_inproj(P);
    }
    GRID_SYNC();
    PH(4) {
        unsigned* qctr = (unsigned*)(P->ws + WS_BAR) + 3584 + 64 * (rep_ + 2 * outer_);
        volatile LAS unsigned* slot = (volatile LAS unsigned*)(lds + LDS_BYTES - 32);
        constexpr int Q0 = LATE_WG_ITEMS, Q1 = Q0 + 480, Q2 = Q1 + 512, Q3 = Q2 + 32, Q4 = Q3 + 16, Q5 = Q4 + 16, Q6 = Q5 + 16;
        for (;;) {
            __syncthreads();
            if (threadIdx.x == 0) slot[0] = __hip_atomic_fetch_add(qctr, 1u, __ATOMIC_RELAXED, __HIP_MEMORY_SCOPE_AGENT);
            __syncthreads();
            const int it = (int)slot[0];
            if (it >= Q6) break;
            if (it < Q0) convert_late_item(P, lds, it);
            else if (it < Q1) { const int j = it - Q0; attn_tile(P, lds, (j / 120) * 128 + 8 + j % 120); }
            else if (it < Q2) ssd_states_tile(P, lds, it - Q1);
            else if (it < Q3) { const int j = it - Q2; attn_tile(P, lds, (j & 3) * 128 + 7 - (j >> 2)); }
            else if (it < Q4) ssd_out_tile(P, lds, 512 + it - Q3);
            else if (it < Q5) attn_tile(P, lds, 512 + it - Q4);
            else ssd_states_tile(P, lds, 512 + it - Q5);
        }
    }
    GRID_SYNC();
    PH(3) phase_scan(P, lds);
    GRID_SYNC();
    PH(5) for (int ch = bx; ch < 512; ch += G) ssd_out_tile(P, lds, ch);
    PH(5) phase_sample_state(P);
    GRID_SYNC();
    PH(6) {
        __syncthreads();
        pg8::AMapPlain am{(const void*)(P->ws + WS_A2), 2048}; pg8::Order S; S.init(128, 4, G, bx);
        EpiOutProj E{P->in[0], P->in[1], (bf16_t*)(P->out + O_Y)};
        pg8::gemm_phase<EpiOutProj, pg8::AMapPlain>(lds, am, (const void*)(P->ws + WS_WOUT), 2048, S, E);
        small_out_splitk(P, lds, TIDX());
    }
    GRID_SYNC();
    PH(7) phase_ln<true>((const bf16_t*)(P->out + O_Y), P->in[17], P->in[18], (void*)(P->ws + WS_XB), P->ws + WS_X1F8, P->ws + WS_G, TIDX());
    GRID_SYNC();
    PH(8) {
        pg8::Order S; S.init(132, 21, G, bx);
        pg8::AMapUp<126> am{(const void*)(P->ws + WS_X1F8), 1024};
        EpiUp<false> E{P->ws + WS_G, nullptr, P->in[20], P->in[21], P->in[6], nullptr};
        pg8::gemm_phase<EpiUp<false>, pg8::AMapUp<126>, true>(lds, am, (const void*)(P->ws + WS_WUP8), 1024, S, E);
        pg8::Order S2; S2.init(2, 21, G, (bx + G - (2772 % G)) % G);
        pg8::AMapUp<128> am2{(const void*)(P->ws + WS_XB), 2048};
        EpiUp<true> E2{nullptr, (bf16_t*)(P->ws + WS_GS), P->in[20], P->in[21], P->in[6], P->out + O_FCS};
        pg8::gemm_phase<EpiUp<true>, pg8::AMapUp<128>>(lds, am2, (const void*)(P->ws + WS_WUP), 2048, S2, E2);
        small_ffnconv_prompt(P, lds, TIDX());
    }
    GRID_SYNC();
    PH(9) {
        pg8::AMapPlain am{(const void*)(P->ws + WS_G), DFF * 2}; pg8::Order S; S.init(128, 4, G, bx);
        EpiDown E{(const bf16_t*)(P->ws + WS_XB), (bf16_t*)(P->ws + WS_A2)};
        pg8::gemm_phase<EpiDown, pg8::AMapPlain>(lds, am, (const void*)(P->ws + WS_WDOWN), DFF * 2, S, E);
        small_down_splitk(P, lds, TIDX());
    }
    GRID_SYNC();
    PH(10) phase_ln<false>((const bf16_t*)(P->ws + WS_A2), P->in[23], P->in[24], (void*)(P->out + O_Y), nullptr, nullptr, TIDX());
    }
}

extern "C" void kernel_launch(void* const* d_in, const int* in_sizes, int n_in, void* d_out, int out_size, void* d_ws, size_t ws_size, hipStream_t stream) {
    static int grid_blocks = 0;
    if (!grid_blocks) {
        int dev = 0, cus = 0, per_cu = 0;
        hipGetDevice(&dev);
        hipDeviceGetAttribute(&cus, hipDeviceAttributeMultiprocessorCount, dev);
        hipFuncSetAttribute((const void*)hybrid_fwd, hipFuncAttributeMaxDynamicSharedMemorySize, LDS_BYTES);
        hipOccupancyMaxActiveBlocksPerMultiprocessor(&per_cu, (const void*)hybrid_fwd, NT, LDS_BYTES);
        if (per_cu < 1) per_cu = 1;
        if (per_cu > 1) per_cu = 1;
        grid_blocks = cus * per_cu;
        if (ws_size < WS_END) fprintf(stderr, "kernel_launch: workspace too small: %zu < %zu\n", ws_size, (size_t)WS_END);
    }
    Params p{};
    for (int i = 0; i < 25; ++i) p.in[i] = (const float*)d_in[i];
    p.out = (float*)d_out; p.ws = (unsigned char*)d_ws;
    hipMemsetAsync((unsigned char*)d_ws + WS_BAR, 0, 16384, stream);
    void* args[] = {&p};
    hipError_t e = hipLaunchCooperativeKernel((const void*)hybrid_fwd, dim3(grid_blocks), dim3(NT), args, LDS_BYTES, stream);
    if (e != hipSuccess) fprintf(stderr, "cooperative launch failed: %s (grid %d)\n", hipGetErrorString(e), grid_blocks);
}
```

```cpp
#include <hip/hip_runtime.h>
#include <hip/hip_cooperative_groups.h>
#include <cstdio>
namespace cg = cooperative_groups;

#define LAS __attribute__((address_space(3)))
typedef unsigned short bf16_t;
typedef short bf16x8 __attribute__((ext_vector_type(8)));
typedef short s16x4 __attribute__((ext_vector_type(4)));
typedef float f32x2 __attribute__((ext_vector_type(2)));
typedef float f32x4 __attribute__((ext_vector_type(4)));
typedef float f32x16 __attribute__((ext_vector_type(16)));
typedef unsigned u32x2 __attribute__((ext_vector_type(2)));
typedef unsigned u32x4 __attribute__((ext_vector_type(4)));
typedef __bf16 bf2_t __attribute__((ext_vector_type(2)));
typedef int i32x4 __attribute__((ext_vector_type(4)));
typedef int i32x8 __attribute__((ext_vector_type(8)));
#define DI __device__ __forceinline__

constexpr int MP = 32768, MS = 512, MT = MP + MS;
constexpr int DM = 1024, NIN = 3080, NINP = 3328, DFF = 2688, NUP = 5376;
constexpr int NCHUNK = 528;
constexpr float ALPHA = 1.189207115002721f;
constexpr float LOG2E = 1.4426950408889634f;
constexpr int NT = 512;
constexpr int LDS_BYTES = 147456;
constexpr int GP8 = 2816;
constexpr float SC_X1 = 16.f, SC_WUP = 64.f, SC_G = 8.f, SC_WDN = 128.f;

constexpr size_t O_Y = 0;
constexpr size_t O_NKP = (size_t)MT * 1024;
constexpr size_t O_NVP = O_NKP + 1048576;
constexpr size_t O_NKS = O_NVP + 1048576;
constexpr size_t O_NVS = O_NKS + 262144;
constexpr size_t O_SSP = O_NVS + 262144;
constexpr size_t O_SSS = O_SSP + 262144;
constexpr size_t O_SCP = O_SSS + 1048576;
constexpr size_t O_SCS = O_SCP + 12288;
constexpr size_t O_FCP = O_SCS + 49152;
constexpr size_t O_FCS = O_FCP + 43008;

constexpr size_t al256(size_t x) { return (x + 255) & ~(size_t)255; }
constexpr size_t WS_WIN = 0;
constexpr size_t WS_WOUT = WS_WIN + al256((size_t)NINP * 1024 * 2);
constexpr size_t WS_WUP = WS_WOUT + al256((size_t)1024 * 1024 * 2);
constexpr size_t WS_WDOWN = WS_WUP + al256((size_t)NUP * 1024 * 2);
constexpr size_t WS_WUP8 = WS_WDOWN + al256((size_t)1024 * DFF * 2);
constexpr size_t WS_WDN8 = WS_WUP8 + al256((size_t)NUP * 1024);
constexpr size_t WS_GS = WS_WDN8 + al256((size_t)1024 * GP8);
constexpr size_t WS_DT = WS_GS + al256((size_t)MS * DFF * 2);
constexpr size_t WS_DEC = WS_DT + al256((size_t)MT * 8 * 4);
constexpr size_t WS_BAR = WS_DEC + al256((size_t)NCHUNK * 8 * 4);
constexpr size_t WS_XB = WS_BAR + 16384 + 8192;
constexpr size_t WS_R3 = WS_XB + al256((size_t)(MT + 256) * 1024 * 2);
constexpr size_t WS_G = WS_R3;
constexpr size_t WS_X1F8 = WS_R3 + al256((size_t)MP * DFF * 2) + 8192;
constexpr size_t WS_Q = WS_R3;
constexpr size_t WS_KP = WS_Q + al256((size_t)MT * 512 * 2);
constexpr size_t WS_KS = WS_KP + al256((size_t)MP * 512 * 2);
constexpr size_t WS_VFP = WS_KS + al256((size_t)16 * 544 * 512 * 2);
constexpr size_t WS_VFS = WS_VFP + al256((size_t)4 * 8 * 512 * 1024 * 2);
constexpr size_t WS_Z = WS_VFS + al256((size_t)16 * 8 * 34 * 1024 * 2) + 65536;
constexpr size_t WS_XBC = WS_Z + al256((size_t)MT * 512 * 2);
constexpr size_t WS_A2 = WS_XBC + al256((size_t)MT * 1024 * 2);
constexpr size_t WS_ST = WS_A2 + al256((size_t)MT * 1024 * 2);
constexpr size_t WS_END = WS_ST + al256((size_t)NCHUNK * 65536 * 2);
static_assert(WS_X1F8 + (size_t)(MT + 256) * 1024 <= WS_A2, "G8/X1F8 alias");
static_assert(WS_A2 + (size_t)MT * 1024 * 4 <= WS_END, "U2 alias");

struct Params {
    const float* in[25];
    float* out;
    unsigned char* ws;
};
typedef const __attribute__((address_space(4))) Params* KP;

DI unsigned pk2(float lo, float hi) { f32x2 f = {lo, hi}; return __builtin_bit_cast(unsigned, __builtin_convertvector(f, bf2_t)); }
DI unsigned pk4_f8(float a, float b, float c, float d) { int w = 0; w = __builtin_amdgcn_cvt_pk_fp8_f32(a, b, w, false); w = __builtin_amdgcn_cvt_pk_fp8_f32(c, d, w, true); return (unsigned)w; }
DI float bf_lo(unsigned w) { return __uint_as_float(w << 16); }
DI float bf_hi(unsigned w) { return __uint_as_float(w & 0xffff0000u); }
DI float silu_f(float x) { return x * __builtin_amdgcn_rcpf(1.0f + __builtin_amdgcn_exp2f(-x * LOG2E)); }
DI int crow(int reg, int h) { return (reg & 3) + 8 * (reg >> 2) + 4 * h; }
#define MFMA32(a, b, c) __builtin_amdgcn_mfma_f32_32x32x16_bf16((a), (b), (c), 0, 0, 0)
DI bf16x8 pack8(float a0, float a1, float a2, float a3, float a4, float a5, float a6, float a7) {
    u32x4 p; p.x = pk2(a0, a1); p.y = pk2(a2, a3); p.z = pk2(a4, a5); p.w = pk2(a6, a7); return __builtin_bit_cast(bf16x8, p);
}
DI void pin(bf16x8& v) { asm volatile("" : "+v"(v)); }
DI void pin(u32x2& v) { asm volatile("" : "+v"(v)); }
DI void pin(f32x4& v) { asm volatile("" : "+v"(v)); }
DI bf16x8 tr_frag(LAS unsigned char* lo, LAS unsigned char* hi) {
    s16x4 a = __builtin_amdgcn_ds_read_tr16_b64_v4i16((LAS s16x4*)lo);
    s16x4 b = __builtin_amdgcn_ds_read_tr16_b64_v4i16((LAS s16x4*)hi);
    return __builtin_shufflevector(a, b, 0, 1, 2, 3, 4, 5, 6, 7);
}


#define XB_TMO      128
#define XB_XCNT(j)  (256  + 64 * (j))
#define XB_XSUB(j)  (1280 + 64 * (j))
#define XB_XGEN(j)  (2304 + 64 * (j))
#define XB_TOP      3328
#define XB_TOPGEN   3392
#define XCD_BAR_WORDS 3456
#define XB_SPIN_CAP (1u << 20)
DI unsigned xb_ld(unsigned* p)              { return __hip_atomic_load(p, __ATOMIC_RELAXED, __HIP_MEMORY_SCOPE_AGENT); }
DI unsigned xb_add(unsigned* p, unsigned v) { return __hip_atomic_fetch_add(p, v, __ATOMIC_RELAXED, __HIP_MEMORY_SCOPE_AGENT); }
DI unsigned xb_xcc_id() { return (unsigned)__builtin_amdgcn_s_getreg((3 << 11) | 20) & 0xFu; }
#define XB_SPIN(cond, bar) do { unsigned _sp = 0; while (cond) { __builtin_amdgcn_s_sleep(1); \
    if ((++_sp & 255u) == 0u) { if (xb_ld(&(bar)[XB_TMO])) break; if (_sp > XB_SPIN_CAP) { atomicAdd(&(bar)[XB_TMO], 1u); break; } } } } while (0)
struct XcdBarrier { unsigned* bar; unsigned x; volatile LAS unsigned* st; };
DI XcdBarrier xcd_barrier_post(unsigned* bar, volatile LAS unsigned* st) {
    XcdBarrier b; b.bar = bar; b.x = xb_xcc_id(); b.st = st;
    if (threadIdx.x == 0) (void)xb_add(&bar[XB_XCNT(b.x)], 1u);
    return b;
}
DI void xcd_barrier_complete(unsigned* bar, unsigned x, unsigned& nloc, unsigned& nx) {
    const unsigned G = gridDim.x * gridDim.y * gridDim.z;
    unsigned sum, cnt, mine, sp = 0u;
    for (;;) {
        sum = 0u; cnt = 0u; mine = 0u;
#pragma unroll
        for (unsigned j = 0; j < 16; ++j) { const unsigned c = xb_ld(&bar[XB_XCNT(j)]); sum += c; cnt += (c > 0u) ? 1u : 0u; mine = (j == x) ? c : mine; }
        if (sum == G) break;
        __builtin_amdgcn_s_sleep(1);
        if ((++sp & 255u) == 0u) { if (xb_ld(&bar[XB_TMO])) break; if (sp > XB_SPIN_CAP) { atomicAdd(&bar[XB_TMO], 1u); break; } }
    }
    nloc = mine > 0u ? mine : 1u; nx = cnt > 0u ? cnt : 1u;
}
DI void xcd_barrier(const XcdBarrier& b, int tid_in) {
    asm volatile("s_waitcnt vmcnt(0)" ::: "memory");
    __syncthreads();
    if (tid_in == 0) {
        unsigned* bar = b.bar;
        __builtin_amdgcn_s_waitcnt(0);
        unsigned nloc = b.st[0], nx = b.st[1];
        if (nloc == 0u) { xcd_barrier_complete(bar, b.x, nloc, nx); b.st[0] = nloc; b.st[1] = nx; }
        const unsigned old = xb_add(&bar[XB_XSUB(b.x)], 1u);
        const unsigned gen = old / nloc;
        if (old + 1u == (gen + 1u) * nloc) {
            __builtin_amdgcn_fence(__ATOMIC_RELEASE, "agent");
            asm volatile("s_waitcnt vmcnt(0)" ::: "memory");
            const unsigned og = xb_add(&bar[XB_TOP], 1u);
            const unsigned tg = og / nx;
            if (og + 1u == (tg + 1u) * nx) xb_add(&bar[XB_TOPGEN], 1u);
            else XB_SPIN(xb_ld(&bar[XB_TOPGEN]) == tg, bar);
            __builtin_amdgcn_fence(__ATOMIC_ACQUIRE, "agent");
            xb_add(&bar[XB_XGEN(b.x)], 1u);
            asm volatile("s_waitcnt vmcnt(0)" ::: "memory");
        } else {
            XB_SPIN(xb_ld(&bar[XB_XGEN(b.x)]) == gen, bar);
            __builtin_amdgcn_fence(__ATOMIC_ACQUIRE, "agent");
            asm volatile("s_waitcnt vmcnt(0)" ::: "memory");
        }
    }
    __syncthreads();
}

namespace pg8 {
constexpr int BM = 256, BK = 64, HALF = 128, HTB = HALF * BK * 2, NXCD = 8, WGM = 8;
DI int lds_byte(int r, int c) { const int st = (r >> 4) * 2 + (c >> 5), rr = r & 15, cc = c & 31, ob = rr * 64 + cc * 2; return st * 1024 + (ob ^ (((ob >> 9) & 1) << 5)); }
DI void stage_rc(int b, int& R, int& C) { const int st = b / 1024, sb = b % 1024, swz = sb ^ (((sb >> 9) & 1) << 5); R = (st >> 1) * 16 + swz / 64; C = (st & 1) * 32 + (swz % 64) / 2; }
DI int perm32(int rho) { const int n = rho >> 4, i = rho & 15; return 8 * (i >> 2) + 4 * n + (i & 3); }
struct Unit { int pm, pn; };
struct Order {
    int nM, nN, nwg, G, c;
    DI void init(int nM_, int nN_, int G_, int c_) { nM = nM_; nN = nN_; nwg = nM * nN; G = G_; c = c_; }
    DI bool next(int i, Unit& u) const {
        const long L = (long)i * G + c; if (L >= nwg) return false;
        int wgid = (int)L; { const int q = nwg / NXCD, r = nwg % NXCD, xcd = wgid % NXCD, off = wgid / NXCD; wgid = (xcd < r ? xcd * (q + 1) : r * (q + 1) + (xcd - r) * q) + off; }
        const int nig = WGM * nN, gid = wgid / nig, fm = gid * WGM, gsz = (nM - fm) < WGM ? (nM - fm) : WGM;
        u.pm = fm + ((wgid % nig) % gsz); u.pn = (wgid % nig) / gsz; return true;
    }
};
struct AMapPlain {
    const void* A; int pitch;
    DI const char* unit_base(int pm) const { return (const char*)A + (size_t)pm * 256 * pitch; }
    DI size_t hstep() const { return (size_t)HALF * pitch; }
    DI unsigned voff(int R, int Cb) const { return (unsigned)(R * pitch + Cb); }
};
template <int WRS> struct AMapUp {
    const void* A; int pitch;
    DI const char* unit_base(int pm) const {
        if (WRS == 126) { const int b = pm / 33, ti = pm - b * 33; return (const char*)A + ((long)b * 8192 + ti * 252 - 2) * pitch; }
        return (const char*)A + ((long)MP + pm * 256) * pitch;
    }
    DI size_t hstep() const { return (size_t)4 * pitch; }
    DI unsigned voff(int R, int Cb) const { return (unsigned)((((R >> 6) * WRS + (R & 15) * 8 + ((R >> 4) & 3)) * pitch) + Cb); }
};

template <class Epi, class AMap, bool F8 = false>
DI void gemm_phase(LAS unsigned char* lds, const AMap am, const void* Bt, const int Kb, const Order& S, const Epi& E) {
    int tid = threadIdx.x; asm volatile("" : "+v"(tid));
    const int wid = __builtin_amdgcn_readfirstlane(tid >> 6), lane = tid & 63, wr = wid >> 2, wc = wid & 3, fr = lane & 15, fq = lane >> 4;
    const int nt = Kb / 128;
    unsigned voffA, voffB; size_t dA2, dB2;
    { int R, C; stage_rc(tid * 16, R, C); const int Rb = Epi::PERM ? ((R & ~31) + perm32(R & 31)) : R;
      voffA = am.voff(R, 2 * C); voffB = (unsigned)(Rb * Kb + 2 * C); dA2 = (size_t)(am.voff(64, 0) - am.voff(0, 0)); dB2 = (size_t)64 * Kb; }
    const size_t kstep = (size_t)128;
    const size_t hstepA = am.hstep();
    const size_t hstepB = (size_t)HALF * Kb;
    const size_t tstepB = 2 * hstepB;
    const unsigned ldsw = (unsigned)wid * 1024u;
    constexpr int QOFF = F8 ? 16 : 1024;
    const int aoff = F8 ? lds_byte(wr * 64 + fr, 16 * (fq & 1)) + 1024 * (fq >> 1) : lds_byte(wr * 64 + fr, fq * 8);
    const int boff = F8 ? lds_byte(wc * 32 + fr, 16 * (fq & 1)) + 1024 * (fq >> 1) : lds_byte(wc * 32 + fr, fq * 8);
#define PG8_SA(b, h) (((b) * 2 + (h)) * HTB)
#define PG8_SB(b, h) ((4 + (b) * 2 + (h)) * HTB)
#define PG8_STAGE(bufoff, gbase, voff) do { \
        __builtin_amdgcn_global_load_lds((const unsigned*)((const char*)(gbase) + (voff)), (LAS unsigned*)(lds + (bufoff) + ldsw), 16, 0, 0); \
        __builtin_amdgcn_global_load_lds((const unsigned*)((const char*)(gbase) + d2_##voff + (voff)), (LAS unsigned*)(lds + (bufoff) + ldsw + 8192), 16, 0, 0); } while (0)
#define d2_voffA dA2
#define d2_voffB dB2
#define PG8_LDA(dst, b, h) do { _Pragma("unroll") for (int m = 0; m < 4; ++m) { const i32x4 lo_ = *(const LAS i32x4*)(lds + PG8_SA(b, h) + aoff + m * 2048), hi_ = *(const LAS i32x4*)(lds + PG8_SA(b, h) + aoff + QOFF + m * 2048); \
        dst[m] = __builtin_shufflevector(lo_, hi_, 0, 1, 2, 3, 4, 5, 6, 7); } } while (0)
#define PG8_LDB(dst, b, h) do { _Pragma("unroll") for (int n = 0; n < 2; ++n) { const i32x4 lo_ = *(const LAS i32x4*)(lds + PG8_SB(b, h) + boff + n * 2048), hi_ = *(const LAS i32x4*)(lds + PG8_SB(b, h) + boff + QOFF + n * 2048); \
        dst[n] = __builtin_shufflevector(lo_, hi_, 0, 1, 2, 3, 4, 5, 6, 7); } } while (0)
#define PG8_HALF(v, k) __builtin_bit_cast(bf16x8, __builtin_shufflevector(v, v, 4 * (k), 4 * (k) + 1, 4 * (k) + 2, 4 * (k) + 3))
#define PG8_MMA(ai, bj, At, Bt_) do { __builtin_amdgcn_s_setprio(1); _Pragma("unroll") for (int m = 0; m < 4; ++m) _Pragma("unroll") for (int n = 0; n < 2; ++n) { \
        if (F8) acc[ai][bj][m][n] = __builtin_amdgcn_mfma_scale_f32_16x16x128_f8f6f4(Bt_[n], At[m], acc[ai][bj][m][n], 0, 0, 0, 0, 0, 0); \
        else { acc[ai][bj][m][n] = __builtin_amdgcn_mfma_f32_16x16x32_bf16(PG8_HALF(Bt_[n], 0), PG8_HALF(At[m], 0), acc[ai][bj][m][n], 0, 0, 0); \
               acc[ai][bj][m][n] = __builtin_amdgcn_mfma_f32_16x16x32_bf16(PG8_HALF(Bt_[n], 1), PG8_HALF(At[m], 1), acc[ai][bj][m][n], 0, 0, 0); } } \
        __builtin_amdgcn_s_setprio(0); } while (0)
#define PG8_WAIT_V(n) asm volatile("s_waitcnt vmcnt(" #n ")" ::: "memory")
#define PG8_WAIT_L(n) asm volatile("s_waitcnt lgkmcnt(" #n ")" ::: "memory")
#define PG8_BAR __builtin_amdgcn_s_barrier()
#define PG8_SCHED __builtin_amdgcn_sched_barrier(0)
    Unit cur, nxt; int ui = 0;
    if (!S.next(0, cur)) return;
    f32x4 acc[2][2][4][2];
#pragma unroll
    for (int a = 0; a < 2; ++a)
#pragma unroll
        for (int b = 0; b < 2; ++b)
#pragma unroll
            for (int m = 0; m < 4; ++m)
#pragma unroll
                for (int n = 0; n < 2; ++n) acc[a][b][m][n] = (f32x4){0.f, 0.f, 0.f, 0.f};
    i32x8 At[4], B0[2], B1[2];
    const char* cA = am.unit_base(cur.pm); const char* cB = (const char*)Bt + (size_t)cur.pn * tstepB;
    PG8_STAGE(PG8_SB(0, 0), cB, voffB); PG8_STAGE(PG8_SA(0, 0), cA, voffA); PG8_STAGE(PG8_SB(0, 1), cB + hstepB, voffB); PG8_STAGE(PG8_SA(0, 1), cA + hstepA, voffA);
    if (wr == 1) PG8_BAR;
    PG8_WAIT_V(4); PG8_BAR;
    PG8_STAGE(PG8_SB(1, 0), cB + kstep, voffB); PG8_STAGE(PG8_SA(1, 0), cA + kstep, voffA); PG8_STAGE(PG8_SB(1, 1), cB + hstepB + kstep, voffB);
    PG8_WAIT_V(6); PG8_BAR;
    for (;;) {
        const bool has_next = S.next(ui + 1, nxt);
        const char* nA = has_next ? am.unit_base(nxt.pm) : cA; const char* nB = has_next ? (const char*)Bt + (size_t)nxt.pn * tstepB : cB;
        for (int t = 0; t < nt; t += 2) {
            const bool last = (t == nt - 2);
            const char* a1 = cA + (size_t)(t + 1) * kstep;
            const char* a2 = last ? nA : cA + (size_t)(t + 2) * kstep; const char* b2 = last ? nB : cB + (size_t)(t + 2) * kstep;
            const char* a3 = a2 + kstep; const char* b3 = b2 + kstep;
            PG8_LDB(B0, 0, 0); PG8_SCHED; PG8_LDA(At, 0, 0); PG8_STAGE(PG8_SA(1, 1), a1 + hstepA, voffA);
            PG8_WAIT_L(8); PG8_BAR; PG8_WAIT_L(0); PG8_MMA(0, 0, At, B0); PG8_BAR; PG8_SCHED;
            PG8_LDB(B1, 0, 1); PG8_STAGE(PG8_SB(0, 0), b2, voffB);
            PG8_BAR; PG8_WAIT_L(0); PG8_MMA(0, 1, At, B1); PG8_BAR;
            PG8_LDA(At, 0, 1); PG8_STAGE(PG8_SA(0, 0), a2, voffA);
            PG8_BAR; PG8_WAIT_L(0); PG8_MMA(1, 0, At, B0); PG8_BAR; PG8_SCHED;
            PG8_STAGE(PG8_SB(0, 1), b2 + hstepB, voffB);
            PG8_WAIT_V(6); PG8_BAR; PG8_MMA(1, 1, At, B1); PG8_BAR;
            PG8_LDB(B0, 1, 0); PG8_SCHED; PG8_LDA(At, 1, 0); PG8_STAGE(PG8_SA(0, 1), a2 + hstepA, voffA);
            PG8_WAIT_L(8); PG8_BAR; PG8_WAIT_L(0); PG8_MMA(0, 0, At, B0); PG8_BAR; PG8_SCHED;
            PG8_LDB(B1, 1, 1); PG8_STAGE(PG8_SB(1, 0), b3, voffB);
            PG8_BAR; PG8_WAIT_L(0); PG8_MMA(0, 1, At, B1); PG8_BAR;
            PG8_LDA(At, 1, 1); PG8_STAGE(PG8_SA(1, 0), a3, voffA);
            PG8_BAR; PG8_WAIT_L(0); PG8_MMA(1, 0, At, B0); PG8_BAR; PG8_SCHED;
            PG8_STAGE(PG8_SB(1, 1), b3 + hstepB, voffB);
            PG8_WAIT_V(6); PG8_BAR; PG8_MMA(1, 1, At, B1); PG8_BAR;
        }
        { unsigned z_ = 0u; asm volatile("" : "+s"(z_)); int l2_ = (int)__builtin_amdgcn_mbcnt_hi(~0u, __builtin_amdgcn_mbcnt_lo(~0u, z_)); asm volatile("" : "+v"(l2_));
          E(acc, cur, wr, wc, l2_ & 15, l2_ >> 4); }
        if (!has_next) break;
#pragma unroll
        for (int a = 0; a < 2; ++a)
#pragma unroll
            for (int b = 0; b < 2; ++b)
#pragma unroll
                for (int m = 0; m < 4; ++m)
#pragma unroll
                    for (int n = 0; n < 2; ++n) acc[a][b][m][n] = (f32x4){0.f, 0.f, 0.f, 0.f};
        cur = nxt; cA = nA; cB = nB; ++ui;
    }
    PG8_WAIT_V(0);
    if (wr == 0) PG8_BAR;
    PG8_BAR;
#undef PG8_SA
#undef PG8_SB
#undef PG8_STAGE
#undef d2_voffA
#undef d2_voffB
#undef PG8_LDA
#undef PG8_LDB
#undef PG8_HALF
#undef PG8_MMA
#undef PG8_WAIT_V
#undef PG8_WAIT_L
#undef PG8_BAR
#undef PG8_SCHED
}
}

typedef f32x4 AccT[2][2][4][2];

struct EpiInProj {
    static constexpr bool PERM = true;
    float* out; unsigned char* ws;
    DI void operator()(const AccT& acc, const pg8::Unit& u, int wr, int wc, int fr, int fq) const {
        const int pn = u.pn, r0 = u.pm * 256 + wr * 64 + fr, ct = wc * 32 + 8 * fq;
        const bool samp = u.pm >= 128;
        if (pn == 12) {
            if (wc == 0 && fq == 0) {
                float* DT = (float*)(ws + WS_DT);
#pragma unroll
                for (int ai = 0; ai < 2; ++ai)
#pragma unroll
                    for (int m = 0; m < 4; ++m) { const int row = r0 + ai * 128 + m * 16;
                        *(f32x4*)(DT + (size_t)row * 8) = acc[ai][0][m][0]; *(f32x4*)(DT + (size_t)row * 8 + 4) = acc[ai][0][m][1]; }
            }
            return;
        }
#pragma unroll
        for (int ai = 0; ai < 2; ++ai)
#pragma unroll
            for (int m = 0; m < 4; ++m) {
                const int row = r0 + ai * 128 + m * 16;
                const int rs = row - MP, sb = rs >> 5, st = rs & 31;
                const int pb = row >> 13, pt = row & 8191;
#pragma unroll
                for (int bj = 0; bj < 2; ++bj) {
                    const f32x4 v0 = acc[ai][bj][m][0], v1 = acc[ai][bj][m][1];
                    u32x4 w; w.x = pk2(v0[0], v0[1]); w.y = pk2(v0[2], v0[3]); w.z = pk2(v1[0], v1[1]); w.w = pk2(v1[2], v1[3]);
                    const int ctile = bj * 128 + ct;
                    if (pn < 2) {
                        *(u32x4*)((bf16_t*)(ws + WS_Q) + (size_t)row * 512 + pn * 256 + ctile) = w;
                    } else if (pn < 4) {
                        const int col = (pn - 2) * 256 + ctile;
                        if (!samp) {
                            *(u32x4*)((bf16_t*)(ws + WS_KP) + (size_t)row * 512 + col) = w;
                            if (pt >= 7680) { float* o = out + O_NKP + ((size_t)(pb * 512 + pt - 7680)) * 512 + col; *(f32x4*)o = v0; *(f32x4*)(o + 4) = v1; }
                        } else {
                            *(u32x4*)((bf16_t*)(ws + WS_KS) + ((size_t)sb * 544 + 512 + st) * 512 + col) = w;
                            float* o = out + O_NKS + (size_t)rs * 512 + col; *(f32x4*)o = v0; *(f32x4*)(o + 4) = v1;
                        }
                    } else if (pn < 6) {
                        const int col = (pn - 4) * 256 + ctile, head = col >> 6, d0 = col & 63;
                        bf16_t* vb; int t;
                        if (!samp) { t = pt; vb = (bf16_t*)(ws + WS_VFP) + ((size_t)(pb * 8 + head) * 512 + (t >> 4)) * 1024;
                            if (pt >= 7680) { float* o = out + O_NVP + ((size_t)(pb * 512 + pt - 7680)) * 512 + col; *(f32x4*)o = v0; *(f32x4*)(o + 4) = v1; } }
                        else { t = 512 + st; vb = (bf16_t*)(ws + WS_VFS) + ((size_t)(sb * 8 + head) * 34 + (t >> 4)) * 1024;
                            float* o = out + O_NVS + (size_t)rs * 512 + col; *(f32x4*)o = v0; *(f32x4*)(o + 4) = v1; }
                        const int tt = t & 15, hh = (tt >> 2) & 1, jj = ((tt >> 3) << 2) | (tt & 3);
                        bf16_t* p = vb + (hh * 64 + d0) * 8 + jj;
                        p[0] = (bf16_t)(w.x & 0xffff); p[8] = (bf16_t)(w.x >> 16); p[16] = (bf16_t)(w.y & 0xffff); p[24] = (bf16_t)(w.y >> 16);
                        p[32] = (bf16_t)(w.z & 0xffff); p[40] = (bf16_t)(w.z >> 16); p[48] = (bf16_t)(w.w & 0xffff); p[56] = (bf16_t)(w.w >> 16);
                    } else if (pn < 8) {
                        *(u32x4*)((bf16_t*)(ws + WS_Z) + (size_t)row * 512 + (pn - 6) * 256 + ctile) = w;
                    } else {
                        const int col = (pn - 8) * 256 + ctile;
                        *(u32x4*)((bf16_t*)(ws + WS_XBC) + (size_t)row * 1024 + col) = w;
                        if (!samp) { if (pt >= 8189) { float* o = out + O_SCP + ((size_t)(pb * 3 + pt - 8189)) * 1024 + col; *(f32x4*)o = v0; *(f32x4*)(o + 4) = v1; } }
                        else { if (st >= 29) { float* o = out + O_SCS + ((size_t)(sb * 3 + st - 29)) * 1024 + col; *(f32x4*)o = v0; *(f32x4*)(o + 4) = v1; } }
                    }
                }
            }
    }
};

struct EpiOutProj {
    static constexpr bool PERM = false;
    const float* xp; const float* xs; bf16_t* U;
    DI void operator()(const AccT& acc, const pg8::Unit& u, int wr, int wc, int fr, int fq) const {
        const int r0 = u.pm * 256 + wr * 64 + fr, c0 = u.pn * 256 + wc * 32 + 4 * fq;
#pragma unroll
        for (int ai = 0; ai < 2; ++ai) {
            f32x4 xv[4][2][2];
#pragma unroll
            for (int m = 0; m < 4; ++m) { const int row = r0 + ai * 128 + m * 16; const float* xr = (row < MP) ? xp + (size_t)row * 1024 : xs + (size_t)(row - MP) * 1024;
#pragma unroll
                for (int bj = 0; bj < 2; ++bj)
#pragma unroll
                    for (int n = 0; n < 2; ++n) xv[m][bj][n] = __builtin_nontemporal_load((const f32x4*)(xr + c0 + bj * 128 + n * 16)); }
#pragma unroll
            for (int m = 0; m < 4; ++m)
#pragma unroll
                for (int bj = 0; bj < 2; ++bj)
#pragma unroll
                    for (int n = 0; n < 2; ++n) pin(xv[m][bj][n]);
#pragma unroll
            for (int m = 0; m < 4; ++m) { const int row = r0 + ai * 128 + m * 16; bf16_t* ur = U + (size_t)row * 1024;
#pragma unroll
                for (int bj = 0; bj < 2; ++bj)
#pragma unroll
                    for (int n = 0; n < 2; ++n) { const f32x4 o = xv[m][bj][n] * ALPHA + acc[ai][bj][m][n];
                        u32x2 w; w.x = pk2(o[0], o[1]); w.y = pk2(o[2], o[3]); *(u32x2*)(ur + c0 + bj * 128 + n * 16) = w; } }
        }
    }
};
struct EpiDown {
    static constexpr bool PERM = false;
    const bf16_t* X1; bf16_t* U;
    DI void operator()(const AccT& acc, const pg8::Unit& u, int wr, int wc, int fr, int fq) const {
        const int r0 = u.pm * 256 + wr * 64 + fr, c0 = u.pn * 256 + wc * 32 + 4 * fq;
        u32x2 xw[2][4][2][2];
#pragma unroll
        for (int ai = 0; ai < 2; ++ai)
#pragma unroll
            for (int m = 0; m < 4; ++m) { const bf16_t* xr = X1 + (size_t)(r0 + ai * 128 + m * 16) * 1024;
#pragma unroll
                for (int bj = 0; bj < 2; ++bj)
#pragma unroll
                    for (int n = 0; n < 2; ++n) xw[ai][m][bj][n] = *(const u32x2*)(xr + c0 + bj * 128 + n * 16); }
#pragma unroll
        for (int ai = 0; ai < 2; ++ai)
#pragma unroll
            for (int m = 0; m < 4; ++m)
#pragma unroll
                for (int bj = 0; bj < 2; ++bj)
#pragma unroll
                    for (int n = 0; n < 2; ++n) pin(xw[ai][m][bj][n]);
#pragma unroll
        for (int ai = 0; ai < 2; ++ai)
#pragma unroll
            for (int m = 0; m < 4; ++m) { bf16_t* ur = U + (size_t)(r0 + ai * 128 + m * 16) * 1024;
#pragma unroll
                for (int bj = 0; bj < 2; ++bj)
#pragma unroll
                    for (int n = 0; n < 2; ++n) { const u32x2 w = xw[ai][m][bj][n];
                        const f32x4 xv = {bf_lo(w.x), bf_hi(w.x), bf_lo(w.y), bf_hi(w.y)}; const f32x4 o = xv * ALPHA + acc[ai][bj][m][n];
                        u32x2 wo; wo.x = pk2(o[0], o[1]); wo.y = pk2(o[2], o[3]); *(u32x2*)(ur + c0 + bj * 128 + n * 16) = wo; } }
    }
};

DI float dpp_shr1(float v) { return __builtin_bit_cast(float, __builtin_amdgcn_update_dpp(0, __builtin_bit_cast(int, v), 0x111, 0xf, 0xf, false)); }
template <bool SAMP> struct EpiUp {
    static constexpr bool PERM = true;
    unsigned char* G8; bf16_t* GS; const float* cw; const float* cb; const float* past; float* onf;
    DI void operator()(const AccT& acc, const pg8::Unit& u, int wr, int wc, int fr, int fq) const {
        const int colv = u.pn * 128 + wc * 32 + 8 * fq;
        int bb, tb; long grow0;
        if (!SAMP) { bb = u.pm / 33; const int ti = u.pm - bb * 33; tb = ti * 252 + wr * 126 + fr * 8 - 2; grow0 = (long)bb * 8192 + tb; }
        else { const int lg = wr * 16 + fr; bb = u.pm * 8 + (lg >> 2); tb = (lg & 3) * 8; grow0 = (long)bb * 32 + tb; }
        const bool first = SAMP ? ((fr & 3) == 0) : (fr == 0);
        const float asc = SAMP ? 1.0f : 1.0f / (SC_X1 * SC_WUP);
        f32x4 nw[8];
#pragma unroll
        for (int q = 0; q < 8; ++q) nw[q] = *(const f32x4*)((q & 3) == 3 ? cb + (q >> 2) * DFF + colv : cw + (q & 3) * NUP + (q >> 2) * DFF + colv);
#pragma unroll
        for (int n = 0; n < 2; ++n) {
            const int cv = colv + 4 * n, cgt = DFF + cv;
            const f32x4 wv0 = nw[0], wv1 = nw[1], wv2 = nw[2], bv = nw[3], wg0 = nw[4], wg1 = nw[5], wg2 = nw[6], bg = nw[7];
            f32x4 hv[8], hg[8];
#pragma unroll
            for (int tau = 0; tau < 8; ++tau) { hv[tau] = acc[tau >> 2][0][tau & 3][n] * asc; hg[tau] = acc[tau >> 2][1][tau & 3][n] * asc; }
            if (SAMP) {
                if ((fr & 3) == 3) { float* o = onf + ((size_t)(bb * 2)) * NUP; *(f32x4*)(o + cv) = hv[6]; *(f32x4*)(o + cgt) = hg[6]; *(f32x4*)(o + NUP + cv) = hv[7]; *(f32x4*)(o + NUP + cgt) = hg[7]; }
            }
            if (!SAMP) { if (tb < 0) { hv[0] = (f32x4){0.f, 0.f, 0.f, 0.f}; hv[1] = hv[0]; hg[0] = hv[0]; hg[1] = hv[0]; } }
            f32x4 pv2, pv1, pg2, pg1;
#pragma unroll
            for (int j = 0; j < 4; ++j) { pv2[j] = dpp_shr1(hv[6][j]); pv1[j] = dpp_shr1(hv[7][j]); pg2[j] = dpp_shr1(hg[6][j]); pg1[j] = dpp_shr1(hg[7][j]); }
            if (SAMP) { if (first) { const float* ps = past + (size_t)bb * 2 * NUP; pv2 = *(const f32x4*)(ps + cv); pv1 = *(const f32x4*)(ps + NUP + cv); pg2 = *(const f32x4*)(ps + cgt); pg1 = *(const f32x4*)(ps + NUP + cgt); } }
#pragma unroll
            for (int tau = 0; tau < 8; ++tau) {
                if (n == 0 && tau == 5) {
#pragma unroll
                    for (int q = 0; q < 8; ++q) nw[q] = *(const f32x4*)((q & 3) == 3 ? cb + (q >> 2) * DFF + colv + 4 : cw + (q & 3) * NUP + (q >> 2) * DFF + colv + 4); }
                const f32x4 a2v = (tau >= 2) ? hv[tau >= 2 ? tau - 2 : 0] : (tau == 0 ? pv2 : pv1);
                const f32x4 a1v = (tau >= 1) ? hv[tau >= 1 ? tau - 1 : 0] : pv1;
                const f32x4 a2g = (tau >= 2) ? hg[tau >= 2 ? tau - 2 : 0] : (tau == 0 ? pg2 : pg1);
                const f32x4 a1g = (tau >= 1) ? hg[tau >= 1 ? tau - 1 : 0] : pg1;
                const f32x4 ov = bv + wv0 * a2v + wv1 * a1v + wv2 * hv[tau];
                const f32x4 og = bg + wg0 * a2g + wg1 * a1g + wg2 * hg[tau];
                const float g0 = ov[0] * silu_f(og[0]), g1 = ov[1] * silu_f(og[1]), g2 = ov[2] * silu_f(og[2]), g3 = ov[3] * silu_f(og[3]);
                if (!SAMP) { const int t = tb + tau; const bool ok = (t >= 0) && (t < 8192) && (fr > 0 || tau >= 2);
                    const unsigned off = ok ? (unsigned)(((int)grow0 + tau) * DFF + cv) * 2u : (unsigned)((size_t)MP * DFF * 2) + (unsigned)(fr + 16 * fq) * 8u;
                    u32x2 w; w.x = pk2(g0, g1); w.y = pk2(g2, g3); *(u32x2*)(G8 + off) = w; }
                else { u32x2 w; w.x = pk2(g0, g1); w.y = pk2(g2, g3); *(u32x2*)(GS + (size_t)(grow0 + tau) * DFF + cv) = w; }
            }
        }
    }
};

DI f32x16 small_block_p(const bf16_t* xp, const bf16_t* wp, int K);
DI f32x16 small_block(const bf16_t* X, const bf16_t* Wt, int K, int row0, int col0, int lane) {
    const int r = lane & 31, h2 = lane >> 5;
    return small_block_p(X + (size_t)(row0 + r) * K + 8 * h2, Wt + (size_t)(col0 + r) * K + 8 * h2, K);
}
DI f32x16 small_block_p(const bf16_t* xp, const bf16_t* wp, int K) {
    f32x16 acc;
#pragma unroll
    for (int i = 0; i < 16; ++i) acc[i] = 0.f;
    int k0 = 0;
#pragma unroll 1
    for (; k0 + 256 <= K; k0 += 256) {
        bf16x8 a[16], b[16];
#pragma unroll
        for (int j = 0; j < 16; ++j) { a[j] = *(const bf16x8*)(wp + k0 + 16 * j); b[j] = *(const bf16x8*)(xp + k0 + 16 * j); }
#pragma unroll
        for (int j = 0; j < 16; ++j) { pin(a[j]); pin(b[j]); }
#pragma unroll
        for (int j = 0; j < 16; ++j) acc = MFMA32(a[j], b[j], acc);
    }
    if (k0 < K) {
        bf16x8 a[8], b[8];
#pragma unroll
        for (int j = 0; j < 8; ++j) { a[j] = *(const bf16x8*)(wp + k0 + 16 * j); b[j] = *(const bf16x8*)(xp + k0 + 16 * j); }
#pragma unroll
        for (int j = 0; j < 8; ++j) { pin(a[j]); pin(b[j]); }
#pragma unroll
        for (int j = 0; j < 8; ++j) acc = MFMA32(a[j], b[j], acc);
    }
    return acc;
}
DI void small_inproj(KP P) {
    int tid = threadIdx.x; asm volatile("" : "+v"(tid));
    const int lane = tid & 63, wave = tid >> 6, gw = blockIdx.x * 8 + wave, NGW = gridDim.x * 8, r = lane & 31, h2 = lane >> 5;
    const bf16_t* XB = (const bf16_t*)(P->ws + WS_XB); const bf16_t* WI = (const bf16_t*)(P->ws + WS_WIN);
    float* DT = (float*)(P->ws + WS_DT); float* out = P->out;
    for (int task = gw; task < 1024 + 16 * 97; task += NGW) {
        if (task < 1024) {
            const f32x16 acc = small_block(XB, WI, 1024, task * 32, 3072, lane);
            *(f32x4*)(DT + (size_t)(task * 32 + r) * 8 + 4 * h2) = (f32x4){acc[0], acc[1], acc[2], acc[3]};
            continue;
        }
        const int t2 = task - 1024, sb = t2 / 97, cb = t2 - sb * 97, row = MP + sb * 32 + r, col0 = cb * 32;
        const f32x16 acc = small_block(XB, WI, 1024, MP + sb * 32, col0, lane);
#pragma unroll
        for (int g = 0; g < 4; ++g) {
            const int col = col0 + 8 * g + 4 * h2; const f32x4 v = {acc[4 * g], acc[4 * g + 1], acc[4 * g + 2], acc[4 * g + 3]};
            u32x2 w; w.x = pk2(v[0], v[1]); w.y = pk2(v[2], v[3]);
            if (col < 512) *(u32x2*)((bf16_t*)(P->ws + WS_Q) + (size_t)row * 512 + col) = w;
            else if (col < 1024) { *(u32x2*)((bf16_t*)(P->ws + WS_KS) + ((size_t)sb * 544 + 512 + r) * 512 + col - 512) = w; *(f32x4*)(out + O_NKS + (size_t)(sb * 32 + r) * 512 + col - 512) = v; }
            else if (col < 1536) { const int c = col - 1024, head = c >> 6, d0 = c & 63, t = 512 + r, tt = t & 15, hh = (tt >> 2) & 1, jj = ((tt >> 3) << 2) | (tt & 3);
                bf16_t* p = (bf16_t*)(P->ws + WS_VFS) + ((size_t)(sb * 8 + head) * 34 + (t >> 4)) * 1024 + (hh * 64 + d0) * 8 + jj;
                p[0] = (bf16_t)(w.x & 0xffff); p[8] = (bf16_t)(w.x >> 16); p[16] = (bf16_t)(w.y & 0xffff); p[24] = (bf16_t)(w.y >> 16);
                *(f32x4*)(out + O_NVS + (size_t)(sb * 32 + r) * 512 + c) = v; }
            else if (col < 2048) *(u32x2*)((bf16_t*)(P->ws + WS_Z) + (size_t)row * 512 + col - 1536) = w;
            else if (col < 3072) { *(u32x2*)((bf16_t*)(P->ws + WS_XBC) + (size_t)row * 1024 + col - 2048) = w;
                if (r >= 29) *(f32x4*)(out + O_SCS + ((size_t)(sb * 3 + r - 29)) * 1024 + col - 2048) = v; }
            else if (col < 3080) *(f32x4*)(DT + (size_t)row * 8 + col - 3072) = v;
        }
    }
}
DI void small_down_splitk(KP P, LAS unsigned char* lds, int tid_in) {
    int tid = tid_in; asm volatile("" : "+v"(tid));
    const int lane = tid & 63, wave = __builtin_amdgcn_readfirstlane(tid >> 6), r = lane & 31, h2 = lane >> 5;
    const int tl = wave / 3, kq = wave - 3 * tl;
    const bf16_t* X = (const bf16_t*)(P->ws + WS_GS); const bf16_t* Wt = (const bf16_t*)(P->ws + WS_WDOWN);
    LAS float* part = (LAS float*)lds;
    for (int pair = blockIdx.x; pair < 256; pair += gridDim.x) {
        const int task = pair * 2 + tl, sb = task >> 5, cb = task & 31, col0 = cb * 32;
        __syncthreads();
        if (tl < 2) {
            const f32x16 acc = small_block_p(X + (size_t)(sb * 32 + r) * DFF + kq * 896 + 8 * h2, Wt + (size_t)(col0 + r) * DFF + kq * 896 + 8 * h2, 896);
#pragma unroll
            for (int i = 0; i < 16; ++i) part[((tl * 3 + kq) * 16 + i) * 64 + lane] = acc[i];
        }
        __syncthreads();
        if (tl < 2 && kq == 0) {
            const int row = MP + sb * 32 + r;
#pragma unroll
            for (int g = 0; g < 4; ++g) {
                f32x4 v;
#pragma unroll
                for (int e = 0; e < 4; ++e) { const int i = 4 * g + e; v[e] = part[((tl * 3 + 0) * 16 + i) * 64 + lane] + part[((tl * 3 + 1) * 16 + i) * 64 + lane] + part[((tl * 3 + 2) * 16 + i) * 64 + lane]; }
                const int col = col0 + 8 * g + 4 * h2;
                const u32x2 w = *(const u32x2*)((const bf16_t*)(P->ws + WS_XB) + (size_t)row * 1024 + col); const f32x4 xv = {bf_lo(w.x), bf_hi(w.x), bf_lo(w.y), bf_hi(w.y)};
                const f32x4 o = xv * ALPHA + v; u32x2 wo; wo.x = pk2(o[0], o[1]); wo.y = pk2(o[2], o[3]);
                *(u32x2*)((bf16_t*)(P->ws + WS_A2) + (size_t)row * 1024 + col) = wo;
            }
        }
    }
}
DI void small_out_splitk(KP P, LAS unsigned char* lds, int tid_in) {
    int tid = tid_in; asm volatile("" : "+v"(tid));
    const int lane = tid & 63, wave = __builtin_amdgcn_readfirstlane(tid >> 6), r = lane & 31, h2 = lane >> 5;
    const int tl = wave >> 2, kq = wave & 3;
    const bf16_t* X = (const bf16_t*)(P->ws + WS_A2); const bf16_t* Wt = (const bf16_t*)(P->ws + WS_WOUT);
    LAS float* part = (LAS float*)lds;
    for (int pair = blockIdx.x; pair < 256; pair += gridDim.x) {
        const int task = pair * 2 + tl, sb = task >> 5, cb = task & 31, col0 = cb * 32;
        __syncthreads();
        const f32x16 acc = small_block_p(X + (size_t)(MP + sb * 32 + r) * 1024 + kq * 256 + 8 * h2, Wt + (size_t)(col0 + r) * 1024 + kq * 256 + 8 * h2, 256);
#pragma unroll
        for (int i = 0; i < 16; ++i) part[((tl * 4 + kq) * 16 + i) * 64 + lane] = acc[i];
        __syncthreads();
        if (kq == 0) {
            const int row = MP + sb * 32 + r;
#pragma unroll
            for (int g = 0; g < 4; ++g) {
                f32x4 v;
#pragma unroll
                for (int e = 0; e < 4; ++e) { const int i = 4 * g + e; v[e] = (part[((tl * 4 + 0) * 16 + i) * 64 + lane] + part[((tl * 4 + 1) * 16 + i) * 64 + lane]) + (part[((tl * 4 + 2) * 16 + i) * 64 + lane] + part[((tl * 4 + 3) * 16 + i) * 64 + lane]); }
                const int col = col0 + 8 * g + 4 * h2;
                const f32x4 xv = *(const f32x4*)(P->in[1] + (size_t)(row - MP) * 1024 + col);
                const f32x4 o = xv * ALPHA + v; u32x2 wo; wo.x = pk2(o[0], o[1]); wo.y = pk2(o[2], o[3]);
                *(u32x2*)((bf16_t*)(P->out + O_Y) + (size_t)row * 1024 + col) = wo;
            }
        }
    }
}
DI void small_ffnconv_prompt(KP P, LAS unsigned char* lds, int tid_in) {
    int tid = tid_in; asm volatile("" : "+v"(tid));
    const int lane = tid & 63, kq = __builtin_amdgcn_readfirstlane(tid >> 6), r = lane & 31, h2 = lane >> 5;
    const bf16_t* X1 = (const bf16_t*)(P->ws + WS_XB); const bf16_t* WU = (const bf16_t*)(P->ws + WS_WUP);
    const int rr = r & 7, b = rr >> 1, t = 8190 + (rr & 1);
    LAS float* part = (LAS float*)lds;
    for (int task = blockIdx.x; task < 168; task += gridDim.x) {
        const int rho0 = task * 32, n0 = ((rho0 >> 7) & 1) * DFF + (rho0 >> 8) * 128 + (rho0 & 127);
        __syncthreads();
        const f32x16 acc = small_block_p(X1 + ((size_t)b * 8192 + t) * 1024 + kq * 128 + 8 * h2, WU + (size_t)(rho0 + r) * 1024 + kq * 128 + 8 * h2, 128);
#pragma unroll
        for (int i = 0; i < 16; ++i) part[(kq * 16 + i) * 64 + lane] = acc[i];
        __syncthreads();
        if (kq == 0 && r < 8) {
#pragma unroll
            for (int g = 0; g < 4; ++g) { f32x4 v;
#pragma unroll
                for (int e = 0; e < 4; ++e) { float s = 0.f;
#pragma unroll
                    for (int q = 0; q < 8; ++q) s += part[(q * 16 + 4 * g + e) * 64 + lane];
                    v[e] = s; }
                *(f32x4*)(P->out + O_FCP + (size_t)(b * 2 + (rr & 1)) * NUP + n0 + 8 * g + 4 * h2) = v; }
        }
    }
}
template <bool DOWN> DI void small_resid(KP P, int tid_in) {
    int tid = tid_in; asm volatile("" : "+v"(tid));
    const int lane = tid & 63, wave = tid >> 6, gw = blockIdx.x * 8 + wave, NGW = gridDim.x * 8, r = lane & 31, h2 = lane >> 5;
    const bf16_t* X = DOWN ? (const bf16_t*)(P->ws + WS_GS) - (size_t)MP * DFF : (const bf16_t*)(P->ws + WS_A2); const bf16_t* Wt = (const bf16_t*)(P->ws + (DOWN ? WS_WDOWN : WS_WOUT));
    const int K = DOWN ? DFF : 1024;
    for (int task = gw; task < 512; task += NGW) {
        const int sb = task >> 5, cb = task & 31, row = MP + sb * 32 + r, col0 = cb * 32;
        const f32x16 acc = small_block(X, Wt, K, MP + sb * 32, col0, lane);
#pragma unroll
        for (int g = 0; g < 4; ++g) {
            const int col = col0 + 8 * g + 4 * h2; const f32x4 v = {acc[4 * g], acc[4 * g + 1], acc[4 * g + 2], acc[4 * g + 3]};
            f32x4 xv;
            if (DOWN) { const u32x2 w = *(const u32x2*)((const bf16_t*)(P->ws + WS_XB) + (size_t)row * 1024 + col); xv = (f32x4){bf_lo(w.x), bf_hi(w.x), bf_lo(w.y), bf_hi(w.y)}; }
            else xv = *(const f32x4*)(P->in[1] + (size_t)(row - MP) * 1024 + col);
            bf16_t* U = DOWN ? (bf16_t*)(P->ws + WS_A2) : (bf16_t*)(P->out + O_Y);
            const f32x4 o = xv * ALPHA + v; u32x2 wo; wo.x = pk2(o[0], o[1]); wo.y = pk2(o[2], o[3]); *(u32x2*)(U + (size_t)row * 1024 + col) = wo;
        }
    }
}

DI void p0_transpose_item(const float* W, int K, int N, bf16_t* WT, int drow0, LAS float* scr, int k0, int n0, int lane) {
    const int nn = n0 + (lane & 31); const int nc = (nn < N) ? nn : N - 1;
    float tv[32];
#pragma unroll
    for (int i = 0; i < 32; ++i) tv[i] = __builtin_nontemporal_load(W + (size_t)(k0 + 2 * i + (lane >> 5)) * N + nc);
#pragma unroll
    for (int i = 0; i < 32; ++i) scr[(2 * i + (lane >> 5)) * 33 + (lane & 31)] = tv[i];
    asm volatile("s_waitcnt lgkmcnt(0)" ::: "memory");
    const int c = lane & 7;
#pragma unroll
    for (int j = 0; j < 4; ++j) { const int n = (lane >> 3) + 8 * j; const LAS float* s = scr + (8 * c) * 33 + n;
        u32x4 o; o.x = pk2(s[0 * 33], s[1 * 33]); o.y = pk2(s[2 * 33], s[3 * 33]); o.z = pk2(s[4 * 33], s[5 * 33]); o.w = pk2(s[6 * 33], s[7 * 33]);
        if (n0 + n < N) *(u32x4*)(WT + (size_t)(drow0 + n) * K + k0 + 8 * c) = o; }
    asm volatile("s_waitcnt lgkmcnt(0)" ::: "memory");
}
DI void p0_transpose_item_f8(const float* W, int K, int N, unsigned char* WT, int pitch, int drow0, LAS float* scr, int k0, int n0, int lane, float sc) {
    const int nn = n0 + (lane & 31); const int nc = (nn < N) ? nn : N - 1;
    float tv[32];
#pragma unroll
    for (int i = 0; i < 32; ++i) tv[i] = __builtin_nontemporal_load(W + (size_t)(k0 + 2 * i + (lane >> 5)) * N + nc);
#pragma unroll
    for (int i = 0; i < 32; ++i) scr[(2 * i + (lane >> 5)) * 33 + (lane & 31)] = tv[i] * sc;
    asm volatile("s_waitcnt lgkmcnt(0)" ::: "memory");
    const int c = lane & 7;
#pragma unroll
    for (int j = 0; j < 4; ++j) { const int n = (lane >> 3) + 8 * j; const LAS float* s = scr + (8 * c) * 33 + n;
        u32x2 o; o.x = pk4_f8(s[0 * 33], s[1 * 33], s[2 * 33], s[3 * 33]); o.y = pk4_f8(s[4 * 33], s[5 * 33], s[6 * 33], s[7 * 33]);
        if (n0 + n < N) *(u32x2*)(WT + (size_t)(drow0 + n) * pitch + k0 + 8 * c) = o; }
    asm volatile("s_waitcnt lgkmcnt(0)" ::: "memory");
}
constexpr int LATE_ITEMS = 16 * 32 + 16 * 168 + 42 * 32, LATE_WG_ITEMS = LATE_ITEMS / 64;
DI void convert_late_item(KP P, LAS unsigned char* lds, int wi) {
    int tid = threadIdx.x; asm volatile("" : "+v"(tid));
    const int lane = tid & 63, wave = tid >> 6;
    __syncthreads();
    LAS float* scr = (LAS float*)(lds + wave * 8448);
    constexpr int I_OUT = 16 * 32, I_UP = 16 * 168;
#pragma unroll 1
    for (int j = 0; j < 8; ++j) {
        int r = wi * 64 + wave * 8 + j;
        if (r < I_OUT) { const int kb = r / 32, nb = r % 32; p0_transpose_item(P->in[16], 1024, 1024, (bf16_t*)(P->ws + WS_WOUT), nb * 32, scr, kb * 64, nb * 32, lane); continue; } r -= I_OUT;
        if (r < I_UP) { const int kb = r / 168, nb = r % 168; const int n0 = nb * 32; const int np = (n0 < DFF) ? n0 : n0 - DFF;
            const int drow = (np >> 7) * 256 + ((n0 < DFF) ? 0 : 128) + (np & 127);
            p0_transpose_item(P->in[19], 1024, NUP, (bf16_t*)(P->ws + WS_WUP), drow, scr, kb * 64, n0, lane);
            p0_transpose_item_f8(P->in[19], 1024, NUP, P->ws + WS_WUP8, 1024, drow, scr, kb * 64, n0, lane, SC_WUP); continue; } r -= I_UP;
        { const int kb = r / 32, nb = r % 32; p0_transpose_item(P->in[22], DFF, 1024, (bf16_t*)(P->ws + WS_WDOWN), nb * 32, scr, kb * 64, nb * 32, lane); }
    }
}
DI void phase_convert(KP P, LAS unsigned char* lds) {
    int tid = threadIdx.x; asm volatile("" : "+v"(tid));
    const int lane = tid & 63, wave = tid >> 6, G = gridDim.x;
    LAS float* scr = (LAS float*)(lds + wave * 8448);
    const int gw = blockIdx.x * 8 + wave, NGW = G * 8;
    constexpr int I_IN = 16 * 97;
    for (int it = gw; it < I_IN; it += NGW) { const int kb = it / 97, nb = it % 97; p0_transpose_item(P->in[7], 1024, NIN, (bf16_t*)(P->ws + WS_WIN), nb * 32, scr, kb * 64, nb * 32, lane); }
    const size_t gt = (size_t)blockIdx.x * NT + tid, NGT = (size_t)G * NT;
    { bf16_t* XB = (bf16_t*)(P->ws + WS_XB);
      constexpr size_t NCH = (size_t)MT * 128;
      size_t i0 = gt;
      for (; i0 + 3 * NGT < NCH; i0 += 4 * NGT) {
          f32x4 a[4], b[4];
#pragma unroll
          for (int u = 0; u < 4; ++u) { const size_t e = (i0 + u * NGT) * 8; const float* src = (e < (size_t)MP * 1024) ? P->in[0] + e : P->in[1] + (e - (size_t)MP * 1024);
              a[u] = __builtin_nontemporal_load((const f32x4*)src); b[u] = __builtin_nontemporal_load((const f32x4*)(src + 4)); }
#pragma unroll
          for (int u = 0; u < 4; ++u) { pin(a[u]); pin(b[u]); }
#pragma unroll
          for (int u = 0; u < 4; ++u) { u32x4 w; w.x = pk2(a[u][0], a[u][1]); w.y = pk2(a[u][2], a[u][3]); w.z = pk2(b[u][0], b[u][1]); w.w = pk2(b[u][2], b[u][3]); *(u32x4*)(XB + (i0 + u * NGT) * 8) = w; }
      }
      for (; i0 < NCH; i0 += NGT) { const size_t e = i0 * 8; const float* src = (e < (size_t)MP * 1024) ? P->in[0] + e : P->in[1] + (e - (size_t)MP * 1024);
          const f32x4 a = *(const f32x4*)src, b = *(const f32x4*)(src + 4); u32x4 w; w.x = pk2(a[0], a[1]); w.y = pk2(a[2], a[3]); w.z = pk2(b[0], b[1]); w.w = pk2(b[2], b[3]); *(u32x4*)(XB + e) = w; }
    }
    { bf16_t* WI = (bf16_t*)(P->ws + WS_WIN) + (size_t)NIN * 1024;
      for (size_t i = gt; i < (size_t)(NINP - NIN) * 128; i += NGT) *(u32x4*)(WI + i * 8) = (u32x4){0u, 0u, 0u, 0u}; }
    { bf16_t* KS = (bf16_t*)(P->ws + WS_KS); bf16_t* VF = (bf16_t*)(P->ws + WS_VFS);
      for (size_t i = gt; i < (size_t)16 * 512 * 64; i += NGT) {
          const int cgp = (int)(i & 63), t = (int)((i >> 6) & 511), b = (int)(i >> 15);
          const float* ks = P->in[2] + ((size_t)(b * 512 + t)) * 512 + cgp * 8; const float* vs = P->in[3] + ((size_t)(b * 512 + t)) * 512 + cgp * 8;
          const f32x4 a = __builtin_nontemporal_load((const f32x4*)ks), c = __builtin_nontemporal_load((const f32x4*)(ks + 4)); u32x4 w; w.x = pk2(a[0], a[1]); w.y = pk2(a[2], a[3]); w.z = pk2(c[0], c[1]); w.w = pk2(c[2], c[3]);
          *(u32x4*)(KS + ((size_t)b * 544 + t) * 512 + cgp * 8) = w;
          const f32x4 va = __builtin_nontemporal_load((const f32x4*)vs), vc = __builtin_nontemporal_load((const f32x4*)(vs + 4));
          const int head = cgp >> 3, d0 = (cgp & 7) * 8, tt = t & 15, hh = (tt >> 2) & 1, jj = ((tt >> 3) << 2) | (tt & 3);
          bf16_t* p = VF + ((size_t)(b * 8 + head) * 34 + (t >> 4)) * 1024 + (hh * 64 + d0) * 8 + jj;
          const unsigned w0 = pk2(va[0], va[1]), w1 = pk2(va[2], va[3]), w2 = pk2(vc[0], vc[1]), w3 = pk2(vc[2], vc[3]);
          p[0] = (bf16_t)(w0 & 0xffff); p[8] = (bf16_t)(w0 >> 16); p[16] = (bf16_t)(w1 & 0xffff); p[24] = (bf16_t)(w1 >> 16);
          p[32] = (bf16_t)(w2 & 0xffff); p[40] = (bf16_t)(w2 >> 16); p[48] = (bf16_t)(w3 & 0xffff); p[56] = (bf16_t)(w3 >> 16);
      } }
}

template <bool OUT_BF16>
DI void phase_ln(const bf16_t* src, const float* gam, const float* bet, void* dst, unsigned char* dst8, unsigned char* g8pad, int tid_in) {
    int tid = tid_in; asm volatile("" : "+v"(tid));
    const int lane = tid & 63, wave = tid >> 6, gw = blockIdx.x * 8 + wave, NGW = gridDim.x * 8;
    f32x4 g4[4], b4[4];
#pragma unroll
    for (int j = 0; j < 4; ++j) { g4[j] = *(const f32x4*)(gam + (lane + 64 * j) * 4); b4[j] = *(const f32x4*)(bet + (lane + 64 * j) * 4); }
    for (int row0 = gw; row0 < MT; row0 += 2 * NGW) {
        u32x2 wv[2][4];
#pragma unroll
        for (int u = 0; u < 2; ++u) { const int row = row0 + u * NGW;
#pragma unroll
            for (int j = 0; j < 4; ++j) { wv[u][j] = (u32x2){0u, 0u}; if (row < MT) wv[u][j] = __builtin_nontemporal_load((const u32x2*)(src + (size_t)row * 1024 + (lane + 64 * j) * 4)); } }
#pragma unroll
        for (int u = 0; u < 2; ++u) { const int row = row0 + u * NGW; if (row >= MT) continue;
            f32x4 v[4]; float s = 0.f;
#pragma unroll
            for (int j = 0; j < 4; ++j) { const u32x2 w = wv[u][j]; v[j] = (f32x4){bf_lo(w.x), bf_hi(w.x), bf_lo(w.y), bf_hi(w.y)}; s += (v[j][0] + v[j][1]) + (v[j][2] + v[j][3]); }
#pragma unroll
            for (int o = 1; o < 64; o <<= 1) s += __shfl_xor(s, o);
            const float mean = s * (1.f / 1024.f); float q = 0.f;
#pragma unroll
            for (int j = 0; j < 4; ++j) { v[j] = v[j] - mean; q += (v[j][0] * v[j][0] + v[j][1] * v[j][1]) + (v[j][2] * v[j][2] + v[j][3] * v[j][3]); }
#pragma unroll
            for (int o = 1; o < 64; o <<= 1) q += __shfl_xor(q, o);
            const float rstd = 1.0f / sqrtf(q * (1.f / 1024.f) + 1e-5f);
#pragma unroll
            for (int j = 0; j < 4; ++j) { const f32x4 o = v[j] * rstd * g4[j] + b4[j];
                if (OUT_BF16) { u32x2 w; w.x = pk2(o[0], o[1]); w.y = pk2(o[2], o[3]); *(u32x2*)((bf16_t*)dst + (size_t)row * 1024 + (lane + 64 * j) * 4) = w;
                    *(unsigned*)(dst8 + (size_t)row * 1024 + (lane + 64 * j) * 4) = pk4_f8(o[0] * SC_X1, o[1] * SC_X1, o[2] * SC_X1, o[3] * SC_X1); }
                else *(f32x4*)((float*)dst + (size_t)row * 1024 + (lane + 64 * j) * 4) = o; }
        }
    }
}

constexpr int XCS = 2080;
constexpr int L_DT = 64 * XCS;
constexpr int L_AC = L_DT + 2048;
constexpr int L_RED = L_AC + 2048;

DI float ssd_dt_scan(KP P, LAS unsigned char* lds, int r0, int Lv, int h, int lane) {
    const float* DT = (const float*)(P->ws + WS_DT);
    float dt = 0.f;
    if (lane < Lv) { const float x = DT[(size_t)(r0 + lane) * 8 + h] + P->in[12][h]; dt = (x > 20.f) ? x : log1pf(expf(x)); }
    const float A = -expf(P->in[13][h]);
    float a = dt * A;
#pragma unroll
    for (int off = 1; off < 64; off <<= 1) { const float v = __shfl_up(a, off); if (lane >= off) a += v; }
    ((LAS float*)(lds + L_DT))[h * 64 + lane] = dt;
    ((LAS float*)(lds + L_AC))[h * 64 + lane] = a;
    return __shfl(a, 63);
}
template <bool DEC, int NCG>
DI void ssd_conv_to_lds(KP P, LAS unsigned char* lds, int tid, int r0, int Lv, bool samp, int sb, bool has_prev) {
    const int tblk = tid >> 7, cgp = tid & 127;
    if (cgp >= NCG) return;
    const int ch0 = cgp * 8, t0 = tblk * 16;
    const bf16_t* XBC = (const bf16_t*)(P->ws + WS_XBC);
    const float* cwp = P->in[10]; const float* cbp = P->in[11];
    float w[4][8], bias[8];
#pragma unroll
    for (int k = 0; k < 4; ++k) { const f32x4 a = *(const f32x4*)(cwp + k * 1024 + ch0), b = *(const f32x4*)(cwp + k * 1024 + ch0 + 4);
#pragma unroll
        for (int e = 0; e < 4; ++e) { w[k][e] = a[e]; w[k][4 + e] = b[e]; } }
    { const f32x4 a = *(const f32x4*)(cbp + ch0), b = *(const f32x4*)(cbp + ch0 + 4);
#pragma unroll
        for (int e = 0; e < 4; ++e) { bias[e] = a[e]; bias[4 + e] = b[e]; } }
    u32x4 raw[19]; f32x4 pa[3], pb[3];
    const bool halo_f32 = samp && (t0 == 0);
#pragma unroll
    for (int k = 0; k < 19; ++k) {
        const int tt = t0 - 3 + k;
        raw[k] = (u32x4){0u, 0u, 0u, 0u};
        if (tt >= 0) { if (tt < Lv) raw[k] = *(const u32x4*)(XBC + (size_t)(r0 + tt) * 1024 + ch0); }
        else if (!samp && has_prev) raw[k] = *(const u32x4*)(XBC + (size_t)(r0 + tt) * 1024 + ch0);
    }
#pragma unroll
    for (int k = 0; k < 3; ++k) { pa[k] = (f32x4){0.f, 0.f, 0.f, 0.f}; pb[k] = pa[k];
        if (halo_f32) { const float* s = P->in[5] + ((size_t)(sb * 3 + k)) * 1024 + ch0; pa[k] = *(const f32x4*)s; pb[k] = *(const f32x4*)(s + 4); } }
    float xw[3][8];
#pragma unroll
    for (int k = 0; k < 3; ++k) {
        const u32x4 q = raw[k];
        xw[k][0] = bf_lo(q.x); xw[k][1] = bf_hi(q.x); xw[k][2] = bf_lo(q.y); xw[k][3] = bf_hi(q.y); xw[k][4] = bf_lo(q.z); xw[k][5] = bf_hi(q.z); xw[k][6] = bf_lo(q.w); xw[k][7] = bf_hi(q.w);
        if (halo_f32) {
#pragma unroll
            for (int e = 0; e < 4; ++e) { xw[k][e] = pa[k][e]; xw[k][4 + e] = pb[k][e]; } }
    }
    const int head = cgp >> 3;
    const LAS float* sdt = (const LAS float*)(lds + L_DT) + head * 64; const LAS float* sac = (const LAS float*)(lds + L_AC) + head * 64;
    const float atot = (cgp < 64) ? sac[63] : 0.f;
#pragma unroll
    for (int i = 0; i < 16; ++i) {
        const int t = t0 + i; float xc[8];
        { const u32x4 q = raw[3 + i];
          xc[0] = bf_lo(q.x); xc[1] = bf_hi(q.x); xc[2] = bf_lo(q.y); xc[3] = bf_hi(q.y); xc[4] = bf_lo(q.z); xc[5] = bf_hi(q.z); xc[6] = bf_lo(q.w); xc[7] = bf_hi(q.w); }
        float f = 1.f;
        if (cgp < 64) { f = sdt[t]; if (DEC) f *= __builtin_amdgcn_exp2f((atot - sac[t]) * LOG2E); }
        if (t >= Lv) f = 0.f;
        float o[8];
#pragma unroll
        for (int e = 0; e < 8; ++e) { const float v = bias[e] + w[0][e] * xw[0][e] + w[1][e] * xw[1][e] + w[2][e] * xw[2][e] + w[3][e] * xc[e]; o[e] = silu_f(v) * f; }
        u32x4 q; q.x = pk2(o[0], o[1]); q.y = pk2(o[2], o[3]); q.z = pk2(o[4], o[5]); q.w = pk2(o[6], o[7]);
        *(LAS u32x4*)(lds + t * XCS + ch0 * 2) = q;
#pragma unroll
        for (int e = 0; e < 8; ++e) { xw[0][e] = xw[1][e]; xw[1][e] = xw[2][e]; xw[2][e] = xc[e]; }
    }
}
DI void chunk_geom(int ch, bool& samp, int& sb, int& r0, int& Lv, bool& has_prev) {
    samp = ch >= 512; sb = ch - 512;
    if (!samp) { r0 = ch * 64; Lv = 64; has_prev = (ch & 127) != 0; } else { r0 = MP + sb * 32; Lv = 32; has_prev = false; }
}
DI void ssd_states_tile(KP P, LAS unsigned char* lds, int ch) {
    int tid = threadIdx.x; asm volatile("" : "+v"(tid));
    const int lane = tid & 63, h = __builtin_amdgcn_readfirstlane(tid >> 6);
    bool samp, has_prev; int sb, r0, Lv; chunk_geom(ch, samp, sb, r0, Lv, has_prev);
    __syncthreads();
    const float atot = ssd_dt_scan(P, lds, r0, Lv, h, lane);
    if (lane == 0) ((float*)(P->ws + WS_DEC))[ch * 8 + h] = expf(atot);
    __syncthreads();
    ssd_conv_to_lds<true, 96>(P, lds, tid, r0, Lv, samp, sb, has_prev);
    __syncthreads();
    const int r = lane & 31, h2 = lane >> 5, blk = (lane >> 4) & 1, i16 = lane & 15, q = i16 >> 2, pp = i16 & 3, g = h >> 2;
    bf16_t* ST = (bf16_t*)(P->ws + WS_ST) + ((size_t)ch * 8 + h) * 8192;
#pragma unroll 1
    for (int nh = 0; nh < 2; ++nh) {
        f32x16 acc[2][2];
#pragma unroll
        for (int a = 0; a < 2; ++a)
#pragma unroll
            for (int b = 0; b < 2; ++b)
#pragma unroll
                for (int i = 0; i < 16; ++i) acc[a][b][i] = 0.f;
#pragma unroll
        for (int sp = 0; sp < 4; ++sp) {
            LAS unsigned char* rlo = lds + (16 * sp + 8 * h2 + q) * XCS + (16 * blk + 4 * pp) * 2;
            LAS unsigned char* rhi = rlo + 4 * XCS;
            bf16x8 af[2], bfr[2];
#pragma unroll
            for (int pb = 0; pb < 2; ++pb) af[pb] = tr_frag(rlo + (h * 64 + 32 * pb) * 2, rhi + (h * 64 + 32 * pb) * 2);
#pragma unroll
            for (int nb = 0; nb < 2; ++nb) bfr[nb] = tr_frag(rlo + (512 + g * 128 + 64 * nh + 32 * nb) * 2, rhi + (512 + g * 128 + 64 * nh + 32 * nb) * 2);
#pragma unroll
            for (int pb = 0; pb < 2; ++pb)
#pragma unroll
                for (int nb = 0; nb < 2; ++nb) acc[pb][nb] = MFMA32(af[pb], bfr[nb], acc[pb][nb]);
        }
#pragma unroll
        for (int pb = 0; pb < 2; ++pb)
#pragma unroll
            for (int nb = 0; nb < 2; ++nb) {
                bf16_t* sp_ = ST + (32 * pb + 4 * h2) * 128 + 64 * nh + 32 * nb + r;
#pragma unroll
                for (int i = 0; i < 16; ++i) sp_[((i & 3) + 8 * (i >> 2)) * 128] = (bf16_t)(pk2(acc[pb][nb][i], 0.f) & 0xffff);
            }
    }
}
DI void phase_scan(KP P, LAS unsigned char* lds) {
    int tid = threadIdx.x; asm volatile("" : "+v"(tid));
    unsigned* ST = (unsigned*)(P->ws + WS_ST); const float* DEC = (const float*)(P->ws + WS_DEC);
    LAS float* sdec = (LAS float*)lds;
    for (int blk = blockIdx.x; blk < 256; blk += gridDim.x) {
        const int b = blk >> 6, h = (blk >> 3) & 7, rem = (blk & 63) * 512 + tid;
        __syncthreads();
        if (tid < 128) sdec[tid] = DEC[(b * 128 + tid) * 8 + h];
        __syncthreads();
        float H0 = 0.f, H1 = 0.f;
        unsigned* sp = ST + (size_t)b * 128 * 32768 + rem;
#pragma unroll 1
        for (int c0 = 0; c0 < 128; c0 += 64) {
            unsigned w[64];
#pragma unroll
            for (int k = 0; k < 64; ++k) w[k] = sp[(size_t)(c0 + k) * 32768];
#pragma unroll
            for (int k = 0; k < 64; ++k) { const float d = sdec[c0 + k]; sp[(size_t)(c0 + k) * 32768] = pk2(H0, H1); H0 = H0 * d + bf_lo(w[k]); H1 = H1 * d + bf_hi(w[k]); }
        }
        *(f32x2*)(P->out + O_SSP + ((size_t)blk * 512 + tid) * 2) = (f32x2){H0, H1};
    }
}
DI void phase_sample_state(KP P) {
    int tid = threadIdx.x; asm volatile("" : "+v"(tid));
    const size_t gt = (size_t)blockIdx.x * NT + tid, NGT = (size_t)gridDim.x * NT;
    const unsigned* ST = (const unsigned*)(P->ws + WS_ST); const float* DEC = (const float*)(P->ws + WS_DEC);
    for (size_t pr0 = gt; pr0 < 524288; pr0 += 4 * NGT) {
        f32x2 h0[4]; unsigned w[4]; float d[4];
#pragma unroll
        for (int u = 0; u < 4; ++u) { const size_t pr = pr0 + u * NGT; h0[u] = (f32x2){0.f, 0.f}; w[u] = 0u; d[u] = 0.f;
            if (pr < 524288) { const int b = (int)(pr >> 15), rem = (int)(pr & 32767), h = rem >> 12, chq = 512 + b;
                h0[u] = *(const f32x2*)(P->in[4] + pr * 2); w[u] = ST[(size_t)chq * 32768 + rem]; d[u] = DEC[chq * 8 + h]; } }
#pragma unroll
        for (int u = 0; u < 4; ++u) { const size_t pr = pr0 + u * NGT;
            if (pr < 524288) *(f32x2*)(P->out + O_SSS + pr * 2) = (f32x2){h0[u][0] * d[u] + bf_lo(w[u]), h0[u][1] * d[u] + bf_hi(w[u])}; }
    }
}
DI void ssd_out_tile(KP P, LAS unsigned char* lds, int ch) {
    int tid = threadIdx.x; asm volatile("" : "+v"(tid));
    const int lane = tid & 63, h = __builtin_amdgcn_readfirstlane(tid >> 6);
    bool samp, has_prev; int sb, r0, Lv; chunk_geom(ch, samp, sb, r0, Lv, has_prev);
    __syncthreads();
    ssd_dt_scan(P, lds, r0, Lv, h, lane);
    __syncthreads();
    ssd_conv_to_lds<false, 128>(P, lds, tid, r0, Lv, samp, sb, has_prev);
    __syncthreads();
    const int r = lane & 31, h2 = lane >> 5, blk = (lane >> 4) & 1, i16 = lane & 15, q = i16 >> 2, pp = i16 & 3, g = h >> 2;
    const LAS float* sac = (const LAS float*)(lds + L_AC) + h * 64; const LAS float* sdt = (const LAS float*)(lds + L_DT) + h * 64;
    f32x16 cb[2][2];
#pragma unroll
    for (int a = 0; a < 2; ++a)
#pragma unroll
        for (int b = 0; b < 2; ++b)
#pragma unroll
            for (int i = 0; i < 16; ++i) cb[a][b][i] = 0.f;
    const bf16_t* PREV = (const bf16_t*)(P->ws + WS_ST) + ((size_t)ch * 8 + h) * 8192;
#pragma unroll 2
    for (int kk = 0; kk < 8; ++kk) {
        bf16x8 bm[2], cm[2];
#pragma unroll
        for (int x = 0; x < 2; ++x) {
            bm[x] = *(const LAS bf16x8*)(lds + (32 * x + r) * XCS + (512 + g * 128 + 16 * kk + 8 * h2) * 2);
            cm[x] = *(const LAS bf16x8*)(lds + (32 * x + r) * XCS + (768 + g * 128 + 16 * kk + 8 * h2) * 2);
        }
#pragma unroll
        for (int a = 0; a < 2; ++a)
#pragma unroll
            for (int b = 0; b < 2; ++b) cb[a][b] = MFMA32(bm[a], cm[b], cb[a][b]);
    }
    __builtin_amdgcn_sched_barrier(0);
    float acl[2]; acl[0] = sac[r]; acl[1] = sac[32 + r];
    f32x16 y[2][2];
#pragma unroll
    for (int a = 0; a < 2; ++a)
#pragma unroll
        for (int b = 0; b < 2; ++b)
#pragma unroll
            for (int i = 0; i < 16; ++i) y[a][b][i] = 0.f;
#pragma unroll
    for (int sbk = 0; sbk < 2; ++sbk) {
        float acs[16];
#pragma unroll
        for (int gi = 0; gi < 4; ++gi) { const f32x4 t4 = *(const LAS f32x4*)(sac + 32 * sbk + 8 * gi + 4 * h2); acs[4 * gi] = t4[0]; acs[4 * gi + 1] = t4[1]; acs[4 * gi + 2] = t4[2]; acs[4 * gi + 3] = t4[3]; }
#pragma unroll
        for (int s2 = 0; s2 < 2; ++s2) {
            bf16x8 pf[2];
#pragma unroll
            for (int lb = 0; lb < 2; ++lb) {
                const int l = 32 * lb + r; float m[8];
#pragma unroll
                for (int j = 0; j < 8; ++j) { const int i = 8 * s2 + j, s = 32 * sbk + crow(i, h2);
                    m[j] = (s <= l) ? cb[sbk][lb][i] * __builtin_amdgcn_exp2f((acl[lb] - acs[i]) * LOG2E) : 0.f; }
                pf[lb] = pack8(m[0], m[1], m[2], m[3], m[4], m[5], m[6], m[7]);
            }
            LAS unsigned char* rlo = lds + (32 * sbk + 16 * s2 + 4 * h2 + q) * XCS + (h * 64 + 16 * blk + 4 * pp) * 2;
            LAS unsigned char* rhi = rlo + 8 * XCS;
#pragma unroll
            for (int pb = 0; pb < 2; ++pb) { const bf16x8 xa = tr_frag(rlo + 64 * pb, rhi + 64 * pb);
#pragma unroll
                for (int lb = 0; lb < 2; ++lb) y[pb][lb] = MFMA32(xa, pf[lb], y[pb][lb]); }
        }
    }
    __builtin_amdgcn_sched_barrier(0);
    {
        f32x16 yo[2][2];
#pragma unroll
        for (int a = 0; a < 2; ++a)
#pragma unroll
            for (int b = 0; b < 2; ++b)
#pragma unroll
                for (int i = 0; i < 16; ++i) yo[a][b][i] = 0.f;
        bf16x8 pv[8][2];
#pragma unroll
        for (int kk = 0; kk < 8; ++kk)
#pragma unroll
            for (int x = 0; x < 2; ++x) {
                if (!samp) pv[kk][x] = *(const bf16x8*)(PREV + (32 * x + r) * 128 + 16 * kk + 8 * h2);
                else { const float* hp = P->in[4] + ((size_t)(sb * 8 + h) * 64 + 32 * x + r) * 128 + 16 * kk + 8 * h2; const f32x4 ha = *(const f32x4*)hp, hb = *(const f32x4*)(hp + 4);
                    pv[kk][x] = pack8(ha[0], ha[1], ha[2], ha[3], hb[0], hb[1], hb[2], hb[3]); }
            }
#pragma unroll
        for (int kk = 0; kk < 8; ++kk)
#pragma unroll
            for (int x = 0; x < 2; ++x) pin(pv[kk][x]);
#pragma unroll
        for (int kk = 0; kk < 8; ++kk) {
            bf16x8 cm[2];
#pragma unroll
            for (int x = 0; x < 2; ++x) cm[x] = *(const LAS bf16x8*)(lds + (32 * x + r) * XCS + (768 + g * 128 + 16 * kk + 8 * h2) * 2);
#pragma unroll
            for (int a = 0; a < 2; ++a)
#pragma unroll
                for (int b = 0; b < 2; ++b) yo[a][b] = MFMA32(pv[kk][a], cm[b], yo[a][b]);
        }
#pragma unroll
        for (int lb = 0; lb < 2; ++lb) { const float eo = __builtin_amdgcn_exp2f(acl[lb] * LOG2E);
#pragma unroll
            for (int pb = 0; pb < 2; ++pb)
#pragma unroll
                for (int i = 0; i < 16; ++i) y[pb][lb][i] += eo * yo[pb][lb][i]; }
    }
    __builtin_amdgcn_sched_barrier(0);
    const float Dh = P->in[14][h];
    const bf16_t* Z = (const bf16_t*)(P->ws + WS_Z);
    float ss[2] = {0.f, 0.f};
    u32x2 zq[2][2][4];
#pragma unroll
    for (int lb = 0; lb < 2; ++lb)
#pragma unroll
        for (int pb = 0; pb < 2; ++pb)
#pragma unroll
            for (int gi = 0; gi < 4; ++gi) { const int l = 32 * lb + r; zq[lb][pb][gi] = (u32x2){0u, 0u};
                if (l < Lv) zq[lb][pb][gi] = *(const u32x2*)(Z + (size_t)(r0 + l) * 512 + h * 64 + 32 * pb + 8 * gi + 4 * h2); }
#pragma unroll
    for (int lb = 0; lb < 2; ++lb)
#pragma unroll
        for (int pb = 0; pb < 2; ++pb)
#pragma unroll
            for (int gi = 0; gi < 4; ++gi) pin(zq[lb][pb][gi]);
#pragma unroll
    for (int lb = 0; lb < 2; ++lb) {
        const int l = 32 * lb + r; const bool ok = l < Lv;
        const float dtl = sdt[l]; const float dsk = ok ? Dh / dtl : 0.f;
#pragma unroll
        for (int pb = 0; pb < 2; ++pb)
#pragma unroll
            for (int gi = 0; gi < 4; ++gi) {
                const int p0 = 32 * pb + 8 * gi + 4 * h2;
                const u32x2 xq = *(const LAS u32x2*)(lds + l * XCS + (h * 64 + p0) * 2);
                const u32x2 zv2 = zq[lb][pb][gi];
                const float xv[4] = {bf_lo(xq.x), bf_hi(xq.x), bf_lo(xq.y), bf_hi(xq.y)}; const float zv[4] = {bf_lo(zv2.x), bf_hi(zv2.x), bf_lo(zv2.y), bf_hi(zv2.y)};
#pragma unroll
                for (int e = 0; e < 4; ++e) { const int i = 4 * gi + e; float v = y[pb][lb][i] + xv[e] * dsk; v *= silu_f(zv[e]); y[pb][lb][i] = v; ss[lb] += v * v; }
            }
    }
    LAS float* red = (LAS float*)(lds + L_RED);
#pragma unroll
    for (int lb = 0; lb < 2; ++lb) { ss[lb] += __shfl_xor(ss[lb], 32); if (h2 == 0) red[h * 64 + 32 * lb + r] = ss[lb]; }
    __syncthreads();
    bf16_t* A2 = (bf16_t*)(P->ws + WS_A2); const float* gam = P->in[15];
    f32x4 gv[2][4];
#pragma unroll
    for (int pb = 0; pb < 2; ++pb)
#pragma unroll
        for (int gi = 0; gi < 4; ++gi) gv[pb][gi] = *(const f32x4*)(gam + h * 64 + 32 * pb + 8 * gi + 4 * h2);
#pragma unroll
    for (int pb = 0; pb < 2; ++pb)
#pragma unroll
        for (int gi = 0; gi < 4; ++gi) pin(gv[pb][gi]);
#pragma unroll
    for (int lb = 0; lb < 2; ++lb) {
        const int l = 32 * lb + r; float tot = 0.f;
#pragma unroll
        for (int hh = 0; hh < 8; ++hh) tot += red[hh * 64 + l];
        const float rs = 1.0f / sqrtf(tot * (1.f / 512.f) + 1e-5f);
        if (l < Lv) {
#pragma unroll
            for (int pb = 0; pb < 2; ++pb)
#pragma unroll
                for (int gi = 0; gi < 4; ++gi) { const int p0 = 32 * pb + 8 * gi + 4 * h2; const f32x4 g4 = gv[pb][gi];
                    u32x2 w; w.x = pk2(y[pb][lb][4 * gi] * rs * g4[0], y[pb][lb][4 * gi + 1] * rs * g4[1]); w.y = pk2(y[pb][lb][4 * gi + 2] * rs * g4[2], y[pb][lb][4 * gi + 3] * rs * g4[3]);
                    *(u32x2*)(A2 + (size_t)(r0 + l) * 1024 + 512 + h * 64 + p0) = w; }
        }
    }
}

constexpr int L_TBL = 0;
constexpr int L_ARED = 8 * 260 * 4;
constexpr int L_AQ = 16384;
DI void attn_tile(KP P, LAS unsigned char* lds, int ch) {
    int tid = threadIdx.x; asm volatile("" : "+v"(tid));
    const int lane = tid & 63, hd = __builtin_amdgcn_readfirstlane(tid >> 6), r = lane & 31, h2 = lane >> 5;
    const bool samp = ch >= 512;
    int Lq, jt_lo, nkeys, ngr; long qrow0; const bf16_t* Kb; const bf16_t* Vb;
    if (!samp) { const int b = ch >> 7, c = ch & 127; qrow0 = (long)ch * 64; Lq = 64; jt_lo = (c < 8) ? 8 - c : 0; nkeys = 576; ngr = 36;
        Kb = (const bf16_t*)(P->ws + WS_KP) + ((long)b * 8192 + (long)(c - 8) * 64) * 512 + hd * 64;
        Vb = (const bf16_t*)(P->ws + WS_VFP) + ((long)(b * 8 + hd) * 512 + (long)(c - 8) * 4) * 1024; }
    else { const int b = ch - 512; qrow0 = (long)MP + b * 32; Lq = 32; jt_lo = 0; nkeys = 544; ngr = 34;
        Kb = (const bf16_t*)(P->ws + WS_KS) + (long)b * 544 * 512 + hd * 64;
        Vb = (const bf16_t*)(P->ws + WS_VFS) + (long)(b * 8 + hd) * 34 * 1024; }
    __syncthreads();
    LAS float* tbl = (LAS float*)(lds + L_TBL) + hd * 260;
    for (int i = lane; i < 257; i += 64) tbl[i] = P->in[8][hd * 257 + i] * LOG2E;
    __syncthreads();
    const bf16_t* Q = (const bf16_t*)(P->ws + WS_Q);
    LAS unsigned char* qlds = lds + L_AQ + hd * 8192 + lane * 16;
    { bf16x8 qtmp[2][4];
#pragma unroll
      for (int qb = 0; qb < 2; ++qb) { int qi = 32 * qb + r; if (qi > Lq - 1) qi = Lq - 1;
#pragma unroll
          for (int s = 0; s < 4; ++s) qtmp[qb][s] = *(const bf16x8*)(Q + (size_t)(qrow0 + qi) * 512 + hd * 64 + 16 * s + 8 * h2); }
#pragma unroll
      for (int qb = 0; qb < 2; ++qb)
#pragma unroll
          for (int s = 0; s < 4; ++s) pin(qtmp[qb][s]);
#pragma unroll
      for (int qb = 0; qb < 2; ++qb)
#pragma unroll
          for (int s = 0; s < 4; ++s) *(LAS bf16x8*)(qlds + (qb * 4 + s) * 1024) = qtmp[qb][s]; }
    f32x16 o[2][2];
#pragma unroll
    for (int a = 0; a < 2; ++a)
#pragma unroll
        for (int b = 0; b < 2; ++b)
#pragma unroll
            for (int i = 0; i < 16; ++i) o[a][b][i] = 0.f;
    float mrun[2] = {-1e30f, -1e30f}, lrun[2] = {0.f, 0.f};
    const float SC = 0.125f * LOG2E;
    for (int jt = jt_lo; jt < 9; ++jt) {
        bf16x8 kf[2][4];
#pragma unroll
        for (int kb = 0; kb < 2; ++kb) {
            int kj = 64 * jt + 32 * kb + r; if (kj > nkeys - 1) kj = nkeys - 1;
#pragma unroll
            for (int s = 0; s < 4; ++s) kf[kb][s] = *(const bf16x8*)(Kb + (long)kj * 512 + 16 * s + 8 * h2);
        }
#pragma unroll
        for (int kb = 0; kb < 2; ++kb)
#pragma unroll
            for (int s = 0; s < 4; ++s) pin(kf[kb][s]);
        f32x16 st[2][2];
#pragma unroll
        for (int kb = 0; kb < 2; ++kb)
#pragma unroll
            for (int qb = 0; qb < 2; ++qb) {
#pragma unroll
                for (int i = 0; i < 16; ++i) st[kb][qb][i] = 0.f;
#pragma unroll
                for (int s = 0; s < 4; ++s) st[kb][qb] = MFMA32(kf[kb][s], *(const LAS bf16x8*)(qlds + (qb * 4 + s) * 1024), st[kb][qb]);
            }
        __builtin_amdgcn_sched_barrier(0);
        bf16x8 vf[2][2][2];
#pragma unroll
        for (int kb = 0; kb < 2; ++kb)
#pragma unroll
            for (int s2 = 0; s2 < 2; ++s2) {
                int gidx = 4 * jt + 2 * kb + s2; if (gidx > ngr - 1) gidx = ngr - 1;
#pragma unroll
                for (int db = 0; db < 2; ++db) vf[kb][s2][db] = *(const bf16x8*)(Vb + (long)gidx * 1024 + (h2 * 64 + 32 * db + r) * 8);
            }
        __builtin_amdgcn_sched_barrier(0);
        const bool far = (jt <= 5);
        const bool tailmask = samp && (jt == 8);
        const float bfar = tbl[256];
#pragma unroll
        for (int qb = 0; qb < 2; ++qb) {
            const int qi = 32 * qb + r;
            float mx = -1e30f;
#pragma unroll
            for (int kb = 0; kb < 2; ++kb)
#pragma unroll
                for (int i = 0; i < 16; ++i) {
                    const int kj = 64 * jt + 32 * kb + crow(i, h2);
                    float bias = bfar;
                    if (!far) { int rel = 512 + qi - kj; rel = rel > 128 ? 128 : rel; rel = rel < -128 ? -128 : rel; bias = tbl[rel + 128]; }
                    float sc = st[kb][qb][i] * SC + bias;
                    if (tailmask && kj >= nkeys) sc = -1e30f;
                    st[kb][qb][i] = sc; mx = fmaxf(mx, sc);
                }
            mx = fmaxf(mx, __shfl_xor(mx, 32));
            const float mnew = fmaxf(mrun[qb], mx), alpha = __builtin_amdgcn_exp2f(mrun[qb] - mnew);
            float ls = 0.f;
#pragma unroll
            for (int kb = 0; kb < 2; ++kb)
#pragma unroll
                for (int i = 0; i < 16; ++i) { const float p = __builtin_amdgcn_exp2f(st[kb][qb][i] - mnew); st[kb][qb][i] = p; ls += p; }
            ls += __shfl_xor(ls, 32);
            lrun[qb] = lrun[qb] * alpha + ls; mrun[qb] = mnew;
            if (__builtin_amdgcn_ballot_w64(alpha != 1.0f) != 0ull) {
#pragma unroll
                for (int db = 0; db < 2; ++db)
#pragma unroll
                    for (int i = 0; i < 16; ++i) o[db][qb][i] *= alpha;
            }
        }
#pragma unroll
        for (int kb = 0; kb < 2; ++kb)
#pragma unroll
            for (int s2 = 0; s2 < 2; ++s2) {
                bf16x8 pf[2];
#pragma unroll
                for (int qb = 0; qb < 2; ++qb) pf[qb] = pack8(st[kb][qb][8 * s2], st[kb][qb][8 * s2 + 1], st[kb][qb][8 * s2 + 2], st[kb][qb][8 * s2 + 3],
                                                               st[kb][qb][8 * s2 + 4], st[kb][qb][8 * s2 + 5], st[kb][qb][8 * s2 + 6], st[kb][qb][8 * s2 + 7]);
#pragma unroll
                for (int db = 0; db < 2; ++db)
#pragma unroll
                    for (int qb = 0; qb < 2; ++qb) o[db][qb] = MFMA32(vf[kb][s2][db], pf[qb], o[db][qb]);
            }
    }
    LAS float* red = (LAS float*)(lds + L_ARED);
#pragma unroll
    for (int qb = 0; qb < 2; ++qb) {
        const float il = 1.0f / lrun[qb]; float ss = 0.f;
#pragma unroll
        for (int db = 0; db < 2; ++db)
#pragma unroll
            for (int i = 0; i < 16; ++i) { const float v = o[db][qb][i] * il; o[db][qb][i] = v; ss += v * v; }
        ss += __shfl_xor(ss, 32);
        if (h2 == 0) red[hd * 64 + 32 * qb + r] = ss;
    }
    __syncthreads();
    bf16_t* A2 = (bf16_t*)(P->ws + WS_A2); const float* gam = P->in[9];
    f32x4 gv[2][4];
#pragma unroll
    for (int db = 0; db < 2; ++db)
#pragma unroll
        for (int gi = 0; gi < 4; ++gi) gv[db][gi] = *(const f32x4*)(gam + hd * 64 + 32 * db + 8 * gi + 4 * h2);
#pragma unroll
    for (int db = 0; db < 2; ++db)
#pragma unroll
        for (int gi = 0; gi < 4; ++gi) pin(gv[db][gi]);
#pragma unroll
    for (int qb = 0; qb < 2; ++qb) {
        const int qi = 32 * qb + r; float tot = 0.f;
#pragma unroll
        for (int hh = 0; hh < 8; ++hh) tot += red[hh * 64 + qi];
        const float rs = 1.0f / sqrtf(tot * (1.f / 512.f) + 1e-5f);
        if (qi < Lq) {
#pragma unroll
            for (int db = 0; db < 2; ++db)
#pragma unroll
                for (int gi = 0; gi < 4; ++gi) { const int d0 = 32 * db + 8 * gi + 4 * h2; const f32x4 g4 = gv[db][gi];
                    u32x2 w; w.x = pk2(o[db][qb][4 * gi] * rs * g4[0], o[db][qb][4 * gi + 1] * rs * g4[1]); w.y = pk2(o[db][qb][4 * gi + 2] * rs * g4[2], o[db][qb][4 * gi + 3] * rs * g4[3]);
                    *(u32x2*)(A2 + (size_t)(qrow0 + qi) * 1024 + hd * 64 + d0) = w; }
        }
    }
}

__global__ void __launch_bounds__(NT, 2) hybrid_fwd(Params PA) {
    extern __shared__ __attribute__((aligned(16))) unsigned char lds_raw[];
    LAS unsigned char* lds = (LAS unsigned char*)lds_raw;
    cg::grid_group grid = cg::this_grid();
    const int G = gridDim.x, bx = blockIdx.x;
    int wid_s = __builtin_amdgcn_readfirstlane(threadIdx.x >> 6); asm volatile("" : "+s"(wid_s));
#define TIDX() ({ unsigned z_ = 0u; asm volatile("" : "+s"(z_)); (wid_s << 6) | (int)__builtin_amdgcn_mbcnt_hi(~0u, __builtin_amdgcn_mbcnt_lo(~0u, z_)); })
#define KARGS() ({ KP p_ = (KP)__builtin_amdgcn_kernarg_segment_ptr(); asm volatile("" : "+s"(p_)); p_; })
    if (PA.out == nullptr) grid.sync();
    {
        volatile LAS unsigned* stw = (volatile LAS unsigned*)(lds + LDS_BYTES - 16);
        if (threadIdx.x == 0) { stw[0] = 0u; stw[1] = 0u; }
        __syncthreads();
    }
    const XcdBarrier gbar = xcd_barrier_post((unsigned*)(PA.ws + WS_BAR), (volatile LAS unsigned*)(lds + LDS_BYTES - 16));
#define GRID_SYNC() xcd_barrier(gbar, TIDX())

#ifndef PHASE_MASK
#define PHASE_MASK 0xFFFF
#endif
#ifndef REPEAT_MASK
#define REPEAT_MASK 0
#endif
#define PH(k) if (KP P = KARGS()) if (PHASE_MASK & (1 << (k))) for (int rep_ = 0; rep_ <= ((REPEAT_MASK >> (k)) & 1); ++rep_)
#ifndef NREP_ALL
#define NREP_ALL 1
#endif
    for (int outer_ = 0; outer_ < NREP_ALL; ++outer_) {
    if (outer_) GRID_SYNC();
    PH(0) phase_convert(P, lds);
    GRID_SYNC();
    PH(1) {
        pg8::AMapPlain am{(const void*)(P->ws + WS_XB), 2048}; pg8::Order S; S.init(128, 12, G, bx);
        EpiInProj E{P->out, P->ws};
        pg8::gemm_phase<EpiInProj, pg8::AMapPlain>(lds, am, (const void*)(P->ws + WS_WIN), 2048, S, E);
        small_inproj(P);
    }
    GRID_SYNC();
    PH(4) {
        unsigned* qctr = (unsigned*)(P->ws + WS_BAR) + 3584 + 64 * (rep_ + 2 * outer_);
        volatile LAS unsigned* slot = (volatile LAS unsigned*)(lds + LDS_BYTES - 32);
        constexpr int Q0 = LATE_WG_ITEMS, Q1 = Q0 + 480, Q2 = Q1 + 512, Q3 = Q2 + 32, Q4 = Q3 + 16, Q5 = Q4 + 16, Q6 = Q5 + 16;
        for (;;) {
            __syncthreads();
            if (threadIdx.x == 0) slot[0] = __hip_atomic_fetch_add(qctr, 1u, __ATOMIC_RELAXED, __HIP_MEMORY_SCOPE_AGENT);
            __syncthreads();
            const int it = (int)slot[0];
            if (it >= Q6) break;
            if (it < Q0) convert_late_item(P, lds, it);
            else if (it < Q1) { const int j = it - Q0; attn_tile(P, lds, (j / 120) * 128 + 8 + j % 120); }
            else if (it < Q2) ssd_states_tile(P, lds, it - Q1);
            else if (it < Q3) { const int j = it - Q2; attn_tile(P, lds, (j & 3) * 128 + 7 - (j >> 2)); }
            else if (it < Q4) ssd_out_tile(P, lds, 512 + it - Q3);
            else if (it < Q5) attn_tile(P, lds, 512 + it - Q4);
            else ssd_states_tile(P, lds, 512 + it - Q5);
        }
    }
    GRID_SYNC();
    PH(3) phase_scan(P, lds);
    GRID_SYNC();
    PH(5) for (int ch = bx; ch < 512; ch += G) ssd_out_tile(P, lds, ch);
    PH(5) phase_sample_state(P);
    GRID_SYNC();
    PH(6) {
        __syncthreads();
        pg8::AMapPlain am{(const void*)(P->ws + WS_A2), 2048}; pg8::Order S; S.init(128, 4, G, bx);
        EpiOutProj E{P->in[0], P->in[1], (bf16_t*)(P->out + O_Y)};
        pg8::gemm_phase<EpiOutProj, pg8::AMapPlain>(lds, am, (const void*)(P->ws + WS_WOUT), 2048, S, E);
        small_out_splitk(P, lds, TIDX());
    }
    GRID_SYNC();
    PH(7) phase_ln<true>((const bf16_t*)(P->out + O_Y), P->in[17], P->in[18], (void*)(P->ws + WS_XB), P->ws + WS_X1F8, P->ws + WS_G, TIDX());
    GRID_SYNC();
    PH(8) {
        pg8::Order S; S.init(132, 21, G, bx);
        pg8::AMapUp<126> am{(const void*)(P->ws + WS_X1F8), 1024};
        EpiUp<false> E{P->ws + WS_G, nullptr, P->in[20], P->in[21], P->in[6], nullptr};
        pg8::gemm_phase<EpiUp<false>, pg8::AMapUp<126>, true>(lds, am, (const void*)(P->ws + WS_WUP8), 1024, S, E);
        pg8::Order S2; S2.init(2, 21, G, (bx + G - (2772 % G)) % G);
        pg8::AMapUp<128> am2{(const void*)(P->ws + WS_XB), 2048};
        EpiUp<true> E2{nullptr, (bf16_t*)(P->ws + WS_GS), P->in[20], P->in[21], P->in[6], P->out + O_FCS};
        pg8::gemm_phase<EpiUp<true>, pg8::AMapUp<128>>(lds, am2, (const void*)(P->ws + WS_WUP), 2048, S2, E2);
        small_ffnconv_prompt(P, lds, TIDX());
    }
    GRID_SYNC();
    PH(9) {
        pg8::AMapPlain am{(const void*)(P->ws + WS_G), DFF * 2}; pg8::Order S; S.init(128, 4, G, bx);
        EpiDown E{(const bf16_t*)(P->ws + WS_XB), (bf16_t*)(P->ws + WS_A2)};
        pg8::gemm_phase<EpiDown, pg8::AMapPlain>(lds, am, (const void*)(P->ws + WS_WDOWN), DFF * 2, S, E);
        small_down_splitk(P, lds, TIDX());
    }
    GRID_SYNC();
    PH(10) phase_ln<false>((const bf16_t*)(P->ws + WS_A2), P->in[23], P->in[24], (void*)(P->out + O_Y), nullptr, nullptr, TIDX());
    }
}

extern "C" void kernel_launch(void* const* d_in, const int* in_sizes, int n_in, void* d_out, int out_size, void* d_ws, size_t ws_size, hipStream_t stream) {
    static int grid_blocks = 0;
    if (!grid_blocks) {
        int dev = 0, cus = 0, per_cu = 0;
        hipGetDevice(&dev);
        hipDeviceGetAttribute(&cus, hipDeviceAttributeMultiprocessorCount, dev);
        hipFuncSetAttribute((const void*)hybrid_fwd, hipFuncAttributeMaxDynamicSharedMemorySize, LDS_BYTES);
        hipOccupancyMaxActiveBlocksPerMultiprocessor(&per_cu, (const void*)hybrid_fwd, NT, LDS_BYTES);
        if (per_cu < 1) per_cu = 1;
        if (per_cu > 1) per_cu = 1;
        grid_blocks = cus * per_cu;
        if (ws_size < WS_END) fprintf(stderr, "kernel_launch: workspace too small: %zu < %zu\n", ws_size, (size_t)WS_END);
    }
    Params p{};
    for (int i = 0; i < 25; ++i) p.in[i] = (const float*)d_in[i];
    p.out = (float*)d_out; p.ws = (unsigned char*)d_ws;
    hipMemsetAsync((unsigned char*)d_ws + WS_BAR, 0, 16384, stream);
    void* args[] = {&p};
    hipError_t e = hipLaunchCooperativeKernel((const void*)hybrid_fwd, dim3(grid_blocks), dim3(NT), args, LDS_BYTES, stream);
    if (e != hipSuccess) fprintf(stderr, "cooperative launch failed: %s (grid %d)\n", hipGetErrorString(e), grid_blocks);
}
```
